# Optimizing an MI355X kernel written in HIP

```python
import jax, jax.numpy as jnp
from jax import lax
import numpy as np

D_MODEL = 2048
BATCH = 4
SEQ = 2048
DEPTH = 1

PLE_DIM = 256
ATTN_HEADS = 8
HEAD_DIM = 128
ATTN_WIDTH = ATTN_HEADS * HEAD_DIM
MOBA_BLOCK = 256
MOBA_TOPK = 3
QUERY_CHUNK = 16
LRU_WIDTH = 1024
LRU_BLOCKS = 8
LRU_BLOCK_DIM = LRU_WIDTH // LRU_BLOCKS
CONV_WIDTH = 4
LRU_C = 8.0
EPS = 1e-6
NEG = -1e30
IN_SPLITS = (ATTN_WIDTH, ATTN_WIDTH, ATTN_WIDTH, ATTN_WIDTH, LRU_WIDTH, LRU_WIDTH, D_MODEL, D_MODEL)
D_IN = sum(IN_SPLITS)

kernel_name = "moba_rglru_gated_hybrid"


def rms_norm(x, g):
    xf = x.astype(jnp.float32)
    y = xf * lax.rsqrt(jnp.mean(xf * xf, axis=-1, keepdims=True) + EPS)
    return (y * g.astype(jnp.float32)).astype(x.dtype)


def moba_attention(q, k, v):
    B, S, H, Dh = q.shape
    nblk = -(-S // MOBA_BLOCK)
    S_pad = nblk * MOBA_BLOCK
    pad = ((0, 0), (0, S_pad - S), (0, 0), (0, 0))
    q, k, v = [jnp.pad(t, pad).transpose(0, 2, 1, 3) for t in (q, k, v)]
    kb = k.reshape(B, H, nblk, MOBA_BLOCK, Dh)
    vb = v.reshape(B, H, nblk, MOBA_BLOCK, Dh)
    k_mean = jnp.mean(kb.astype(jnp.float32), axis=3)
    gate = jnp.einsum('bhsd,bhnd->bhsn', q.astype(jnp.float32), k_mean)
    qblk = jnp.arange(S_pad) // MOBA_BLOCK
    past = jnp.arange(nblk)[None, :] < qblk[:, None]
    gate = jnp.where(past, gate, NEG)
    n_sel = min(MOBA_TOPK, max(nblk - 1, 1))
    _, sel = lax.top_k(gate, n_sel)
    sel_valid = sel < qblk[:, None]

    n_chunk = S_pad // QUERY_CHUNK

    def to_chunks(t):
        return jnp.moveaxis(t.reshape(B, H, n_chunk, QUERY_CHUNK, *t.shape[3:]), 2, 0)

    starts = jnp.arange(n_chunk, dtype=jnp.int32) * QUERY_CHUNK
    scale = Dh ** -0.5
    gather = jax.vmap(jax.vmap(lambda blocks, idx: blocks[idx]))

    def chunk_fn(args):
        qc, sc, vc, start = args
        cblk = start // MOBA_BLOCK
        k_own = lax.dynamic_index_in_dim(kb, cblk, axis=2, keepdims=False)
        v_own = lax.dynamic_index_in_dim(vb, cblk, axis=2, keepdims=False)
        k_sel = gather(kb, sc)
        v_sel = gather(vb, sc)
        s_own = jnp.einsum('bhqd,bhld->bhql', qc, k_own, preferred_element_type=jnp.float32) * scale
        qpos = start + jnp.arange(QUERY_CHUNK)
        kpos = cblk * MOBA_BLOCK + jnp.arange(MOBA_BLOCK)
        s_own = jnp.where(kpos[None, :] <= qpos[:, None], s_own, NEG)
        s_sel = jnp.einsum('bhqd,bhqkld->bhqkl', qc, k_sel, preferred_element_type=jnp.float32) * scale
        s_sel = jnp.where(vc[..., None], s_sel, NEG)
        s = jnp.concatenate([s_own, s_sel.reshape(B, H, QUERY_CHUNK, n_sel * MOBA_BLOCK)], axis=-1)
        pr = jax.nn.softmax(s, axis=-1).astype(v.dtype)
        p_own = pr[..., :MOBA_BLOCK]
        p_sel = pr[..., MOBA_BLOCK:].reshape(B, H, QUERY_CHUNK, n_sel, MOBA_BLOCK)
        return (jnp.einsum('bhql,bhld->bhqd', p_own, v_own)
                + jnp.einsum('bhqkl,bhqkld->bhqd', p_sel, v_sel))

    out = lax.map(chunk_fn, (to_chunks(q), to_chunks(sel), to_chunks(sel_valid), starts))
    out = jnp.moveaxis(out, 0, 2).reshape(B, H, S_pad, Dh)[:, :, :S]
    return out.transpose(0, 2, 1, 3)


def causal_depthwise_conv(x, w, b):
    y = lax.conv_general_dilated(x, w[:, None, :], window_strides=(1,),
                                 padding=[(CONV_WIDTH - 1, 0)],
                                 dimension_numbers=('NWC', 'WIO', 'NWC'),
                                 feature_group_count=x.shape[-1])
    return y + b


def rg_lru(x, w_r, b_r, w_i, b_i, lam):
    B, S, W = x.shape
    xb = x.reshape(B, S, LRU_BLOCKS, LRU_BLOCK_DIM)
    r = jax.nn.sigmoid(jnp.einsum('bsnd,nde->bsne', xb, w_r).reshape(B, S, W) + b_r)
    i = jax.nn.sigmoid(jnp.einsum('bsnd,nde->bsne', xb, w_i).reshape(B, S, W) + b_i)
    log_a = -LRU_C * r.astype(jnp.float32) * jax.nn.softplus(-lam.astype(jnp.float32))
    a = jnp.exp(log_a)
    mult = jnp.sqrt(-jnp.expm1(2.0 * log_a))
    u = mult * (i * x).astype(jnp.float32)

    def combine(left, right):
        a1, b1 = left
        a2, b2 = right
        return a1 * a2, a2 * b1 + b2

    _, h = lax.associative_scan(combine, (a, u), axis=1)
    return h.astype(x.dtype)


def setup_inputs(seed: int = 0) -> dict:
    key = jax.random.key(seed)
    ks = jax.random.split(key, 20)
    n = jax.random.normal
    f32 = jnp.float32
    u = jax.random.uniform(ks[11], (DEPTH, LRU_WIDTH), f32, 0.9, 0.999)
    s = u ** (1.0 / LRU_C)
    lru_lambda = jnp.log(s) - jnp.log1p(-s)
    return {
        "x": n(ks[0], (BATCH, SEQ, D_MODEL), f32),
        "p": n(ks[1], (DEPTH, BATCH, SEQ, PLE_DIM), f32),
        "norm_g": 1.0 + 0.02 * n(ks[2], (DEPTH, D_MODEL), f32),
        "w_in": n(ks[3], (DEPTH, D_MODEL, D_IN), f32) * D_MODEL ** -0.5,
        "q_norm_g": 1.0 + 0.02 * n(ks[4], (DEPTH, HEAD_DIM), f32),
        "k_norm_g": 1.0 + 0.02 * n(ks[5], (DEPTH, HEAD_DIM), f32),
        "conv_w": n(ks[6], (DEPTH, CONV_WIDTH, LRU_WIDTH), f32) * CONV_WIDTH ** -0.5,
        "conv_b": 0.01 * n(ks[7], (DEPTH, LRU_WIDTH), f32),
        "lru_wr": n(ks[8], (DEPTH, LRU_BLOCKS, LRU_BLOCK_DIM, LRU_BLOCK_DIM), f32) * LRU_BLOCK_DIM ** -0.5,
        "lru_br": 0.01 * n(ks[9], (DEPTH, LRU_WIDTH), f32),
        "lru_wi": n(ks[10], (DEPTH, LRU_BLOCKS, LRU_BLOCK_DIM, LRU_BLOCK_DIM), f32) * LRU_BLOCK_DIM ** -0.5,
        "lru_bi": 0.01 * n(ks[12], (DEPTH, LRU_WIDTH), f32),
        "lru_lambda": lru_lambda,
        "w_up_attn": n(ks[13], (DEPTH, ATTN_WIDTH, D_MODEL), f32) * ATTN_WIDTH ** -0.5,
        "w_up_lru": n(ks[14], (DEPTH, LRU_WIDTH, D_MODEL), f32) * LRU_WIDTH ** -0.5,
        "w_out": n(ks[15], (DEPTH, D_MODEL, D_MODEL), f32) * D_MODEL ** -0.5,
        "ple_norm_g": 1.0 + 0.02 * n(ks[16], (DEPTH, D_MODEL), f32),
        "w_ple_gate": n(ks[17], (DEPTH, D_MODEL, D_MODEL), f32) * D_MODEL ** -0.5,
        "b_ple_gate": 0.01 * n(ks[18], (DEPTH, D_MODEL), f32),
        "w_ple": n(ks[19], (DEPTH, PLE_DIM, D_MODEL), f32) * PLE_DIM ** -0.5,
    }


def reference(x, p, norm_g, w_in, q_norm_g, k_norm_g, conv_w, conv_b, lru_wr, lru_br,
              lru_wi, lru_bi, lru_lambda, w_up_attn, w_up_lru, w_out, ple_norm_g,
              w_ple_gate, b_ple_gate, w_ple):
    B, S, _ = x.shape
    split_points = [int(v) for v in np.cumsum(IN_SPLITS)[:-1]]
    for l in range(DEPTH):
        h = rms_norm(x, norm_g[l])
        proj = jnp.einsum('bsd,de->bse', h, w_in[l])
        q, k, v, g_attn, xr, g_lru, m_attn, m_lru = jnp.split(proj, split_points, axis=-1)
        q = rms_norm(q.reshape(B, S, ATTN_HEADS, HEAD_DIM), q_norm_g[l])
        k = rms_norm(k.reshape(B, S, ATTN_HEADS, HEAD_DIM), k_norm_g[l])
        v = v.reshape(B, S, ATTN_HEADS, HEAD_DIM)
        ya = moba_attention(q, k, v).reshape(B, S, ATTN_WIDTH) * jax.nn.silu(g_attn)
        xr = causal_depthwise_conv(xr, conv_w[l], conv_b[l])
        yb = rg_lru(xr, lru_wr[l], lru_br[l], lru_wi[l], lru_bi[l], lru_lambda[l]) * jax.nn.silu(g_lru)
        ua = jnp.einsum('bse,ed->bsd', ya, w_up_attn[l])
        ub = jnp.einsum('bse,ed->bsd', yb, w_up_lru[l])
        merged = jax.nn.sigmoid(m_attn) * ua + jax.nn.sigmoid(m_lru) * ub
        x = x + jnp.einsum('bsd,de->bse', merged, w_out[l])
        pg = jax.nn.sigmoid(jnp.einsum('bsd,de->bse', rms_norm(x, ple_norm_g[l]), w_ple_gate[l]) + b_ple_gate[l])
        x = x + jnp.einsum('bsk,kd->bsd', p[l], w_ple[l]) * pg
    return x
```

```cpp
#include <hip/hip_runtime.h>
#include <hip/hip_bf16.h>
#include <hip/hip_cooperative_groups.h>
#include <cstdio>
#include <cstdint>
#include <cmath>
namespace pg8 {
#define PG8_LAS __attribute__((address_space(3)))
typedef unsigned short bf16_t;
typedef short bf16x8 __attribute__((ext_vector_type(8)));
typedef float f32x4 __attribute__((ext_vector_type(4)));
typedef unsigned u32x4 __attribute__((ext_vector_type(4)));
constexpr int BM = 256, BK = 64, HALF = 128, HTB = HALF * BK * 2  , STAGE_BYTES = 8 * HTB, NXCD = 8, WGM = 8;

__host__ __device__ __forceinline__ int lds_byte(int r, int c) { const int st = (r >> 4) * 2 + (c >> 5), rr = r & 15, cc = c & 31, ob = rr * 64 + cc * 2; return st * 1024 + (ob ^ (((ob >> 9) & 1) << 5)); }
__host__ __device__ __forceinline__ void stage_rc(int b, int& R, int& C) { const int st = b / 1024, sb = b % 1024, swz = sb ^ (((sb >> 9) & 1) << 5); R = (st >> 1) * 16 + swz / 64; C = (st & 1) * 32 + (swz % 64) / 2; }
__host__ __device__ __forceinline__ int perm32(int rho) { const int n = rho >> 4, i = rho & 15; return 8 * (i >> 2) + 4 * n + (i & 3); }

struct Unit { int pm, pn; };
struct Gemm { const bf16_t* A; const bf16_t* Bt; int M, N, K; };

struct StaticOrder {
    int nM, nN, nwg, G, c;
    __host__ __device__ void init(int M, int N, int G_, int c_) { nM = M / BM; nN = N / BM; nwg = nM * nN; G = G_; c = c_; }
    __host__ __device__ bool next(int i, Unit& u) const {
        const long L = (long)i * G + c; if (L >= nwg) return false;
        int wgid = (int)L; { const int q = nwg / NXCD, r = nwg % NXCD, xcd = wgid % NXCD, off = wgid / NXCD; wgid = (xcd < r ? xcd * (q + 1) : r * (q + 1) + (xcd - r) * q) + off; }
        const int nig = WGM * nN, gid = wgid / nig, fm = gid * WGM, gsz = (nM - fm) < WGM ? (nM - fm) : WGM;
        u.pm = fm + ((wgid % nig) % gsz); u.pn = (wgid % nig) / gsz; return true;
    }
    __device__ __forceinline__ void a_ready(const Unit&) const {}
    __device__ __forceinline__ void done(const Unit&) const {}
};

__device__ __forceinline__ unsigned cvt_pk_bf16(float lo, float hi) { unsigned r; asm volatile("v_cvt_pk_bf16_f32 %0, %1, %2" : "=v"(r) : "v"(lo), "v"(hi)); return r; }
__device__ __forceinline__ float bf_lo(unsigned w) { return __uint_as_float(w << 16); }
__device__ __forceinline__ float bf_hi(unsigned w) { return __uint_as_float(w & 0xffff0000u); }
__device__ __forceinline__ float sigmoidf_(float x) { return __builtin_amdgcn_rcpf(1.0f + __expf(-x)); }
__device__ __forceinline__ float siluf_(float x) { return x * __builtin_amdgcn_rcpf(1.0f + __expf(-x)); }
__device__ __forceinline__ u32x4 pack8bf(const f32x4& v0, const f32x4& v1) { u32x4 w; w.x = cvt_pk_bf16(v0[0], v0[1]); w.y = cvt_pk_bf16(v0[2], v0[3]); w.z = cvt_pk_bf16(v1[0], v1[1]); w.w = cvt_pk_bf16(v1[2], v1[3]); return w; }
__device__ __forceinline__ void unpack8bf(const u32x4& w, f32x4& v0, f32x4& v1) { v0 = (f32x4){bf_lo(w.x), bf_hi(w.x), bf_lo(w.y), bf_hi(w.y)}; v1 = (f32x4){bf_lo(w.z), bf_hi(w.z), bf_lo(w.w), bf_hi(w.w)}; }

constexpr int SEQ_ = 2048, NHEAD_ = 8;
struct EpiG1 {
    static constexpr bool PERM = true, AFTER_DRAIN = false, HOOK = false;
    unsigned char* wsQ; float* KMP; const float *qg, *kg; PG8_LAS float* scr; int hook_t;
    __device__ __forceinline__ void mid(f32x4 (&acc)[2][2][4][2], const Unit& u, int wr, int wc, int fr, int fq) const {}
    __device__ __forceinline__ void operator()(f32x4 (&acc)[2][2][4][2], const Unit& u, int wr, int wc, int fr, int fq) const {
        const int pn = u.pn; asm volatile("" : "+v"(fr), "+v"(fq));
        if (pn < 12) {
            if (pn < 8) {
#pragma unroll
                for (int ai = 0; ai < 2; ++ai)
#pragma unroll
                    for (int m = 0; m < 4; ++m)
#pragma unroll
                        for (int bj = 0; bj < 2; ++bj) {
                            const f32x4 a = acc[ai][bj][m][0], b = acc[ai][bj][m][1];
                            float s = (a[0] * a[0] + a[1] * a[1]) + (a[2] * a[2] + a[3] * a[3]) + (b[0] * b[0] + b[1] * b[1]) + (b[2] * b[2] + b[3] * b[3]);
                            s += __shfl_xor(s, 16); s += __shfl_xor(s, 32);
                            if (fq == 0) scr[((ai * HALF + wr * 64 + m * 16 + fr) * 2 + bj) * 4 + wc] = s;
                        }
                asm volatile("s_waitcnt lgkmcnt(0)" ::: "memory"); __builtin_amdgcn_s_barrier(); asm volatile("" ::: "memory");
                const f32x4 gq0 = *(const f32x4*)(qg + wc * 32 + 8 * fq), gq1 = *(const f32x4*)(qg + wc * 32 + 8 * fq + 4);
                const f32x4 gk0 = *(const f32x4*)(kg + wc * 32 + 8 * fq), gk1 = *(const f32x4*)(kg + wc * 32 + 8 * fq + 4);
                const f32x4 g0 = (pn < 4) ? gq0 : gk0, g1 = (pn < 4) ? gq1 : gk1;
#pragma unroll
                for (int ai = 0; ai < 2; ++ai)
#pragma unroll
                    for (int m = 0; m < 4; ++m)
#pragma unroll
                        for (int bj = 0; bj < 2; ++bj) {
                            const f32x4 p = *(const PG8_LAS f32x4*)(scr + ((ai * HALF + wr * 64 + m * 16 + fr) * 2 + bj) * 4);
                            const float rstd = __builtin_amdgcn_rsqf(((p[0] + p[1]) + (p[2] + p[3])) * (1.0f / 128.0f) + 1e-6f);
                            acc[ai][bj][m][0] = acc[ai][bj][m][0] * rstd * g0; acc[ai][bj][m][1] = acc[ai][bj][m][1] * rstd * g1;
                        }
                if (pn >= 4) {
#pragma unroll
                    for (int bj = 0; bj < 2; ++bj)
#pragma unroll
                        for (int n = 0; n < 2; ++n) {
                            f32x4 cs = (f32x4){0.f, 0.f, 0.f, 0.f};
#pragma unroll
                            for (int ai = 0; ai < 2; ++ai)
#pragma unroll
                                for (int m = 0; m < 4; ++m) cs += acc[ai][bj][m][n];
#pragma unroll
                            for (int o = 1; o < 16; o <<= 1) { cs[0] += __shfl_xor(cs[0], o); cs[1] += __shfl_xor(cs[1], o); cs[2] += __shfl_xor(cs[2], o); cs[3] += __shfl_xor(cs[3], o); }
                            if (fr == 0) *(f32x4*)(KMP + (size_t)(u.pm * 2 + wr) * 1024 + (pn - 4) * 256 + bj * HALF + wc * 32 + 8 * fq + 4 * n) = cs;
                        }
                }
            }
            bf16_t* base = (bf16_t*)(wsQ + (size_t)(pn >> 2) * (16u << 20));
            const int b = u.pm >> 3; int s0 = (u.pm & 7) * 256 + wr * 64 + fr; asm volatile("" : "+v"(s0));
#pragma unroll
            for (int bj = 0; bj < 2; ++bj) {
                const int h = 2 * (pn & 3) + bj;
                bf16_t* hp = base + ((size_t)(b * NHEAD_ + h) * SEQ_ + s0) * 128 + wc * 32 + 8 * fq;
#pragma unroll
                for (int ai = 0; ai < 2; ++ai)
#pragma unroll
                    for (int m = 0; m < 4; ++m) *(u32x4*)(hp + (size_t)(ai * HALF + m * 16) * 128) = pack8bf(acc[ai][bj][m][0], acc[ai][bj][m][1]);
            }
        } else {
            bf16_t* base; int ldc, colt, act;
            if (pn < 24) { base = (bf16_t*)(wsQ + (size_t)(pn >> 2) * (16u << 20)); ldc = 1024; colt = (pn & 3) * 256; act = ((pn >> 2) == 4) ? 0 : 1; }
            else { base = (bf16_t*)(wsQ + (size_t)(96u << 20) + (size_t)((pn - 24) >> 3) * (32u << 20)); ldc = 2048; colt = ((pn - 24) & 7) * 256; act = 2; }
            int row0 = u.pm * BM + wr * 64 + fr, col0 = colt + wc * 32 + 8 * fq; asm volatile("" : "+v"(row0), "+v"(col0));
#pragma unroll
            for (int ai = 0; ai < 2; ++ai)
#pragma unroll
                for (int m = 0; m < 4; ++m) { bf16_t* rowp = base + (size_t)(row0 + ai * HALF + m * 16) * ldc + col0;
#pragma unroll
                    for (int bj = 0; bj < 2; ++bj) { f32x4 v0 = acc[ai][bj][m][0], v1 = acc[ai][bj][m][1];
                        if (act != 0) {
#pragma unroll
                            for (int j = 0; j < 4; ++j) { const float e0 = __builtin_amdgcn_rcpf(1.0f + __expf(-v0[j])), e1 = __builtin_amdgcn_rcpf(1.0f + __expf(-v1[j]));
                                v0[j] = (act == 1) ? v0[j] * e0 : e0; v1[j] = (act == 1) ? v1[j] * e1 : e1; } }
                        *(u32x4*)(rowp + bj * HALF) = pack8bf(v0, v1); } }
        }
    }
};

struct EpiG2 {
    static constexpr bool PERM = true, AFTER_DRAIN = false, HOOK = true;
    const bf16_t *SA, *SL; bf16_t* MG; int hook_t;
    __device__ __forceinline__ void mid(f32x4 (&acc)[2][2][4][2], const Unit& u, int wr, int wc, int fr, int fq) const {
        int row0 = u.pm * BM + wr * 64 + fr, col0 = u.pn * BM + wc * 32 + 8 * fq; asm volatile("" : "+v"(row0), "+v"(col0));
#pragma unroll
        for (int ai = 0; ai < 2; ++ai)
#pragma unroll
            for (int m = 0; m < 4; ++m) { const size_t off = (size_t)(row0 + ai * HALF + m * 16) * 2048 + col0;
#pragma unroll
                for (int bj = 0; bj < 2; ++bj) {
                    const u32x4 wa = *(const u32x4*)(SA + off + bj * HALF), wl = *(const u32x4*)(SL + off + bj * HALF);
                    f32x4 a0, a1, l0, l1; unpack8bf(wa, a0, a1); unpack8bf(wl, l0, l1);
#pragma unroll
                    for (int j = 0; j < 4; ++j) { acc[ai][bj][m][0][j] *= a0[j] * __builtin_amdgcn_rcpf(l0[j]); acc[ai][bj][m][1][j] *= a1[j] * __builtin_amdgcn_rcpf(l1[j]); }
                }
                if (m & 1) asm volatile("" ::: "memory"); }
    }
    __device__ __forceinline__ void operator()(f32x4 (&acc)[2][2][4][2], const Unit& u, int wr, int wc, int fr, int fq) const {
        int row0 = u.pm * BM + wr * 64 + fr, col0 = u.pn * BM + wc * 32 + 8 * fq; asm volatile("" : "+v"(row0), "+v"(col0));
#pragma unroll
        for (int ai = 0; ai < 2; ++ai)
#pragma unroll
            for (int m = 0; m < 4; ++m) { const size_t off = (size_t)(row0 + ai * HALF + m * 16) * 2048 + col0;
#pragma unroll
                for (int bj = 0; bj < 2; ++bj) {
                    const u32x4 wl = *(const u32x4*)(SL + off + bj * HALF);
                    f32x4 l0, l1; unpack8bf(wl, l0, l1);
                    *(u32x4*)(MG + off + bj * HALF) = pack8bf(acc[ai][bj][m][0] * l0, acc[ai][bj][m][1] * l1);
                } }
    }
};

struct EpiG3 {
    static constexpr bool PERM = true, AFTER_DRAIN = false, HOOK = false;
    const float* X; float* OUT; bf16_t* X1G; float* SSQ; const float* gple; int hook_t;
    __device__ __forceinline__ void mid(f32x4 (&acc)[2][2][4][2], const Unit& u, int wr, int wc, int fr, int fq) const {}
    __device__ __forceinline__ void operator()(f32x4 (&acc)[2][2][4][2], const Unit& u, int wr, int wc, int fr, int fq) const {
        int row0 = u.pm * BM + wr * 64 + fr, col0 = u.pn * BM + wc * 32 + 8 * fq; asm volatile("" : "+v"(row0), "+v"(col0));
        f32x4 gv[2][2];
#pragma unroll
        for (int bj = 0; bj < 2; ++bj) { gv[bj][0] = *(const f32x4*)(gple + col0 + bj * HALF); gv[bj][1] = *(const f32x4*)(gple + col0 + bj * HALF + 4); }
#pragma unroll
        for (int ai = 0; ai < 2; ++ai)
#pragma unroll
            for (int m = 0; m < 4; ++m) { const int row = row0 + ai * HALF + m * 16; const size_t off = (size_t)row * 2048 + col0; float s = 0.f;
#pragma unroll
                for (int bj = 0; bj < 2; ++bj) {
                    const f32x4 x0 = *(const f32x4*)(X + off + bj * HALF) + acc[ai][bj][m][0], x1 = *(const f32x4*)(X + off + bj * HALF + 4) + acc[ai][bj][m][1];
                    *(f32x4*)(OUT + off + bj * HALF) = x0; *(f32x4*)(OUT + off + bj * HALF + 4) = x1;
                    s += (x0[0] * x0[0] + x0[1] * x0[1]) + (x0[2] * x0[2] + x0[3] * x0[3]) + (x1[0] * x1[0] + x1[1] * x1[1]) + (x1[2] * x1[2] + x1[3] * x1[3]);
                    *(u32x4*)(X1G + off + bj * HALF) = pack8bf(x0 * gv[bj][0], x1 * gv[bj][1]);
                }
                s += __shfl_xor(s, 16); s += __shfl_xor(s, 32);
                if (fq == 0) SSQ[(size_t)row * 32 + u.pn * 4 + wc] = s;
            }
    }
};

struct EpiG4a {
    static constexpr bool PERM = true, AFTER_DRAIN = false, HOOK = false;
    bf16_t* PL; int hook_t;
    __device__ __forceinline__ void mid(f32x4 (&acc)[2][2][4][2], const Unit& u, int wr, int wc, int fr, int fq) const {}
    __device__ __forceinline__ void operator()(f32x4 (&acc)[2][2][4][2], const Unit& u, int wr, int wc, int fr, int fq) const {
        int row0 = u.pm * BM + wr * 64 + fr, col0 = u.pn * BM + wc * 32 + 8 * fq; asm volatile("" : "+v"(row0), "+v"(col0));
#pragma unroll
        for (int ai = 0; ai < 2; ++ai)
#pragma unroll
            for (int m = 0; m < 4; ++m) { const size_t off = (size_t)(row0 + ai * HALF + m * 16) * 2048 + col0;
#pragma unroll
                for (int bj = 0; bj < 2; ++bj) *(u32x4*)(PL + off + bj * HALF) = pack8bf(acc[ai][bj][m][0], acc[ai][bj][m][1]); }
    }
};

struct EpiG4b {
    static constexpr bool PERM = true, AFTER_DRAIN = false, HOOK = false;
    float* OUT; const bf16_t* PL; const float* SSQ; const float* bias; PG8_LAS float* scr; int hook_t;
    __device__ __forceinline__ void mid(f32x4 (&acc)[2][2][4][2], const Unit& u, int wr, int wc, int fr, int fq) const {}
    __device__ __forceinline__ void operator()(f32x4 (&acc)[2][2][4][2], const Unit& u, int wr, int wc, int fr, int fq) const {
        int row0 = u.pm * BM + wr * 64 + fr, col0 = u.pn * BM + wc * 32 + 8 * fq; asm volatile("" : "+v"(row0), "+v"(col0));
        {
            const int tid = threadIdx.x, hf = tid & 1; int rr = tid >> 1; asm volatile("" : "+v"(rr));
            f32x4 t = (f32x4){0.f, 0.f, 0.f, 0.f};
#pragma unroll
            for (int i = 0; i < 4; ++i) t += *(const f32x4*)(SSQ + (size_t)(u.pm * BM + rr) * 32 + hf * 16 + 4 * i);
            float s = (t[0] + t[1]) + (t[2] + t[3]); s += __shfl_xor(s, 1);
            if (hf == 0) scr[rr] = __builtin_amdgcn_rsqf(s * (1.0f / 2048.0f) + 1e-6f);
            asm volatile("s_waitcnt lgkmcnt(0)" ::: "memory"); __builtin_amdgcn_s_barrier(); asm volatile("" ::: "memory");
        }
        f32x4 bv[2][2];
#pragma unroll
        for (int bj = 0; bj < 2; ++bj) { bv[bj][0] = *(const f32x4*)(bias + col0 + bj * HALF); bv[bj][1] = *(const f32x4*)(bias + col0 + bj * HALF + 4); }
#pragma unroll
        for (int ai = 0; ai < 2; ++ai)
#pragma unroll
            for (int m = 0; m < 4; ++m) { const int row = row0 + ai * HALF + m * 16; const size_t off = (size_t)row * 2048 + col0;
                const float rstd = scr[ai * HALF + wr * 64 + m * 16 + fr];
#pragma unroll
                for (int bj = 0; bj < 2; ++bj) {
                    const u32x4 wp = *(const u32x4*)(PL + off + bj * HALF); f32x4 p0, p1; unpack8bf(wp, p0, p1);
                    f32x4 x0 = *(const f32x4*)(OUT + off + bj * HALF), x1 = *(const f32x4*)(OUT + off + bj * HALF + 4);
                    const f32x4 z0 = acc[ai][bj][m][0] * rstd + bv[bj][0], z1 = acc[ai][bj][m][1] * rstd + bv[bj][1];
#pragma unroll
                    for (int j = 0; j < 4; ++j) { x0[j] += p0[j] * sigmoidf_(z0[j]); x1[j] += p1[j] * sigmoidf_(z1[j]); }
                    *(f32x4*)(OUT + off + bj * HALF) = x0; *(f32x4*)(OUT + off + bj * HALF + 4) = x1;
                }
                if (m & 1) asm volatile("" ::: "memory"); }
    }
};
template <class Epi, class Sched, bool ALIGN_EPI = false, bool SP2 = false>
__device__ __forceinline__ void gemm_phase(PG8_LAS unsigned char* lds, const Gemm g, const Sched& S, const Epi& E) {
    int tid_ = threadIdx.x; asm volatile("" : "+v"(tid_)); const int tid = tid_, wid = __builtin_amdgcn_readfirstlane(tid >> 6), lane = tid & 63, wr = wid >> 2, wc = wid & 3, fr = lane & 15, fq = lane >> 4;
    const int K = g.K, nt = K / BK;
    unsigned voffA[2], voffB[2];
#pragma unroll
    for (int i = 0; i < 2; ++i) { int R, C; stage_rc(tid * 16 + i * 8192, R, C); const int Rb = Epi::PERM ? ((R & ~31) + perm32(R & 31)) : R;
        voffA[i] = (unsigned)(R * K + C) * 2u; voffB[i] = (unsigned)(Rb * K + C) * 2u; }
    const size_t kstep = (size_t)(BK * 2);
    const size_t hstep = (size_t)HALF * K * 2;
    const size_t tstep = 2 * hstep;
    const unsigned ldsw = (unsigned)wid * 1024u;
    const int aoff = lds_byte(wr * 64 + fr, fq * 8), boff = lds_byte(wc * 32 + fr, fq * 8);
#define PG8_SA(b, h) (((b) * 2 + (h)) * HTB)
#define PG8_SB(b, h) ((4 + (b) * 2 + (h)) * HTB)
#define PG8_STAGE(bufoff, gbase, voff) do { _Pragma("unroll") for (int _i = 0; _i < 2; ++_i) \
        __builtin_amdgcn_global_load_lds((const unsigned*)((const char*)(gbase) + (voff)[_i]), (PG8_LAS unsigned*)(lds + (bufoff) + ldsw + _i * 8192), 16, 0, 0); } while (0)
#define PG8_LDA(dst, b, h) do { _Pragma("unroll") for (int m = 0; m < 4; ++m) _Pragma("unroll") for (int k = 0; k < 2; ++k) dst[m][k] = *(const PG8_LAS bf16x8*)(lds + PG8_SA(b, h) + aoff + m * 2048 + k * 1024); } while (0)
#define PG8_LDB(dst, b, h) do { _Pragma("unroll") for (int n = 0; n < 2; ++n) _Pragma("unroll") for (int k = 0; k < 2; ++k) dst[n][k] = *(const PG8_LAS bf16x8*)(lds + PG8_SB(b, h) + boff + n * 2048 + k * 1024); } while (0)
#define PG8_MMA(ai, bj, At, Bt) do { __builtin_amdgcn_s_setprio(1); _Pragma("unroll") for (int m = 0; m < 4; ++m) _Pragma("unroll") for (int n = 0; n < 2; ++n) _Pragma("unroll") for (int k = 0; k < 2; ++k) \
        acc[ai][bj][m][n] = __builtin_amdgcn_mfma_f32_16x16x32_bf16(Bt[n][k], At[m][k], acc[ai][bj][m][n], 0, 0, 0); __builtin_amdgcn_s_setprio(0); } while (0)
#define PG8_WAIT_V(n) asm volatile("s_waitcnt vmcnt(" #n ")" ::: "memory")
#define PG8_WAIT_L(n) asm volatile("s_waitcnt lgkmcnt(" #n ")" ::: "memory")
#define PG8_BAR __builtin_amdgcn_s_barrier()
#define PG8_SCHED __builtin_amdgcn_sched_barrier(0)
    Unit cur, nxt; int ui = 0;
    if (!S.next(0, cur)) return;
    f32x4 acc[2][2][4][2];
#pragma unroll
    for (int a = 0; a < 2; ++a)
#pragma unroll
        for (int b = 0; b < 2; ++b)
#pragma unroll
            for (int m = 0; m < 4; ++m)
#pragma unroll
                for (int n = 0; n < 2; ++n) acc[a][b][m][n] = (f32x4){0.f, 0.f, 0.f, 0.f};
    bf16x8 At[4][2], B0[2][2], B1[2][2];
    const char* cA = (const char*)g.A + (size_t)cur.pm * tstep; const char* cB = (const char*)g.Bt + (size_t)cur.pn * tstep;
    S.a_ready(cur);
    if constexpr (SP2) {
        PG8_STAGE(PG8_SB(0, 0), cB, voffB); PG8_STAGE(PG8_SB(0, 1), cB + hstep, voffB); PG8_STAGE(PG8_SA(0, 0), cA, voffA); PG8_STAGE(PG8_SA(0, 1), cA + hstep, voffA);
        if (wr == 1) PG8_BAR;
        PG8_WAIT_V(2); PG8_BAR;
        PG8_STAGE(PG8_SB(1, 0), cB + kstep, voffB); PG8_STAGE(PG8_SA(1, 0), cA + kstep, voffA); PG8_STAGE(PG8_SB(1, 1), cB + hstep + kstep, voffB);
        PG8_WAIT_V(6); PG8_BAR;
    } else {
        PG8_STAGE(PG8_SB(0, 0), cB, voffB); PG8_STAGE(PG8_SA(0, 0), cA, voffA); PG8_STAGE(PG8_SB(0, 1), cB + hstep, voffB); PG8_STAGE(PG8_SA(0, 1), cA + hstep, voffA);
        if (wr == 1) PG8_BAR;
        PG8_WAIT_V(4); PG8_BAR;
        PG8_STAGE(PG8_SB(1, 0), cB + kstep, voffB); PG8_STAGE(PG8_SA(1, 0), cA + kstep, voffA); PG8_STAGE(PG8_SB(1, 1), cB + hstep + kstep, voffB);
        PG8_WAIT_V(6); PG8_BAR;
    }
    for (;;) {
        const bool has_next = S.next(ui + 1, nxt);
        const char* nA = has_next ? (const char*)g.A + (size_t)nxt.pm * tstep : cA; const char* nB = has_next ? (const char*)g.Bt + (size_t)nxt.pn * tstep : cB;
        for (int t = 0; t < nt; t += 2) {
            const bool last = (t == nt - 2);
            if constexpr (Epi::HOOK) { if (t == E.hook_t) E.mid(acc, cur, wr, wc, fr, fq); }
            const char* a1 = cA + (size_t)(t + 1) * kstep;
            const char* a2 = last ? nA : cA + (size_t)(t + 2) * kstep; const char* b2 = last ? nB : cB + (size_t)(t + 2) * kstep;
            const char* a3 = a2 + kstep; const char* b3 = b2 + kstep;
            if (last && has_next) S.a_ready(nxt);
            if constexpr (SP2) {
            PG8_LDB(B0, 0, 0); PG8_LDB(B1, 0, 1); PG8_SCHED; PG8_LDA(At, 0, 0); PG8_STAGE(PG8_SA(1, 1), a1 + hstep, voffA);
            PG8_WAIT_V(8); PG8_WAIT_L(0); PG8_BAR; PG8_MMA(0, 0, At, B0); PG8_MMA(0, 1, At, B1); PG8_BAR; PG8_SCHED;
            PG8_LDA(At, 0, 1); PG8_STAGE(PG8_SB(0, 0), b2, voffB); PG8_STAGE(PG8_SB(0, 1), b2 + hstep, voffB); PG8_STAGE(PG8_SA(0, 0), a2, voffA);
            PG8_WAIT_V(8); PG8_WAIT_L(0); PG8_BAR; PG8_MMA(1, 0, At, B0); PG8_MMA(1, 1, At, B1); PG8_BAR; PG8_SCHED;
            PG8_LDB(B0, 1, 0); PG8_LDB(B1, 1, 1); PG8_SCHED; PG8_LDA(At, 1, 0); PG8_STAGE(PG8_SA(0, 1), a2 + hstep, voffA);
            PG8_WAIT_V(8); PG8_WAIT_L(0); PG8_BAR; PG8_MMA(0, 0, At, B0); PG8_MMA(0, 1, At, B1); PG8_BAR; PG8_SCHED;
            PG8_LDA(At, 1, 1); PG8_STAGE(PG8_SB(1, 0), b3, voffB); PG8_STAGE(PG8_SB(1, 1), b3 + hstep, voffB); PG8_STAGE(PG8_SA(1, 0), a3, voffA);
            PG8_WAIT_V(8); PG8_WAIT_L(0); PG8_BAR; PG8_MMA(1, 0, At, B0); PG8_MMA(1, 1, At, B1); PG8_BAR; PG8_SCHED;
            } else {
            PG8_LDB(B0, 0, 0); PG8_SCHED; PG8_LDA(At, 0, 0); PG8_STAGE(PG8_SA(1, 1), a1 + hstep, voffA);
            PG8_WAIT_L(8); PG8_BAR; PG8_WAIT_L(0); PG8_MMA(0, 0, At, B0); PG8_BAR; PG8_SCHED;
            PG8_LDB(B1, 0, 1); PG8_STAGE(PG8_SB(0, 0), b2, voffB);
            PG8_BAR; PG8_WAIT_L(0); PG8_MMA(0, 1, At, B1); PG8_BAR;
            PG8_LDA(At, 0, 1); PG8_STAGE(PG8_SA(0, 0), a2, voffA);
            PG8_BAR; PG8_WAIT_L(0); PG8_MMA(1, 0, At, B0); PG8_BAR; PG8_SCHED;
            PG8_STAGE(PG8_SB(0, 1), b2 + hstep, voffB);
            PG8_WAIT_V(6); PG8_BAR; PG8_MMA(1, 1, At, B1); PG8_BAR;
            PG8_LDB(B0, 1, 0); PG8_SCHED; PG8_LDA(At, 1, 0); PG8_STAGE(PG8_SA(0, 1), a2 + hstep, voffA);
            PG8_WAIT_L(8); PG8_BAR; PG8_WAIT_L(0); PG8_MMA(0, 0, At, B0); PG8_BAR; PG8_SCHED;
            PG8_LDB(B1, 1, 1); PG8_STAGE(PG8_SB(1, 0), b3, voffB);
            PG8_BAR; PG8_WAIT_L(0); PG8_MMA(0, 1, At, B1); PG8_BAR;
            PG8_LDA(At, 1, 1); PG8_STAGE(PG8_SA(1, 0), a3, voffA);
            PG8_BAR; PG8_WAIT_L(0); PG8_MMA(1, 0, At, B0); PG8_BAR; PG8_SCHED;
            PG8_STAGE(PG8_SB(1, 1), b3 + hstep, voffB);
            PG8_WAIT_V(6); PG8_BAR; PG8_MMA(1, 1, At, B1); PG8_BAR;
            }
        }
        if constexpr (ALIGN_EPI) { if (wr == 0) PG8_BAR; }
        if constexpr (!Epi::AFTER_DRAIN) { E(acc, cur, wr, wc, fr, fq); S.done(cur); }
        if (!has_next) break;
#pragma unroll
        for (int a = 0; a < 2; ++a)
#pragma unroll
            for (int b = 0; b < 2; ++b)
#pragma unroll
                for (int m = 0; m < 4; ++m)
#pragma unroll
                    for (int n = 0; n < 2; ++n) acc[a][b][m][n] = (f32x4){0.f, 0.f, 0.f, 0.f};
        cur = nxt; cA = nA; cB = nB; ++ui;
        if constexpr (ALIGN_EPI) { if (wr == 1) PG8_BAR; }
    }
    PG8_WAIT_V(0);
    if constexpr (!ALIGN_EPI) { if (wr == 0) PG8_BAR; }
    PG8_BAR;
#undef PG8_SA
#undef PG8_SB
#undef PG8_STAGE
#undef PG8_LDA
#undef PG8_LDB
#undef PG8_MMA
#undef PG8_WAIT_V
#undef PG8_WAIT_L
#undef PG8_BAR
#undef PG8_SCHED
}
}

namespace attn {
constexpr int D = 128;
constexpr float THR = 8.f;
constexpr bool WSKIP = false;
constexpr float SCALE = 0.08838834764831845f;
constexpr int NW = 8, QBLK = 32, KVBLK = 64, QB = NW * QBLK;
constexpr int SHM_V = KVBLK * D * 2, SHM_K = KVBLK * D * 2;
constexpr int LDS_BYTES = 2 * SHM_V + 2 * SHM_K + NW * 64 * 4;
constexpr int KM_OFF = 69632;
constexpr int LDO = 2048, LDG = 1024, STG_OFF = 73728;
#ifndef MOBA_ON
#define MOBA_ON 1
#endif
#ifndef GA_ON
#define GA_ON 1
#endif
using bf16 = __hip_bfloat16;
typedef short bf16x8 __attribute__((ext_vector_type(8)));
typedef short s16x4 __attribute__((ext_vector_type(4)));
typedef float f32x16 __attribute__((ext_vector_type(16)));
typedef float f32x4 __attribute__((ext_vector_type(4)));
typedef unsigned u32x4 __attribute__((ext_vector_type(4)));
template <class A, class Bt> struct same_t { static constexpr bool v = false; };
template <class A> struct same_t<A, A> { static constexpr bool v = true; };

#define KSWZ(row, colB) ((row) * 256 + ((colB) ^ (((row) & 7) << 4)))
#define SBAR() __builtin_amdgcn_sched_barrier(0)
__device__ __forceinline__ int v_st(int k, int c) { const int kk = (k & ~0xC) | ((k & 4) << 1) | ((k & 8) >> 1); return ((kk >> 3) * 4 + (c >> 5)) * 512 + ((kk & 7) * 32 + (c & 31)) * 2; }
__device__ __forceinline__ int v_rd_base(int lane) { return ((lane & 3) << 3) | (((lane >> 2) & 3) << 6) | (((lane >> 4) & 1) << 5) | (((lane >> 5) & 1) << 8); }
constexpr int v_rd_off(int d0, int ks, int half) { return d0 * 512 + ks * 4096 + half * 2048; }
__device__ __forceinline__ int crow(int r, int hi) { return (r & 3) + 8 * (r >> 2) + 4 * hi; }
__device__ __forceinline__ unsigned cvtpk(float lo, float hi) {
    unsigned r; asm volatile("v_cvt_pk_bf16_f32 %0, %1, %2" : "=v"(r) : "v"(lo), "v"(hi)); return r;
}
__device__ __forceinline__ bf16x8 pack8(f32x4 a, f32x4 b) {
    u32x4 w = {cvtpk(a[0], a[1]), cvtpk(a[2], a[3]), cvtpk(b[0], b[1]), cvtpk(b[2], b[3])};
    return *reinterpret_cast<bf16x8*>(&w);
}
template <class T> __device__ __forceinline__ bf16x8 load8(const T* p) {
    if constexpr (same_t<T, float>::v) { return pack8(*(const f32x4*)p, *(const f32x4*)(p + 4)); }
    else { return *reinterpret_cast<const bf16x8*>(p); }
}
__device__ __forceinline__ void mask_tile(f32x16& p0, f32x16& p1, int dq, unsigned W) {
    const float NEG = -__builtin_inff();
#pragma unroll
    for (int r = 0; r < 16; ++r) {
        const int c = (r & 3) + 8 * (r >> 2);
        if ((unsigned)(dq - c) >= W) p0[r] = NEG;
        if ((unsigned)(dq - c - 32) >= W) p1[r] = NEG;
    }
}
__device__ __forceinline__ void partialSM(f32x16& p0, f32x16& p1, float& m_reg, float& mn, float& alpha) {
    float pmax = p0[0]; for (int r = 1; r < 16; ++r) pmax = fmaxf(pmax, p0[r]); for (int r = 0; r < 16; ++r) pmax = fmaxf(pmax, p1[r]);
    { auto rr = __builtin_amdgcn_permlane32_swap(__float_as_uint(pmax), __float_as_uint(pmax), false, false);
      pmax = fmaxf(__uint_as_float(rr[0]), __uint_as_float(rr[1])); }
    constexpr float C2 = 1.4426950408889634f * SCALE;
    if (__builtin_expect(__all((pmax - m_reg) * SCALE <= THR), 1)) { mn = m_reg; alpha = 1.f; }
    else { mn = fmaxf(m_reg, pmax); alpha = __builtin_amdgcn_exp2f((m_reg - mn) * C2); m_reg = mn; }
    const float mnL = -mn * C2;
    for (int r = 0; r < 16; ++r) p0[r] = fmaf(p0[r], C2, mnL); for (int r = 0; r < 16; ++r) p1[r] = fmaf(p1[r], C2, mnL);
    for (int r = 0; r < 16; ++r) p0[r] = __builtin_amdgcn_exp2f(p0[r]);
}
__device__ __forceinline__ void finishSM(f32x16& p0, f32x16& p1, float alpha, float& l_reg, bf16x8& pa0, bf16x8& pa1, bf16x8& pa2, bf16x8& pa3) {
    for (int r = 0; r < 16; ++r) p1[r] = __builtin_amdgcn_exp2f(p1[r]);
    float ps = 0; for (int r = 0; r < 16; ++r) ps += p0[r]; for (int r = 0; r < 16; ++r) ps += p1[r];
    { auto rr = __builtin_amdgcn_permlane32_swap(__float_as_uint(ps), __float_as_uint(ps), false, false);
      ps = __uint_as_float(rr[0]) + __uint_as_float(rr[1]); }
    l_reg = l_reg * alpha + ps;
#define PK4(P, B_, OUT) do { unsigned a0 = cvtpk(P[B_+0], P[B_+1]), a1 = cvtpk(P[B_+2], P[B_+3]);                          \
        unsigned b0 = cvtpk(P[B_+4], P[B_+5]), b1 = cvtpk(P[B_+6], P[B_+7]);                                             \
        auto r0 = __builtin_amdgcn_permlane32_swap(a0, b0, false, false); auto r1 = __builtin_amdgcn_permlane32_swap(a1, b1, false, false); \
        u32x4 w = {r0[0], r1[0], r0[1], r1[1]}; OUT = *reinterpret_cast<bf16x8*>(&w); } while (0)
    PK4(p0, 0, pa0); PK4(p0, 8, pa1); PK4(p1, 0, pa2); PK4(p1, 8, pa3);
#undef PK4
}
template <int KB, bool SK>
__device__ __forceinline__ void qkt(f32x16& p0, f32x16& p1, const char* K_lds, int r32, int hi, const bf16x8* qr, bool act) {
    if (SK && !act) { const float NEG = -__builtin_inff();
#pragma unroll
        for (int r = 0; r < 16; ++r) { p0[r] = NEG; p1[r] = NEG; } return; }
    p0 = f32x16{}; p1 = f32x16{};
    const char* kb[4];
#pragma unroll
    for (int dd = 0; dd < 4; ++dd) kb[dd] = K_lds + KB * SHM_K + KSWZ(r32, (dd * 16 + hi * 8) * 2);
#pragma unroll
    for (int d0 = 0; d0 < 8; ++d0) { const char* a = kb[d0 & 3] + (d0 >> 2) * 128;
        bf16x8 b0 = *reinterpret_cast<const bf16x8*>(a);
        bf16x8 b1 = *reinterpret_cast<const bf16x8*>(a + 32 * 256);
        p0 = __builtin_amdgcn_mfma_f32_32x32x16_bf16(b0, qr[d0], p0, 0, 0, 0);
        p1 = __builtin_amdgcn_mfma_f32_32x32x16_bf16(b1, qr[d0], p1, 0, 0, 0); }
}
template <int VB, bool SK>
__device__ __forceinline__ void pv_tile(f32x16* o, int vb0, bf16x8 pa0, bf16x8 pa1, bf16x8 pa2, bf16x8 pa3, bool act) {
    if (SK && !act) return;
#define TRRD(dst, off) asm volatile("ds_read_b64_tr_b16 %0, %1 offset:%2" : "=&v"(dst) : "v"(vb0), "i"(off) : "memory")
#define PV_D0(d0) do { s16x4 l0, l1, l2, l3, h0, h1, h2, h3; constexpr int b_ = VB * SHM_V + v_rd_off(d0, 0, 0);     \
        TRRD(l0, b_); TRRD(h0, b_ + 2048); TRRD(l1, b_ + 4096); TRRD(h1, b_ + 6144); TRRD(l2, b_ + 8192); TRRD(h2, b_ + 10240); TRRD(l3, b_ + 12288); TRRD(h3, b_ + 14336); \
        asm volatile("s_waitcnt lgkmcnt(0)" ::: "memory"); SBAR();                 \
        o[d0] = __builtin_amdgcn_mfma_f32_32x32x16_bf16(pa0, (bf16x8){l0[0], l0[1], l0[2], l0[3], h0[0], h0[1], h0[2], h0[3]}, o[d0], 0, 0, 0);   \
        o[d0] = __builtin_amdgcn_mfma_f32_32x32x16_bf16(pa1, (bf16x8){l1[0], l1[1], l1[2], l1[3], h1[0], h1[1], h1[2], h1[3]}, o[d0], 0, 0, 0);   \
        o[d0] = __builtin_amdgcn_mfma_f32_32x32x16_bf16(pa2, (bf16x8){l2[0], l2[1], l2[2], l2[3], h2[0], h2[1], h2[2], h2[3]}, o[d0], 0, 0, 0);   \
        o[d0] = __builtin_amdgcn_mfma_f32_32x32x16_bf16(pa3, (bf16x8){l3[0], l3[1], l3[2], l3[3], h3[0], h3[1], h3[2], h3[3]}, o[d0], 0, 0, 0); } while (0)
    PV_D0(0); PV_D0(1); PV_D0(2); PV_D0(3);
#undef PV_D0
#undef TRRD
}

template <class TIn, class TOut> struct BlockRef { const TIn* Q; const TIn* K; const TIn* V; TOut* O; int P0; const unsigned short* GA; const float* KM; int qb; };
template <class TIn> struct Seam {
    bf16x8 qr[8];
    bf16x8 st_v0, st_v1, st_k0, st_k1; f32x4 sf0, sf1, sf2, sf3;
    f32x4 tq[16];
};
__device__ __forceinline__ int swa_jlo(int P0, int W) { const int lowk = P0 - W + 1; return lowk > 0 ? lowk / KVBLK : 0; }
#define ROW(p, k0, rr) ((p) + (size_t)((k0) + (rr)) * D + sc)
#define VMW() asm volatile("s_waitcnt vmcnt(0)" ::: "memory")
#define VMWN(n) asm volatile("s_waitcnt vmcnt(%0)" :: "i"(n) : "memory")
#define SLOAD_H(Kp, Vp, k0) do { S.st_v0 = load8<TIn>(ROW(Vp, k0, sr)); S.st_v1 = load8<TIn>(ROW(Vp, k0, 32 + sr));              \
                         S.st_k0 = load8<TIn>(ROW(Kp, k0, sr)); S.st_k1 = load8<TIn>(ROW(Kp, k0, 32 + sr)); } while (0)
#define SWRITE_HK(bf) do { *(bf16x8*)(K_lds + (bf) * SHM_K + kws) = S.st_k0; *(bf16x8*)(K_lds + (bf) * SHM_K + kws + 32 * 256) = S.st_k1; } while (0)
#define SWRITE_HV(bf) do { *(bf16x8*)(V_lds + (bf) * SHM_V + vst0) = S.st_v0; *(bf16x8*)(V_lds + (bf) * SHM_V + vst1) = S.st_v1; } while (0)
#define SWRITE_H(bf) do { SWRITE_HV(bf); SWRITE_HK(bf); } while (0)
#define SLOAD_F(p, k0) do { S.sf0 = *(const f32x4*)ROW(p, k0, sr); S.sf1 = *(const f32x4*)(ROW(p, k0, sr) + 4);                \
                            S.sf2 = *(const f32x4*)ROW(p, k0, 32 + sr); S.sf3 = *(const f32x4*)(ROW(p, k0, 32 + sr) + 4); } while (0)
#define SWRITE_KF(bf) do { *(bf16x8*)(K_lds + (bf) * SHM_K + kws) = pack8(S.sf0, S.sf1); *(bf16x8*)(K_lds + (bf) * SHM_K + kws + 32 * 256) = pack8(S.sf2, S.sf3); } while (0)
#define SWRITE_VF(bf) do { *(bf16x8*)(V_lds + (bf) * SHM_V + vst0) = pack8(S.sf0, S.sf1); *(bf16x8*)(V_lds + (bf) * SHM_V + vst1) = pack8(S.sf2, S.sf3); } while (0)
template <class TIn, class TOut>
__device__ __forceinline__ void causal_swa_prime(const BlockRef<TIn, TOut>& cur, int W, char* lds, Seam<TIn>& S) {
    constexpr bool F32 = same_t<TIn, float>::v;
    int tid_ = threadIdx.x; asm volatile("" : "+v"(tid_)); const int tid = tid_, wid = __builtin_amdgcn_readfirstlane(tid >> 6), lane = tid & 63, r32 = lane & 31, hi = lane >> 5;
    const int sr = tid >> 4, sc = (tid & 15) * 8, kws = KSWZ(sr, sc * 2); char* K_lds = lds + 2 * SHM_V;
    const int kb0 = swa_jlo(cur.P0, W) * KVBLK;
    for (int d0 = 0; d0 < 8; ++d0) S.qr[d0] = load8<TIn>(cur.Q + (size_t)(wid * QBLK + r32) * D + d0 * 16 + hi * 8);
    if constexpr (F32) { SLOAD_F((const float*)cur.K, kb0); VMW(); SWRITE_KF(0); SBAR(); SLOAD_F((const float*)cur.V, kb0); }
    else { SLOAD_H(cur.K, cur.V, kb0); VMW(); SWRITE_HK(0); }
    __syncthreads();
}
template <class TIn, class TOut>
__device__ __forceinline__ void causal_swa_block(const BlockRef<TIn, TOut>& cur, const BlockRef<TIn, TOut>& nxt, int skv, int W, char* lds, Seam<TIn>& S) {
    constexpr bool F32 = same_t<TIn, float>::v;
    int tid_ = threadIdx.x; asm volatile("" : "+v"(tid_)); const int tid = tid_, wid = __builtin_amdgcn_readfirstlane(tid >> 6), lane = tid & 63, r32 = lane & 31, hi = lane >> 5;
    const int j_lo = swa_jlo(cur.P0, W);
    int j_hi = (cur.P0 + QB - 1) / KVBLK + 1; if (j_hi > skv / KVBLK) j_hi = skv / KVBLK;
    const int NT = j_hi - j_lo;
    const int kbn = swa_jlo(nxt.P0, W) * KVBLK;
    const int qlo = cur.P0 + wid * QBLK, qm = qlo + r32 - 4 * hi;
    char* V_lds = lds; char* K_lds = lds + 2 * SHM_V;
    float* ws = (float*)(lds + 2 * SHM_V + 2 * SHM_K) + wid * 64; float* li_l = ws, * al_l = ws + 32;
    float m_reg = -1e30f, l_reg = 0; f32x16 o[4] = {};
    const int sr = tid >> 4, sc = (tid & 15) * 8, vst0 = v_st(sr, sc), vst1 = v_st(32 + sr, sc), kws = KSWZ(sr, sc * 2);
    const int vb0 = (int)(uintptr_t)V_lds + v_rd_base(lane);
    const TIn* Kh = cur.K; const TIn* Vh = cur.V;
    unsigned selmask = 0xffu; const bool moba = cur.qb >= 4;
    {
        float* kml = (float*)(lds + KM_OFF);
        for (int idx = tid; idx < 8 * 128; idx += 64 * NW) { const int n_ = idx >> 7, d_ = idx & 127; kml[idx] = (cur.KM[(size_t)n_ * 2048 + d_] + cur.KM[(size_t)n_ * 2048 + 1024 + d_]) * (1.0f / 256.0f); }
        __syncthreads();
        if (moba) {
            float g[7];
#pragma unroll
            for (int n_ = 0; n_ < 7; ++n_) { float s = 0.f;
                if (n_ < cur.qb) {
#pragma unroll
                    for (int d0 = 0; d0 < 8; ++d0) { const f32x4 k0 = *(const f32x4*)(kml + n_ * 128 + d0 * 16 + hi * 8), k1 = *(const f32x4*)(kml + n_ * 128 + d0 * 16 + hi * 8 + 4);
                        const bf16x8 qv = S.qr[d0];
#define B2F_(x) __uint_as_float(((unsigned)(unsigned short)(x)) << 16)
                        s += (B2F_(qv[0]) * k0[0] + B2F_(qv[1]) * k0[1]) + (B2F_(qv[2]) * k0[2] + B2F_(qv[3]) * k0[3]) + (B2F_(qv[4]) * k1[0] + B2F_(qv[5]) * k1[1]) + (B2F_(qv[6]) * k1[2] + B2F_(qv[7]) * k1[3]);
#undef B2F_
                    } }
                g[n_] = s + __shfl_xor(s, 32); }
            selmask = 0u;
#pragma unroll
            for (int rd = 0; rd < 3; ++rd) { float best = -__builtin_inff(); unsigned bi = 0u;
#pragma unroll
                for (int n_ = 0; n_ < 7; ++n_) { const bool ok = (n_ < cur.qb) && (((selmask >> n_) & 1u) == 0u) && (g[n_] > best); best = ok ? g[n_] : best; bi = ok ? (unsigned)n_ : bi; }
                selmask |= 1u << bi; }
        }
    }
#define RESC(a) do { if (__any((a) < 1.f)) { if (hi == 0) al_l[r32] = (a); asm volatile("s_waitcnt lgkmcnt(0)" ::: "memory");              \
                     for (int d_ = 0; d_ < 4; ++d_) for (int r = 0; r < 16; ++r) o[d_][r] *= al_l[crow(r, hi)]; } } while (0)
#define KBASE(t) ((j_lo + (t)) * KVBLK)
#define ACT(t) (KBASE(t) <= qlo + QBLK - 1 && KBASE(t) + KVBLK - 1 >= qlo - W + 1)
#define MASKT(P0_, P1_, t) do { const int kb_ = KBASE(t); if ((!SK || ACT(t)) && (kb_ + KVBLK - 1 > qlo || kb_ <= qlo + QBLK - 1 - W)) mask_tile(P0_, P1_, qm - kb_, (unsigned)W); \
        if (MOBA_ON && moba && kb_ < cur.P0) { const bool dead_ = ((selmask >> (kb_ >> 8)) & 1u) == 0u; const float NEG_ = -__builtin_inff(); \
            _Pragma("unroll") for (int r_ = 0; r_ < 16; ++r_) { P0_[r_] = dead_ ? NEG_ : P0_[r_]; P1_[r_] = dead_ ? NEG_ : P1_[r_]; } } } while (0)
    constexpr int NQL = F32 ? 16 : 8;
    constexpr bool SK = WSKIP && !F32;
#define SEAM_K0() do { VMWN(NQL); if constexpr (F32) { SWRITE_KF(0); SBAR(); SLOAD_F((const float*)nxt.V, kbn); } else { SWRITE_HK(0); } SBAR(); } while (0)
    f32x16 pA0, pA1, pB0, pB1; float mnA, mnB, alA, alB; bf16x8 pa0, pa1, pa2, pa3;
    if constexpr (F32) { VMW(); SWRITE_VF(0); SBAR(); } else { SWRITE_HV(0); SBAR(); }
    if (NT > 1) { if constexpr (F32) SLOAD_F((const float*)Kh, KBASE(1)); else SLOAD_H(Kh, Vh, KBASE(1)); }
    SBAR(); qkt<0, SK>(pA0, pA1, K_lds, r32, hi, S.qr, ACT(0));
    if constexpr (F32) { if (NT > 1) { VMW(); SWRITE_KF(1); SBAR(); SLOAD_F((const float*)Vh, KBASE(1)); } }
    MASKT(pA0, pA1, 0); partialSM(pA0, pA1, m_reg, mnA, alA);
    if (NT > 1) { VMW(); if constexpr (F32) { SWRITE_VF(1); SBAR(); if (NT > 2) SLOAD_F((const float*)Kh, KBASE(2)); } else SWRITE_H(1); }
    __syncthreads();
#define HALF_STEP(PX0, PX1, mnX, alX, PY0, PY1, alY, t, KB, VB, SB) do {                                                      \
        SBAR(); qkt<KB, SK>(PX0, PX1, K_lds, r32, hi, S.qr, ACT(t));                                             \
        finishSM(PY0, PY1, alY, l_reg, pa0, pa1, pa2, pa3); SBAR();                                                           \
        if ((t) + 1 < NT) { if constexpr (F32) { VMW(); SWRITE_KF(SB); SBAR(); SLOAD_F((const float*)Vh, KBASE((t) + 1)); }  \
                            else { SLOAD_H(Kh, Vh, KBASE((t) + 1)); } SBAR(); }                                               \
        pv_tile<VB, SK>(o, vb0, pa0, pa1, pa2, pa3, ACT((t) - 1)); MASKT(PX0, PX1, (t)); partialSM(PX0, PX1, m_reg, mnX, alX);                                        \
        __syncthreads();                                                                                                      \
        if ((t) + 1 < NT) { VMW(); if constexpr (F32) { SWRITE_VF(SB); SBAR(); if ((t) + 2 < NT) SLOAD_F((const float*)Kh, KBASE((t) + 2)); } \
                            else { SWRITE_H(SB); } }                                                                          \
        RESC(alX); __syncthreads(); } while (0)
    for (int t = 1; t + 1 < NT; t += 2) {
        HALF_STEP(pB0, pB1, mnB, alB, pA0, pA1, alA, t, 1, 0, 0);
        HALF_STEP(pA0, pA1, mnA, alA, pB0, pB1, alB, t + 1, 0, 1, 1);
    }
    const bool even = (NT & 1) == 0;
    if (even) { SBAR(); qkt<1, SK>(pB0, pB1, K_lds, r32, hi, S.qr, ACT(NT - 1)); SBAR(); }
#define QROW(e) (nxt.Q + (size_t)(wid * QBLK + r32) * D + ((e) >> 1) * 16 + hi * 8 + ((e) & 1) * 4)
    if constexpr (F32) { SLOAD_F((const float*)nxt.K, kbn); SBAR();
#pragma unroll
        for (int e = 0; e < 8; ++e) S.tq[e] = *(const f32x4*)QROW(e); }
    else { SLOAD_H(nxt.K, nxt.V, kbn); SBAR();
#pragma unroll
        for (int d0 = 0; d0 < 8; ++d0) S.qr[d0] = load8<TIn>(nxt.Q + (size_t)(wid * QBLK + r32) * D + d0 * 16 + hi * 8); }
    SBAR();
    finishSM(pA0, pA1, alA, l_reg, pa0, pa1, pa2, pa3); SBAR();
    if constexpr (F32) {
#pragma unroll
        for (int e = 8; e < 16; ++e) S.tq[e] = *(const f32x4*)QROW(e); SBAR(); }
#undef QROW
    pv_tile<0, SK>(o, vb0, pa0, pa1, pa2, pa3, ACT(even ? NT - 2 : NT - 1));
    if (even) { MASKT(pB0, pB1, NT - 1); partialSM(pB0, pB1, m_reg, mnB, alB); __syncthreads(); RESC(alB);
        finishSM(pB0, pB1, alB, l_reg, pa0, pa1, pa2, pa3); SBAR(); pv_tile<1, SK>(o, vb0, pa0, pa1, pa2, pa3, ACT(NT - 1)); }
    SBAR(); SEAM_K0();
    if (hi == 0) li_l[r32] = l_reg; asm volatile("s_waitcnt lgkmcnt(0)" ::: "memory");
    float rli[16];
#pragma unroll
    for (int r = 0; r < 16; ++r) rli[r] = __builtin_amdgcn_rcpf(li_l[crow(r, hi)]);
    { unsigned short* stg = (unsigned short*)(lds + STG_OFF) + wid * 4096;
#pragma unroll
      for (int r = 0; r < 16; ++r) { const int orow = crow(r, hi);
#pragma unroll
        for (int d0 = 0; d0 < 4; ++d0) { const float v = o[d0][r] * rli[r]; stg[orow * 128 + d0 * 32 + r32] = (unsigned short)(cvtpk(v, v) & 0xffffu); } }
      asm volatile("s_waitcnt lgkmcnt(0)" ::: "memory");
      unsigned short* Ow = (unsigned short*)cur.O + (size_t)(wid * QBLK) * LDO; const unsigned short* Gw = cur.GA + (size_t)(wid * QBLK) * LDG;
#pragma unroll
      for (int i = 0; i < 8; ++i) { const int row = i * 4 + (lane >> 4), ch = lane & 15;
          const u32x4 ov = *(const u32x4*)(stg + row * 128 + ch * 8); const u32x4 gv = *(const u32x4*)(Gw + (size_t)row * LDG + ch * 8);
          u32x4 w;
#define MULPK_(a, b) cvtpk(__uint_as_float((a) << 16) * __uint_as_float((b) << 16), __uint_as_float((a) & 0xffff0000u) * __uint_as_float((b) & 0xffff0000u))
          w.x = MULPK_(ov.x, gv.x); w.y = MULPK_(ov.y, gv.y); w.z = MULPK_(ov.z, gv.z); w.w = MULPK_(ov.w, gv.w);
#undef MULPK_
          *(u32x4*)(Ow + (size_t)row * LDO + ch * 8) = w; } }
    if constexpr (F32) {
#pragma unroll
        for (int d0 = 0; d0 < 8; ++d0) S.qr[d0] = pack8(S.tq[2 * d0], S.tq[2 * d0 + 1]); }
    __syncthreads();
#undef RESC
#undef KBASE
#undef ACT
#undef MASKT
#undef SEAM_K0
#undef HALF_STEP
}
#undef ROW
#undef VMW
#undef VMWN
#undef SLOAD_H
#undef SWRITE_HK
#undef SWRITE_HV
#undef SWRITE_H
#undef SLOAD_F
#undef SWRITE_KF
#undef SWRITE_VF


typedef BlockRef<bf16, bf16> Ref;
__device__ __forceinline__ Ref make_ref(int L, const bf16* Q, const bf16* K, const bf16* V, bf16* Y, const bf16* GA, const float* KMP) {
    const int bh = L >> 3, qb = L & 7, b = bh >> 3, h = bh & 7; Ref r;
    r.Q = Q + ((size_t)bh * 2048 + (size_t)qb * QB) * D; r.K = K + (size_t)bh * 2048 * D; r.V = V + (size_t)bh * 2048 * D;
    r.O = Y + ((size_t)b * 2048 + (size_t)qb * QB) * LDO + h * 128; r.GA = (const unsigned short*)GA + ((size_t)b * 2048 + (size_t)qb * QB) * LDG + h * 128;
    r.P0 = qb * QB; r.KM = KMP + (size_t)b * 16 * 1024 + h * 128; r.qb = qb; return r;
}
__device__ __forceinline__ void phase(char* lds, const bf16* Q, const bf16* K, const bf16* V, bf16* Y, const bf16* GA, const float* KMP, int vcu, int G) {
    int L = vcu; if (L >= 256) return;
    Ref cur = make_ref(L, Q, K, V, Y, GA, KMP);
    Seam<bf16> S;
    causal_swa_prime<bf16, bf16>(cur, 2048, lds, S);
    for (;;) {
        const int Ln = L + G; const bool last = Ln >= 256;
        const Ref nxt = last ? cur : make_ref(Ln, Q, K, V, Y, GA, KMP);
        causal_swa_block<bf16, bf16>(cur, nxt, 2048, 2048, lds, S);
        if (last) break;
        cur = nxt; L = Ln;
    }
}
#undef KSWZ
#undef SBAR
}
namespace lru {
#define LRU_LAS __attribute__((address_space(3)))
typedef short bf16x8 __attribute__((ext_vector_type(8)));
typedef float f32x4 __attribute__((ext_vector_type(4)));
typedef unsigned u32x4 __attribute__((ext_vector_type(4)));
typedef unsigned u32x2 __attribute__((ext_vector_type(2)));
constexpr int CH = 128  , XCP = 272  ;
constexpr int OFF_XC = 0, OFF_A = CH * XCP, OFF_U = OFF_A + CH * 32 * 4, OFF_SA = OFF_U + CH * 32 * 4, OFF_SH = OFF_SA + 16 * 32 * 4, OFF_C0 = OFF_SH + 16 * 32 * 4, LRU_LDS = OFF_C0 + 2 * 32 * 4;
__device__ __forceinline__ float b2f(unsigned short x) { return __uint_as_float(((unsigned)x) << 16); }
__device__ __forceinline__ unsigned cvtpk(float lo, float hi) { unsigned r; asm volatile("v_cvt_pk_bf16_f32 %0, %1, %2" : "=v"(r) : "v"(lo), "v"(hi)); return r; }
struct Tensors { const unsigned short* XR; const unsigned short* GL; unsigned short* Y; const unsigned short* WrT; const unsigned short* WiT;
                 const float *cw, *cb, *br, *bi, *lam; };
__device__ __forceinline__ void unit(LRU_LAS unsigned char* lds, const Tensors& T, int b, int n, int es) {
    int tid_ = threadIdx.x; asm volatile("" : "+v"(tid_)); const int tid = tid_, lane = tid & 63, wid = __builtin_amdgcn_readfirstlane(tid >> 6), fr = lane & 15, fq = lane >> 4;
    LRU_LAS float* LA = (LRU_LAS float*)(lds + OFF_A); LRU_LAS float* LU = (LRU_LAS float*)(lds + OFF_U);
    LRU_LAS float* SA = (LRU_LAS float*)(lds + OFF_SA); LRU_LAS float* SH = (LRU_LAS float*)(lds + OFF_SH); LRU_LAS float* C0 = (LRU_LAS float*)(lds + OFF_C0);
    const int cg = tid & 15, trow = tid >> 4;
    const int chb = n * 128 + cg * 8;
    float cw[4][8], cb[8];
#pragma unroll
    for (int k = 0; k < 4; ++k) { const f32x4 a = *(const f32x4*)(T.cw + k * 1024 + chb), c = *(const f32x4*)(T.cw + k * 1024 + chb + 4);
#pragma unroll
        for (int j = 0; j < 4; ++j) { cw[k][j] = a[j]; cw[k][4 + j] = c[j]; } }
    { const f32x4 a = *(const f32x4*)(T.cb + chb), c = *(const f32x4*)(T.cb + chb + 4);
#pragma unroll
      for (int j = 0; j < 4; ++j) { cb[j] = a[j]; cb[4 + j] = c[j]; } }
    bf16x8 Br[2][4], Bi[2][4];
#pragma unroll
    for (int nb = 0; nb < 2; ++nb)
#pragma unroll
        for (int ks = 0; ks < 4; ++ks) { const size_t o = ((size_t)n * 128 + es * 32 + nb * 16 + fr) * 128 + ks * 32 + fq * 8;
            Br[nb][ks] = *(const bf16x8*)(T.WrT + o); Bi[nb][ks] = *(const bf16x8*)(T.WiT + o); }
    float gbr[2][4], gbi[2][4], gsp[2][4];
#pragma unroll
    for (int nb = 0; nb < 2; ++nb)
#pragma unroll
        for (int j = 0; j < 4; ++j) { const int ch = n * 128 + es * 32 + nb * 16 + fq * 4 + j; gbr[nb][j] = T.br[ch]; gbi[nb][j] = T.bi[ch];
            const float x = -T.lam[ch]; gsp[nb][j] = 8.0f * (fmaxf(x, 0.f) + log1pf(__expf(-fabsf(x)))); }
    if (tid < 32) C0[tid] = 0.f;
    const int se = tid & 31, sg = tid >> 5;
    const size_t rowb = (size_t)b * 2048;
    for (int c = 0; c < 2048 / CH; ++c) {
#pragma unroll
        for (int i = 0; i < 4; ++i) { const int tok = trow + 32 * i, ta = c * CH + tok;
            float acc8[8];
#pragma unroll
            for (int j = 0; j < 8; ++j) acc8[j] = cb[j];
#pragma unroll
            for (int k = 0; k < 4; ++k) { const int tt = ta - 3 + k;
                u32x4 w = (u32x4){0u, 0u, 0u, 0u};
                if (tt >= 0) w = *(const u32x4*)(T.XR + (rowb + tt) * 1024 + chb);
                acc8[0] += cw[k][0] * __uint_as_float(w.x << 16); acc8[1] += cw[k][1] * __uint_as_float(w.x & 0xffff0000u);
                acc8[2] += cw[k][2] * __uint_as_float(w.y << 16); acc8[3] += cw[k][3] * __uint_as_float(w.y & 0xffff0000u);
                acc8[4] += cw[k][4] * __uint_as_float(w.z << 16); acc8[5] += cw[k][5] * __uint_as_float(w.z & 0xffff0000u);
                acc8[6] += cw[k][6] * __uint_as_float(w.w << 16); acc8[7] += cw[k][7] * __uint_as_float(w.w & 0xffff0000u); }
            u32x4 o; o.x = cvtpk(acc8[0], acc8[1]); o.y = cvtpk(acc8[2], acc8[3]); o.z = cvtpk(acc8[4], acc8[5]); o.w = cvtpk(acc8[6], acc8[7]);
            *(LRU_LAS u32x4*)(lds + OFF_XC + tok * XCP + cg * 16) = o; }
        __syncthreads();
        {
            f32x4 ar[2], ai_[2];
#pragma unroll
            for (int nb = 0; nb < 2; ++nb) { ar[nb] = (f32x4){0.f, 0.f, 0.f, 0.f}; ai_[nb] = (f32x4){0.f, 0.f, 0.f, 0.f}; }
            const int tok = 16 * wid + fr;
#pragma unroll
            for (int ks = 0; ks < 4; ++ks) { const bf16x8 af = *(const LRU_LAS bf16x8*)(lds + OFF_XC + tok * XCP + (ks * 32 + fq * 8) * 2);
#pragma unroll
                for (int nb = 0; nb < 2; ++nb) { ar[nb] = __builtin_amdgcn_mfma_f32_16x16x32_bf16(Br[nb][ks], af, ar[nb], 0, 0, 0);
                                                 ai_[nb] = __builtin_amdgcn_mfma_f32_16x16x32_bf16(Bi[nb][ks], af, ai_[nb], 0, 0, 0); } }
#pragma unroll
            for (int nb = 0; nb < 2; ++nb) {
                const u32x2 xw = *(const LRU_LAS u32x2*)(lds + OFF_XC + tok * XCP + (es * 32 + nb * 16 + fq * 4) * 2);
                const float xv[4] = {__uint_as_float(xw.x << 16), __uint_as_float(xw.x & 0xffff0000u), __uint_as_float(xw.y << 16), __uint_as_float(xw.y & 0xffff0000u)};
                f32x4 av, uv;
#pragma unroll
                for (int j = 0; j < 4; ++j) {
                    const float r = __builtin_amdgcn_rcpf(1.0f + __expf(-(ar[nb][j] + gbr[nb][j])));
                    const float ig = __builtin_amdgcn_rcpf(1.0f + __expf(-(ai_[nb][j] + gbi[nb][j])));
                    const float la = -r * gsp[nb][j];
                    av[j] = __expf(la);
                    uv[j] = sqrtf(-expm1f(2.0f * la)) * (ig * xv[j]);
                }
                *(LRU_LAS f32x4*)(LA + tok * 32 + nb * 16 + fq * 4) = av; *(LRU_LAS f32x4*)(LU + tok * 32 + nb * 16 + fq * 4) = uv;
            }
        }
        __syncthreads();
        float a8[8], u8[8];
        { float A = 1.f, Hh = 0.f;
#pragma unroll
          for (int j = 0; j < 8; ++j) { a8[j] = LA[(sg * 8 + j) * 32 + se]; u8[j] = LU[(sg * 8 + j) * 32 + se]; Hh = a8[j] * Hh + u8[j]; A *= a8[j]; }
          SA[sg * 32 + se] = A; SH[sg * 32 + se] = Hh; }
        __syncthreads();
        { float h = C0[(c & 1) * 32 + se];
          for (int s2 = 0; s2 < sg; ++s2) h = SA[s2 * 32 + se] * h + SH[s2 * 32 + se];
          const size_t chn = (size_t)n * 128 + es * 32 + se;
#pragma unroll
          for (int j = 0; j < 8; ++j) { h = a8[j] * h + u8[j]; const size_t row = rowb + c * CH + sg * 8 + j;
              const float gl = b2f(T.GL[row * 1024 + chn]);
              const float y = h * gl; const float yn = __shfl_xor(y, 1);
              if ((se & 1) == 0) *(unsigned*)(T.Y + row * 2048 + 1024 + chn) = cvtpk(y, yn); }
          if (sg == 15) C0[((c + 1) & 1) * 32 + se] = h; }
    }
    __syncthreads();
}
}

namespace cg = cooperative_groups;
constexpr int NWAVES = 8;
constexpr int BATCH = 4, SEQ = 2048, DM = 2048, M = BATCH * SEQ, DIN = 10240, AW = 1024, LW = 1024, PLE = 256, NH = 8, HD = 128;
constexpr size_t MiB = 1u << 20;
constexpr size_t WS_KMP = 0, WS_SSQ = 1 * MiB, WS_WRT = 2 * MiB, WS_WIT = 2 * MiB + 256 * 1024, WS_WPLE = 3 * MiB, WS_W2 = 4 * MiB, WS_WOUT = 12 * MiB, WS_WG = 20 * MiB, WS_WIN = 28 * MiB,
                 WS_H = 68 * MiB, WS_MG = 68 * MiB, WS_PB = 100 * MiB, WS_Q = 104 * MiB, WS_K = 120 * MiB, WS_V = 136 * MiB, WS_GA = 152 * MiB, WS_XR = 168 * MiB, WS_GL = 184 * MiB,
                 WS_SA = 200 * MiB, WS_SL = 232 * MiB, WS_Y = 264 * MiB, WS_X1G = 104 * MiB, WS_PL = 136 * MiB, WS_END = 296 * MiB;
static_assert(WS_K == WS_Q + 16 * MiB && WS_V == WS_Q + 32 * MiB && WS_GA == WS_Q + 48 * MiB && WS_XR == WS_Q + 64 * MiB && WS_GL == WS_Q + 80 * MiB && WS_SA == WS_Q + 96 * MiB && WS_SL == WS_SA + 32 * MiB, "EpiG1 destination arithmetic");
constexpr int RING_BYTES = 131072, SCR_OFF = RING_BYTES, KM_LDS_OFF = 69632;
constexpr int LDS_BYTES = 147456;
static_assert(attn::STG_OFF + 65536 <= LDS_BYTES && attn::KM_OFF == KM_LDS_OFF && attn::KM_OFF + 4096 <= attn::STG_OFF, "attention LDS map");
static_assert(attn::LDS_BYTES <= KM_LDS_OFF && KM_LDS_OFF + 4096 <= RING_BYTES && lru::LRU_LDS <= RING_BYTES && SCR_OFF + 8192 <= LDS_BYTES, "LDS map");

#define GAS __attribute__((address_space(1)))
#define LAS __attribute__((address_space(3)))
typedef unsigned short bf16;
typedef unsigned v4u __attribute__((ext_vector_type(4)));
typedef float f32x4 __attribute__((ext_vector_type(4)));
#define LDS_WAIT() asm volatile("s_waitcnt lgkmcnt(0)" ::: "memory")
__device__ __forceinline__ unsigned f2bf(float f) { unsigned u = __builtin_bit_cast(unsigned, f); return (u + 0x7fffu + ((u >> 16) & 1u)) >> 16; }
__device__ __forceinline__ unsigned pk2(float lo, float hi) { return f2bf(lo) | (f2bf(hi) << 16); }
__device__ __forceinline__ float wave_sum(float v) {
#pragma unroll
    for (int o = 1; o < 64; o <<= 1) v += __shfl_xor(v, o);
    return v;
}
__device__ __forceinline__ void p0_transpose_item(const float* W, int N, bf16* WT, int ldk, int row_off, int k_off, LAS float* scr, int kb, int nb, int lane) {
    const int k0 = 64 * kb, n0 = 32 * nb;
#pragma unroll 8
    for (int i = 0; i < 32; ++i) { const int kk = 2 * i + (lane >> 5); scr[kk * 33 + (lane & 31)] = W[(size_t)(k0 + kk) * N + n0 + (lane & 31)]; }
    LDS_WAIT(); asm volatile("" ::: "memory");
    const int c = lane & 7;
#pragma unroll
    for (int j = 0; j < 4; ++j) { const int n = (lane >> 3) + 8 * j; const LAS float* s = scr + (8 * c) * 33 + n;
        v4u o; o.x = pk2(s[0 * 33], s[1 * 33]); o.y = pk2(s[2 * 33], s[3 * 33]); o.z = pk2(s[4 * 33], s[5 * 33]); o.w = pk2(s[6 * 33], s[7 * 33]);
        *(GAS v4u*)(WT + (size_t)(row_off + n0 + n) * ldk + k_off + k0 + 8 * c) = o; }
    LDS_WAIT(); asm volatile("" ::: "memory");
}

struct Args { const float* in[20]; float* out; unsigned char* ws; };

__global__ void __launch_bounds__(NWAVES * 64, 2) moba_rglru_fwd(Args args) {
    extern __shared__ __attribute__((aligned(16))) unsigned char lds[];
    cg::grid_group grid = cg::this_grid();
    LAS unsigned char* ldsl = (LAS unsigned char*)lds;
    const int tid = threadIdx.x, lane = tid & 63, wave = __builtin_amdgcn_readfirstlane(tid >> 6);
    const int G = gridDim.x; const int bx = blockIdx.x; const int vcu = (G % 8 == 0) ? (bx % 8) * (G / 8) + bx / 8 : bx;
    unsigned char* ws = args.ws;
    bf16* Win_t = (bf16*)(ws + WS_WIN); bf16* W2_t = (bf16*)(ws + WS_W2); bf16* Wout_t = (bf16*)(ws + WS_WOUT); bf16* Wg_t = (bf16*)(ws + WS_WG); bf16* Wple_t = (bf16*)(ws + WS_WPLE);
    bf16* Wr_t = (bf16*)(ws + WS_WRT); bf16* Wi_t = (bf16*)(ws + WS_WIT);
    bf16* Hb = (bf16*)(ws + WS_H); bf16* MG = (bf16*)(ws + WS_MG); bf16* PB = (bf16*)(ws + WS_PB);
    bf16* Qb = (bf16*)(ws + WS_Q); bf16* Kb = (bf16*)(ws + WS_K); bf16* Vb = (bf16*)(ws + WS_V); bf16* GA = (bf16*)(ws + WS_GA); bf16* XR = (bf16*)(ws + WS_XR); bf16* GL = (bf16*)(ws + WS_GL);
    bf16* SAb = (bf16*)(ws + WS_SA); bf16* SLb = (bf16*)(ws + WS_SL); bf16* Yb = (bf16*)(ws + WS_Y); bf16* X1G = (bf16*)(ws + WS_X1G); bf16* PL = (bf16*)(ws + WS_PL);
    float* KMP = (float*)(ws + WS_KMP); float* SSQ = (float*)(ws + WS_SSQ);

#ifndef SKIP_P0
    {
        LAS float* scr = (LAS float*)(ldsl + wave * 16384);
        const int gw = vcu * NWAVES + wave, NGW = G * NWAVES;
        constexpr int I0 = 32 * 320, I1 = 16 * 64, I2 = 16 * 64, I3 = 32 * 64, I4 = 32 * 64, I5 = 4 * 64, I6 = 64, I7 = 64;
        constexpr int NITEMS = I0 + I1 + I2 + I3 + I4 + I5 + I6 + I7;
        for (int it = gw; it < NITEMS; it += NGW) {
            int r = it;
            if (r < I0) { p0_transpose_item(args.in[3], DIN, Win_t, 2048, 0, 0, scr, r / 320, r % 320, lane); continue; } r -= I0;
            if (r < I1) { p0_transpose_item(args.in[13], DM, W2_t, 2048, 0, 0, scr, r / 64, r % 64, lane); continue; } r -= I1;
            if (r < I2) { p0_transpose_item(args.in[14], DM, W2_t, 2048, 0, 1024, scr, r / 64, r % 64, lane); continue; } r -= I2;
            if (r < I3) { p0_transpose_item(args.in[15], DM, Wout_t, 2048, 0, 0, scr, r / 64, r % 64, lane); continue; } r -= I3;
            if (r < I4) { p0_transpose_item(args.in[17], DM, Wg_t, 2048, 0, 0, scr, r / 64, r % 64, lane); continue; } r -= I4;
            if (r < I5) { p0_transpose_item(args.in[19], DM, Wple_t, 256, 0, 0, scr, r / 64, r % 64, lane); continue; } r -= I5;
            if (r < I6) { const int n = r >> 3, s = r & 7; p0_transpose_item(args.in[8] + (size_t)n * 16384, 128, Wr_t, 128, n * 128, 0, scr, s >> 2, s & 3, lane); continue; } r -= I6;
            { const int n = r >> 3, s = r & 7; p0_transpose_item(args.in[10] + (size_t)n * 16384, 128, Wi_t, 128, n * 128, 0, scr, s >> 2, s & 3, lane); }
        }
        const float* x = args.in[0]; const float* ng = args.in[2];
        for (int m = gw; m < M; m += NGW) {
            const GAS f32x4* xr = (const GAS f32x4*)(x + (size_t)m * DM) + lane; const GAS f32x4* gr = (const GAS f32x4*)ng + lane;
            f32x4 v[8]; float s = 0.f;
#pragma unroll
            for (int j = 0; j < 8; ++j) { v[j] = xr[64 * j]; s += (v[j].x * v[j].x + v[j].y * v[j].y) + (v[j].z * v[j].z + v[j].w * v[j].w); }
            const float rstd = 1.0f / sqrtf(wave_sum(s) * (1.0f / DM) + 1e-6f);
            GAS unsigned long long* o8 = (GAS unsigned long long*)(Hb + (size_t)m * DM) + lane;
#pragma unroll
            for (int j = 0; j < 8; ++j) { const f32x4 g = gr[64 * j];
                o8[64 * j] = (unsigned long long)pk2(v[j].x * rstd * g.x, v[j].y * rstd * g.y) | ((unsigned long long)pk2(v[j].z * rstd * g.z, v[j].w * rstd * g.w) << 32); }
        }
        const float* p = args.in[1];
        for (int m = gw; m < M; m += NGW) {
            const f32x4 v = ((const GAS f32x4*)(p + (size_t)m * PLE))[lane];
            ((GAS unsigned long long*)(PB + (size_t)m * PLE))[lane] = (unsigned long long)pk2(v.x, v.y) | ((unsigned long long)pk2(v.z, v.w) << 32);
        }
    }
#endif
    grid.sync();

#ifndef SKIP_P1
    {
        pg8::Gemm g{Hb, Win_t, M, DIN, DM}; pg8::StaticOrder S; S.init(M, DIN, G, bx);
        pg8::EpiG1 E{ws + WS_Q, KMP, args.in[4], args.in[5], (LAS float*)(ldsl + SCR_OFF), 0};
        pg8::gemm_phase<pg8::EpiG1, pg8::StaticOrder, true, true>(ldsl, g, S, E);
    }
#endif
    grid.sync();

#ifndef SKIP_P2
    {
#ifndef SKIP_LRU
        for (int L = vcu; L < 256; L += G) {
            if ((L & 7) < 4) { const int idx = (L >> 3) * 4 + (L & 7);
                lru::Tensors T{XR, GL, Yb, Wr_t, Wi_t, args.in[6], args.in[7], args.in[9], args.in[11], args.in[12]};
                lru::unit(ldsl, T, idx >> 5, (idx >> 2) & 7, idx & 3); }
        }
#endif
#ifndef SKIP_ATTN
        attn::phase((char*)lds, (const attn::bf16*)Qb, (const attn::bf16*)Kb, (const attn::bf16*)Vb, (attn::bf16*)Yb, (const attn::bf16*)GA, KMP, vcu, G);
#endif
    }
#endif
    grid.sync();

#ifndef SKIP_P3
    {
        pg8::Gemm g{Yb, W2_t, M, DM, DM}; pg8::StaticOrder S; S.init(M, DM, G, bx);
        pg8::EpiG2 E{SAb, SLb, MG, 16};
        pg8::gemm_phase<pg8::EpiG2, pg8::StaticOrder, true, true>(ldsl, g, S, E);
    }
#endif
    grid.sync();

#ifndef SKIP_P4
    {
        pg8::Gemm g{MG, Wout_t, M, DM, DM}; pg8::StaticOrder S; S.init(M, DM, G, bx);
        pg8::EpiG3 E{args.in[0], args.out, X1G, SSQ, args.in[16], 0};
        pg8::gemm_phase<pg8::EpiG3, pg8::StaticOrder, true, true>(ldsl, g, S, E);
    }
#endif
    grid.sync();

#ifndef SKIP_P5
    {
        { pg8::Gemm g{PB, Wple_t, M, DM, PLE}; pg8::StaticOrder S; S.init(M, DM, G, bx);
          pg8::EpiG4a E{PL, 0};
          pg8::gemm_phase<pg8::EpiG4a, pg8::StaticOrder, true, true>(ldsl, g, S, E); }
        asm volatile("s_waitcnt vmcnt(0)" ::: "memory"); __syncthreads();
        { pg8::Gemm g{X1G, Wg_t, M, DM, DM}; pg8::StaticOrder S; S.init(M, DM, G, bx);
          pg8::EpiG4b E{args.out, PL, SSQ, args.in[18], (LAS float*)(ldsl + SCR_OFF), 0};
          pg8::gemm_phase<pg8::EpiG4b, pg8::StaticOrder, true, true>(ldsl, g, S, E); }
    }
#endif
}

extern "C" void kernel_launch(void* const* d_in, const int* in_sizes, int n_in, void* d_out, int out_size, void* d_ws, size_t ws_size, hipStream_t stream) {
    static int grid_blocks = 0;
    if (grid_blocks == 0) {
        if (n_in != 20 || in_sizes[0] != M * DM || out_size != M * DM || ws_size < WS_END) { fprintf(stderr, "kernel_launch: unexpected shapes (n_in %d, in0 %d, out %d, ws %zu)\n", n_in, n_in > 0 ? in_sizes[0] : -1, out_size, ws_size); grid_blocks = -1; return; }
        int dev = 0, cus = 0, per_cu = 0;
        (void)hipGetDevice(&dev);
        (void)hipDeviceGetAttribute(&cus, hipDeviceAttributeMultiprocessorCount, dev);
        if (hipFuncSetAttribute((const void*)moba_rglru_fwd, hipFuncAttributeMaxDynamicSharedMemorySize, LDS_BYTES) != hipSuccess) { fprintf(stderr, "kernel_launch: hipFuncSetAttribute failed\n"); }
        if (hipOccupancyMaxActiveBlocksPerMultiprocessor(&per_cu, (const void*)moba_rglru_fwd, NWAVES * 64, LDS_BYTES) != hipSuccess || per_cu < 1) { fprintf(stderr, "kernel_launch: occupancy query failed (%d)\n", per_cu); per_cu = 1; }
        (void)hipGetLastError();
        if (per_cu > 1) per_cu = 1;
        grid_blocks = cus * per_cu;
        if (grid_blocks > 256) grid_blocks = 256;
    }
    if (grid_blocks < 0) return;
    Args a{};
    for (int i = 0; i < 20; ++i) a.in[i] = (const float*)d_in[i];
    a.out = (float*)d_out; a.ws = (unsigned char*)d_ws;
    void* kargs[] = {&a};
    hipError_t e = hipLaunchCooperativeKernel((const void*)moba_rglru_fwd, dim3(grid_blocks), dim3(NWAVES * 64), kargs, LDS_BYTES, stream);
    if (e != hipSuccess) fprintf(stderr, "cooperative launch failed: %s (grid %d)\n", hipGetErrorString(e), grid_blocks);
}
```

```cpp
#include <hip/hip_runtime.h>
#include <hip/hip_bf16.h>
#include <hip/hip_cooperative_groups.h>
#include <cstdio>
#include <cstdint>
#include <cmath>
namespace pg8 {
#define PG8_LAS __attribute__((address_space(3)))
typedef unsigned short bf16_t;
typedef short bf16x8 __attribute__((ext_vector_type(8)));
typedef float f32x4 __attribute__((ext_vector_type(4)));
typedef unsigned u32x4 __attribute__((ext_vector_type(4)));
constexpr int BM = 256, BK = 64, HALF = 128, HTB = HALF * BK * 2  , STAGE_BYTES = 8 * HTB, NXCD = 8, WGM = 8;

__host__ __device__ __forceinline__ int lds_byte(int r, int c) { const int st = (r >> 4) * 2 + (c >> 5), rr = r & 15, cc = c & 31, ob = rr * 64 + cc * 2; return st * 1024 + (ob ^ (((ob >> 9) & 1) << 5)); }
__host__ __device__ __forceinline__ void stage_rc(int b, int& R, int& C) { const int st = b / 1024, sb = b % 1024, swz = sb ^ (((sb >> 9) & 1) << 5); R = (st >> 1) * 16 + swz / 64; C = (st & 1) * 32 + (swz % 64) / 2; }
__host__ __device__ __forceinline__ int perm32(int rho) { const int n = rho >> 4, i = rho & 15; return 8 * (i >> 2) + 4 * n + (i & 3); }

struct Unit { int pm, pn; };
struct Gemm { const bf16_t* A; const bf16_t* Bt; int M, N, K; };

struct StaticOrder {
    int nM, nN, nwg, G, c;
    __host__ __device__ void init(int M, int N, int G_, int c_) { nM = M / BM; nN = N / BM; nwg = nM * nN; G = G_; c = c_; }
    __host__ __device__ bool next(int i, Unit& u) const {
        const long L = (long)i * G + c; if (L >= nwg) return false;
        int wgid = (int)L; { const int q = nwg / NXCD, r = nwg % NXCD, xcd = wgid % NXCD, off = wgid / NXCD; wgid = (xcd < r ? xcd * (q + 1) : r * (q + 1) + (xcd - r) * q) + off; }
        const int nig = WGM * nN, gid = wgid / nig, fm = gid * WGM, gsz = (nM - fm) < WGM ? (nM - fm) : WGM;
        u.pm = fm + ((wgid % nig) % gsz); u.pn = (wgid % nig) / gsz; return true;
    }
    __device__ __forceinline__ void a_ready(const Unit&) const {}
    __device__ __forceinline__ void done(const Unit&) const {}
};

__device__ __forceinline__ unsigned cvt_pk_bf16(float lo, float hi) { unsigned r; asm volatile("v_cvt_pk_bf16_f32 %0, %1, %2" : "=v"(r) : "v"(lo), "v"(hi)); return r; }
__device__ __forceinline__ float bf_lo(unsigned w) { return __uint_as_float(w << 16); }
__device__ __forceinline__ float bf_hi(unsigned w) { return __uint_as_float(w & 0xffff0000u); }
__device__ __forceinline__ float sigmoidf_(float x) { return __builtin_amdgcn_rcpf(1.0f + __expf(-x)); }
__device__ __forceinline__ float siluf_(float x) { return x * __builtin_amdgcn_rcpf(1.0f + __expf(-x)); }
__device__ __forceinline__ u32x4 pack8bf(const f32x4& v0, const f32x4& v1) { u32x4 w; w.x = cvt_pk_bf16(v0[0], v0[1]); w.y = cvt_pk_bf16(v0[2], v0[3]); w.z = cvt_pk_bf16(v1[0], v1[1]); w.w = cvt_pk_bf16(v1[2], v1[3]); return w; }
__device__ __forceinline__ void unpack8bf(const u32x4& w, f32x4& v0, f32x4& v1) { v0 = (f32x4){bf_lo(w.x), bf_hi(w.x), bf_lo(w.y), bf_hi(w.y)}; v1 = (f32x4){bf_lo(w.z), bf_hi(w.z), bf_lo(w.w), bf_hi(w.w)}; }

constexpr int SEQ_ = 2048, NHEAD_ = 8;
struct EpiG1 {
    static constexpr bool PERM = true, AFTER_DRAIN = false, HOOK = false;
    unsigned char* wsQ; float* KMP; const float *qg, *kg; PG8_LAS float* scr; int hook_t;
    __device__ __forceinline__ void mid(f32x4 (&acc)[2][2][4][2], const Unit& u, int wr, int wc, int fr, int fq) const {}
    __device__ __forceinline__ void operator()(f32x4 (&acc)[2][2][4][2], const Unit& u, int wr, int wc, int fr, int fq) const {
        const int pn = u.pn; asm volatile("" : "+v"(fr), "+v"(fq));
        if (pn < 12) {
            if (pn < 8) {
#pragma unroll
                for (int ai = 0; ai < 2; ++ai)
#pragma unroll
                    for (int m = 0; m < 4; ++m)
#pragma unroll
                        for (int bj = 0; bj < 2; ++bj) {
                            const f32x4 a = acc[ai][bj][m][0], b = acc[ai][bj][m][1];
                            float s = (a[0] * a[0] + a[1] * a[1]) + (a[2] * a[2] + a[3] * a[3]) + (b[0] * b[0] + b[1] * b[1]) + (b[2] * b[2] + b[3] * b[3]);
                            s += __shfl_xor(s, 16); s += __shfl_xor(s, 32);
                            if (fq == 0) scr[((ai * HALF + wr * 64 + m * 16 + fr) * 2 + bj) * 4 + wc] = s;
                        }
                asm volatile("s_waitcnt lgkmcnt(0)" ::: "memory"); __builtin_amdgcn_s_barrier(); asm volatile("" ::: "memory");
                const f32x4 gq0 = *(const f32x4*)(qg + wc * 32 + 8 * fq), gq1 = *(const f32x4*)(qg + wc * 32 + 8 * fq + 4);
                const f32x4 gk0 = *(const f32x4*)(kg + wc * 32 + 8 * fq), gk1 = *(const f32x4*)(kg + wc * 32 + 8 * fq + 4);
                const f32x4 g0 = (pn < 4) ? gq0 : gk0, g1 = (pn < 4) ? gq1 : gk1;
#pragma unroll
                for (int ai = 0; ai < 2; ++ai)
#pragma unroll
                    for (int m = 0; m < 4; ++m)
#pragma unroll
                        for (int bj = 0; bj < 2; ++bj) {
                            const f32x4 p = *(const PG8_LAS f32x4*)(scr + ((ai * HALF + wr * 64 + m * 16 + fr) * 2 + bj) * 4);
                            const float rstd = __builtin_amdgcn_rsqf(((p[0] + p[1]) + (p[2] + p[3])) * (1.0f / 128.0f) + 1e-6f);
                            acc[ai][bj][m][0] = acc[ai][bj][m][0] * rstd * g0; acc[ai][bj][m][1] = acc[ai][bj][m][1] * rstd * g1;
                        }
                if (pn >= 4) {
#pragma unroll
                    for (int bj = 0; bj < 2; ++bj)
#pragma unroll
                        for (int n = 0; n < 2; ++n) {
                            f32x4 cs = (f32x4){0.f, 0.f, 0.f, 0.f};
#pragma unroll
                            for (int ai = 0; ai < 2; ++ai)
#pragma unroll
                                for (int m = 0; m < 4; ++m) cs += acc[ai][bj][m][n];
#pragma unroll
                            for (int o = 1; o < 16; o <<= 1) { cs[0] += __shfl_xor(cs[0], o); cs[1] += __shfl_xor(cs[1], o); cs[2] += __shfl_xor(cs[2], o); cs[3] += __shfl_xor(cs[3], o); }
                            if (fr == 0) *(f32x4*)(KMP + (size_t)(u.pm * 2 + wr) * 1024 + (pn - 4) * 256 + bj * HALF + wc * 32 + 8 * fq + 4 * n) = cs;
                        }
                }
            }
            bf16_t* base = (bf16_t*)(wsQ + (size_t)(pn >> 2) * (16u << 20));
            const int b = u.pm >> 3, s0 = (u.pm & 7) * 256 + wr * 64 + fr;
#pragma unroll
            for (int bj = 0; bj < 2; ++bj) {
                const int h = 2 * (pn & 3) + bj;
                bf16_t* hp = base + ((size_t)(b * NHEAD_ + h) * SEQ_ + s0) * 128 + wc * 32 + 8 * fq;
#pragma unroll
                for (int ai = 0; ai < 2; ++ai)
#pragma unroll
                    for (int m = 0; m < 4; ++m) *(u32x4*)(hp + (size_t)(ai * HALF + m * 16) * 128) = pack8bf(acc[ai][bj][m][0], acc[ai][bj][m][1]);
            }
        } else {
            bf16_t* base; int ldc, colt, act;
            if (pn < 24) { base = (bf16_t*)(wsQ + (size_t)(pn >> 2) * (16u << 20)); ldc = 1024; colt = (pn & 3) * 256; act = ((pn >> 2) == 4) ? 0 : 1; }
            else { base = (bf16_t*)(wsQ + (size_t)(96u << 20) + (size_t)((pn - 24) >> 3) * (32u << 20)); ldc = 2048; colt = ((pn - 24) & 7) * 256; act = 2; }
            const int row0 = u.pm * BM + wr * 64 + fr, col0 = colt + wc * 32 + 8 * fq;
#pragma unroll
            for (int ai = 0; ai < 2; ++ai)
#pragma unroll
                for (int m = 0; m < 4; ++m) { bf16_t* rowp = base + (size_t)(row0 + ai * HALF + m * 16) * ldc + col0;
#pragma unroll
                    for (int bj = 0; bj < 2; ++bj) { f32x4 v0 = acc[ai][bj][m][0], v1 = acc[ai][bj][m][1];
                        if (act != 0) {
#pragma unroll
                            for (int j = 0; j < 4; ++j) { const float e0 = __builtin_amdgcn_rcpf(1.0f + __expf(-v0[j])), e1 = __builtin_amdgcn_rcpf(1.0f + __expf(-v1[j]));
                                v0[j] = (act == 1) ? v0[j] * e0 : e0; v1[j] = (act == 1) ? v1[j] * e1 : e1; } }
                        *(u32x4*)(rowp + bj * HALF) = pack8bf(v0, v1); } }
        }
    }
};

struct EpiG2 {
    static constexpr bool PERM = true, AFTER_DRAIN = false, HOOK = true;
    const bf16_t *SA, *SL; bf16_t* MG; int hook_t;
    __device__ __forceinline__ void mid(f32x4 (&acc)[2][2][4][2], const Unit& u, int wr, int wc, int fr, int fq) const {
        asm volatile("" : "+v"(fr), "+v"(fq)); const int row0 = u.pm * BM + wr * 64 + fr, col0 = u.pn * BM + wc * 32 + 8 * fq;
#pragma unroll
        for (int ai = 0; ai < 2; ++ai)
#pragma unroll
            for (int m = 0; m < 4; ++m) { const size_t off = (size_t)(row0 + ai * HALF + m * 16) * 2048 + col0;
#pragma unroll
                for (int bj = 0; bj < 2; ++bj) {
                    const u32x4 wa = *(const u32x4*)(SA + off + bj * HALF), wl = *(const u32x4*)(SL + off + bj * HALF);
                    f32x4 a0, a1, l0, l1; unpack8bf(wa, a0, a1); unpack8bf(wl, l0, l1);
#pragma unroll
                    for (int j = 0; j < 4; ++j) { acc[ai][bj][m][0][j] *= a0[j] * __builtin_amdgcn_rcpf(l0[j]); acc[ai][bj][m][1][j] *= a1[j] * __builtin_amdgcn_rcpf(l1[j]); }
                }
                if (m & 1) asm volatile("" ::: "memory"); }
    }
    __device__ __forceinline__ void operator()(f32x4 (&acc)[2][2][4][2], const Unit& u, int wr, int wc, int fr, int fq) const {
        asm volatile("" : "+v"(fr), "+v"(fq)); const int row0 = u.pm * BM + wr * 64 + fr, col0 = u.pn * BM + wc * 32 + 8 * fq;
#pragma unroll
        for (int ai = 0; ai < 2; ++ai)
#pragma unroll
            for (int m = 0; m < 4; ++m) { const size_t off = (size_t)(row0 + ai * HALF + m * 16) * 2048 + col0;
#pragma unroll
                for (int bj = 0; bj < 2; ++bj) {
                    const u32x4 wl = *(const u32x4*)(SL + off + bj * HALF);
                    f32x4 l0, l1; unpack8bf(wl, l0, l1);
                    *(u32x4*)(MG + off + bj * HALF) = pack8bf(acc[ai][bj][m][0] * l0, acc[ai][bj][m][1] * l1);
                } }
    }
};

struct EpiG3 {
    static constexpr bool PERM = true, AFTER_DRAIN = false, HOOK = false;
    const float* X; float* OUT; bf16_t* X1G; float* SSQ; const float* gple; int hook_t;
    __device__ __forceinline__ void mid(f32x4 (&acc)[2][2][4][2], const Unit& u, int wr, int wc, int fr, int fq) const {}
    __device__ __forceinline__ void operator()(f32x4 (&acc)[2][2][4][2], const Unit& u, int wr, int wc, int fr, int fq) const {
        asm volatile("" : "+v"(fr), "+v"(fq)); const int row0 = u.pm * BM + wr * 64 + fr, col0 = u.pn * BM + wc * 32 + 8 * fq;
        f32x4 gv[2][2];
#pragma unroll
        for (int bj = 0; bj < 2; ++bj) { gv[bj][0] = *(const f32x4*)(gple + col0 + bj * HALF); gv[bj][1] = *(const f32x4*)(gple + col0 + bj * HALF + 4); }
#pragma unroll
        for (int ai = 0; ai < 2; ++ai)
#pragma unroll
            for (int m = 0; m < 4; ++m) { const int row = row0 + ai * HALF + m * 16; const size_t off = (size_t)row * 2048 + col0; float s = 0.f;
#pragma unroll
                for (int bj = 0; bj < 2; ++bj) {
                    const f32x4 x0 = *(const f32x4*)(X + off + bj * HALF) + acc[ai][bj][m][0], x1 = *(const f32x4*)(X + off + bj * HALF + 4) + acc[ai][bj][m][1];
                    *(f32x4*)(OUT + off + bj * HALF) = x0; *(f32x4*)(OUT + off + bj * HALF + 4) = x1;
                    s += (x0[0] * x0[0] + x0[1] * x0[1]) + (x0[2] * x0[2] + x0[3] * x0[3]) + (x1[0] * x1[0] + x1[1] * x1[1]) + (x1[2] * x1[2] + x1[3] * x1[3]);
                    *(u32x4*)(X1G + off + bj * HALF) = pack8bf(x0 * gv[bj][0], x1 * gv[bj][1]);
                }
                s += __shfl_xor(s, 16); s += __shfl_xor(s, 32);
                if (fq == 0) SSQ[(size_t)row * 32 + u.pn * 4 + wc] = s;
            }
    }
};

struct EpiG4a {
    static constexpr bool PERM = true, AFTER_DRAIN = false, HOOK = false;
    bf16_t* PL; int hook_t;
    __device__ __forceinline__ void mid(f32x4 (&acc)[2][2][4][2], const Unit& u, int wr, int wc, int fr, int fq) const {}
    __device__ __forceinline__ void operator()(f32x4 (&acc)[2][2][4][2], const Unit& u, int wr, int wc, int fr, int fq) const {
        asm volatile("" : "+v"(fr), "+v"(fq)); const int row0 = u.pm * BM + wr * 64 + fr, col0 = u.pn * BM + wc * 32 + 8 * fq;
#pragma unroll
        for (int ai = 0; ai < 2; ++ai)
#pragma unroll
            for (int m = 0; m < 4; ++m) { const size_t off = (size_t)(row0 + ai * HALF + m * 16) * 2048 + col0;
#pragma unroll
                for (int bj = 0; bj < 2; ++bj) *(u32x4*)(PL + off + bj * HALF) = pack8bf(acc[ai][bj][m][0], acc[ai][bj][m][1]); }
    }
};

struct EpiG4b {
    static constexpr bool PERM = true, AFTER_DRAIN = false, HOOK = false;
    float* OUT; const bf16_t* PL; const float* SSQ; const float* bias; PG8_LAS float* scr; int hook_t;
    __device__ __forceinline__ void mid(f32x4 (&acc)[2][2][4][2], const Unit& u, int wr, int wc, int fr, int fq) const {}
    __device__ __forceinline__ void operator()(f32x4 (&acc)[2][2][4][2], const Unit& u, int wr, int wc, int fr, int fq) const {
        asm volatile("" : "+v"(fr), "+v"(fq)); const int row0 = u.pm * BM + wr * 64 + fr, col0 = u.pn * BM + wc * 32 + 8 * fq;
        {
            const int tid = threadIdx.x, hf = tid & 1; int rr = tid >> 1; asm volatile("" : "+v"(rr));
            f32x4 t = (f32x4){0.f, 0.f, 0.f, 0.f};
#pragma unroll
            for (int i = 0; i < 4; ++i) t += *(const f32x4*)(SSQ + (size_t)(u.pm * BM + rr) * 32 + hf * 16 + 4 * i);
            float s = (t[0] + t[1]) + (t[2] + t[3]); s += __shfl_xor(s, 1);
            if (hf == 0) scr[rr] = __builtin_amdgcn_rsqf(s * (1.0f / 2048.0f) + 1e-6f);
            asm volatile("s_waitcnt lgkmcnt(0)" ::: "memory"); __builtin_amdgcn_s_barrier(); asm volatile("" ::: "memory");
        }
        f32x4 bv[2][2];
#pragma unroll
        for (int bj = 0; bj < 2; ++bj) { bv[bj][0] = *(const f32x4*)(bias + col0 + bj * HALF); bv[bj][1] = *(const f32x4*)(bias + col0 + bj * HALF + 4); }
#pragma unroll
        for (int ai = 0; ai < 2; ++ai)
#pragma unroll
            for (int m = 0; m < 4; ++m) { const int row = row0 + ai * HALF + m * 16; const size_t off = (size_t)row * 2048 + col0;
                const float rstd = scr[ai * HALF + wr * 64 + m * 16 + fr];
#pragma unroll
                for (int bj = 0; bj < 2; ++bj) {
                    const u32x4 wp = *(const u32x4*)(PL + off + bj * HALF); f32x4 p0, p1; unpack8bf(wp, p0, p1);
                    f32x4 x0 = *(const f32x4*)(OUT + off + bj * HALF), x1 = *(const f32x4*)(OUT + off + bj * HALF + 4);
                    const f32x4 z0 = acc[ai][bj][m][0] * rstd + bv[bj][0], z1 = acc[ai][bj][m][1] * rstd + bv[bj][1];
#pragma unroll
                    for (int j = 0; j < 4; ++j) { x0[j] += p0[j] * sigmoidf_(z0[j]); x1[j] += p1[j] * sigmoidf_(z1[j]); }
                    *(f32x4*)(OUT + off + bj * HALF) = x0; *(f32x4*)(OUT + off + bj * HALF + 4) = x1;
                }
                if (m & 1) asm volatile("" ::: "memory"); }
    }
};
template <class Epi, class Sched, bool ALIGN_EPI = false, bool SP2 = false>
__device__ __forceinline__ void gemm_phase(PG8_LAS unsigned char* lds, const Gemm g, const Sched& S, const Epi& E) {
    int tid_ = threadIdx.x; asm volatile("" : "+v"(tid_)); const int tid = tid_, wid = __builtin_amdgcn_readfirstlane(tid >> 6), lane = tid & 63, wr = wid >> 2, wc = wid & 3, fr = lane & 15, fq = lane >> 4;
    const int K = g.K, nt = K / BK;
    unsigned voffA[2], voffB[2];
#pragma unroll
    for (int i = 0; i < 2; ++i) { int R, C; stage_rc(tid * 16 + i * 8192, R, C); const int Rb = Epi::PERM ? ((R & ~31) + perm32(R & 31)) : R;
        voffA[i] = (unsigned)(R * K + C) * 2u; voffB[i] = (unsigned)(Rb * K + C) * 2u; }
    const size_t kstep = (size_t)(BK * 2);
    const size_t hstep = (size_t)HALF * K * 2;
    const size_t tstep = 2 * hstep;
    const unsigned ldsw = (unsigned)wid * 1024u;
    const int aoff = lds_byte(wr * 64 + fr, fq * 8), boff = lds_byte(wc * 32 + fr, fq * 8);
#define PG8_SA(b, h) (((b) * 2 + (h)) * HTB)
#define PG8_SB(b, h) ((4 + (b) * 2 + (h)) * HTB)
#define PG8_STAGE(bufoff, gbase, voff) do { _Pragma("unroll") for (int _i = 0; _i < 2; ++_i) \
        __builtin_amdgcn_global_load_lds((const unsigned*)((const char*)(gbase) + (voff)[_i]), (PG8_LAS unsigned*)(lds + (bufoff) + ldsw + _i * 8192), 16, 0, 0); } while (0)
#define PG8_LDA(dst, b, h) do { _Pragma("unroll") for (int m = 0; m < 4; ++m) _Pragma("unroll") for (int k = 0; k < 2; ++k) dst[m][k] = *(const PG8_LAS bf16x8*)(lds + PG8_SA(b, h) + aoff + m * 2048 + k * 1024); } while (0)
#define PG8_LDB(dst, b, h) do { _Pragma("unroll") for (int n = 0; n < 2; ++n) _Pragma("unroll") for (int k = 0; k < 2; ++k) dst[n][k] = *(const PG8_LAS bf16x8*)(lds + PG8_SB(b, h) + boff + n * 2048 + k * 1024); } while (0)
#define PG8_MMA(ai, bj, At, Bt) do { __builtin_amdgcn_s_setprio(1); _Pragma("unroll") for (int m = 0; m < 4; ++m) _Pragma("unroll") for (int n = 0; n < 2; ++n) _Pragma("unroll") for (int k = 0; k < 2; ++k) \
        acc[ai][bj][m][n] = __builtin_amdgcn_mfma_f32_16x16x32_bf16(Bt[n][k], At[m][k], acc[ai][bj][m][n], 0, 0, 0); __builtin_amdgcn_s_setprio(0); } while (0)
#define PG8_WAIT_V(n) asm volatile("s_waitcnt vmcnt(" #n ")" ::: "memory")
#define PG8_WAIT_L(n) asm volatile("s_waitcnt lgkmcnt(" #n ")" ::: "memory")
#define PG8_BAR __builtin_amdgcn_s_barrier()
#define PG8_SCHED __builtin_amdgcn_sched_barrier(0)
    Unit cur, nxt; int ui = 0;
    if (!S.next(0, cur)) return;
    f32x4 acc[2][2][4][2];
#pragma unroll
    for (int a = 0; a < 2; ++a)
#pragma unroll
        for (int b = 0; b < 2; ++b)
#pragma unroll
            for (int m = 0; m < 4; ++m)
#pragma unroll
                for (int n = 0; n < 2; ++n) acc[a][b][m][n] = (f32x4){0.f, 0.f, 0.f, 0.f};
    bf16x8 At[4][2], B0[2][2], B1[2][2];
    const char* cA = (const char*)g.A + (size_t)cur.pm * tstep; const char* cB = (const char*)g.Bt + (size_t)cur.pn * tstep;
    S.a_ready(cur);
    if constexpr (SP2) {
        PG8_STAGE(PG8_SB(0, 0), cB, voffB); PG8_STAGE(PG8_SB(0, 1), cB + hstep, voffB); PG8_STAGE(PG8_SA(0, 0), cA, voffA); PG8_STAGE(PG8_SA(0, 1), cA + hstep, voffA);
        if (wr == 1) PG8_BAR;
        PG8_WAIT_V(2); PG8_BAR;
        PG8_STAGE(PG8_SB(1, 0), cB + kstep, voffB); PG8_STAGE(PG8_SA(1, 0), cA + kstep, voffA); PG8_STAGE(PG8_SB(1, 1), cB + hstep + kstep, voffB);
        PG8_WAIT_V(6); PG8_BAR;
    } else {
        PG8_STAGE(PG8_SB(0, 0), cB, voffB); PG8_STAGE(PG8_SA(0, 0), cA, voffA); PG8_STAGE(PG8_SB(0, 1), cB + hstep, voffB); PG8_STAGE(PG8_SA(0, 1), cA + hstep, voffA);
        if (wr == 1) PG8_BAR;
        PG8_WAIT_V(4); PG8_BAR;
        PG8_STAGE(PG8_SB(1, 0), cB + kstep, voffB); PG8_STAGE(PG8_SA(1, 0), cA + kstep, voffA); PG8_STAGE(PG8_SB(1, 1), cB + hstep + kstep, voffB);
        PG8_WAIT_V(6); PG8_BAR;
    }
    for (;;) {
        const bool has_next = S.next(ui + 1, nxt);
        const char* nA = has_next ? (const char*)g.A + (size_t)nxt.pm * tstep : cA; const char* nB = has_next ? (const char*)g.Bt + (size_t)nxt.pn * tstep : cB;
        for (int t = 0; t < nt; t += 2) {
            const bool last = (t == nt - 2);
            if constexpr (Epi::HOOK) { if (t == E.hook_t) E.mid(acc, cur, wr, wc, fr, fq); }
            const char* a1 = cA + (size_t)(t + 1) * kstep;
            const char* a2 = last ? nA : cA + (size_t)(t + 2) * kstep; const char* b2 = last ? nB : cB + (size_t)(t + 2) * kstep;
            const char* a3 = a2 + kstep; const char* b3 = b2 + kstep;
            if (last && has_next) S.a_ready(nxt);
            if constexpr (SP2) {
            PG8_LDB(B0, 0, 0); PG8_LDB(B1, 0, 1); PG8_SCHED; PG8_LDA(At, 0, 0); PG8_STAGE(PG8_SA(1, 1), a1 + hstep, voffA);
            PG8_WAIT_V(8); PG8_WAIT_L(0); PG8_BAR; PG8_MMA(0, 0, At, B0); PG8_MMA(0, 1, At, B1); PG8_BAR; PG8_SCHED;
            PG8_LDA(At, 0, 1); PG8_STAGE(PG8_SB(0, 0), b2, voffB); PG8_STAGE(PG8_SB(0, 1), b2 + hstep, voffB); PG8_STAGE(PG8_SA(0, 0), a2, voffA);
            PG8_WAIT_V(8); PG8_WAIT_L(0); PG8_BAR; PG8_MMA(1, 0, At, B0); PG8_MMA(1, 1, At, B1); PG8_BAR; PG8_SCHED;
            PG8_LDB(B0, 1, 0); PG8_LDB(B1, 1, 1); PG8_SCHED; PG8_LDA(At, 1, 0); PG8_STAGE(PG8_SA(0, 1), a2 + hstep, voffA);
            PG8_WAIT_V(8); PG8_WAIT_L(0); PG8_BAR; PG8_MMA(0, 0, At, B0); PG8_MMA(0, 1, At, B1); PG8_BAR; PG8_SCHED;
            PG8_LDA(At, 1, 1); PG8_STAGE(PG8_SB(1, 0), b3, voffB); PG8_STAGE(PG8_SB(1, 1), b3 + hstep, voffB); PG8_STAGE(PG8_SA(1, 0), a3, voffA);
            PG8_WAIT_V(8); PG8_WAIT_L(0); PG8_BAR; PG8_MMA(1, 0, At, B0); PG8_MMA(1, 1, At, B1); PG8_BAR; PG8_SCHED;
            } else {
            PG8_LDB(B0, 0, 0); PG8_SCHED; PG8_LDA(At, 0, 0); PG8_STAGE(PG8_SA(1, 1), a1 + hstep, voffA);
            PG8_WAIT_L(8); PG8_BAR; PG8_WAIT_L(0); PG8_MMA(0, 0, At, B0); PG8_BAR; PG8_SCHED;
            PG8_LDB(B1, 0, 1); PG8_STAGE(PG8_SB(0, 0), b2, voffB);
            PG8_BAR; PG8_WAIT_L(0); PG8_MMA(0, 1, At, B1); PG8_BAR;
            PG8_LDA(At, 0, 1); PG8_STAGE(PG8_SA(0, 0), a2, voffA);
            PG8_BAR; PG8_WAIT_L(0); PG8_MMA(1, 0, At, B0); PG8_BAR; PG8_SCHED;
            PG8_STAGE(PG8_SB(0, 1), b2 + hstep, voffB);
            PG8_WAIT_V(6); PG8_BAR; PG8_MMA(1, 1, At, B1); PG8_BAR;
            PG8_LDB(B0, 1, 0); PG8_SCHED; PG8_LDA(At, 1, 0); PG8_STAGE(PG8_SA(0, 1), a2 + hstep, voffA);
            PG8_WAIT_L(8); PG8_BAR; PG8_WAIT_L(0); PG8_MMA(0, 0, At, B0); PG8_BAR; PG8_SCHED;
            PG8_LDB(B1, 1, 1); PG8_STAGE(PG8_SB(1, 0), b3, voffB);
            PG8_BAR; PG8_WAIT_L(0); PG8_MMA(0, 1, At, B1); PG8_BAR;
            PG8_LDA(At, 1, 1); PG8_STAGE(PG8_SA(1, 0), a3, voffA);
            PG8_BAR; PG8_WAIT_L(0); PG8_MMA(1, 0, At, B0); PG8_BAR; PG8_SCHED;
            PG8_STAGE(PG8_SB(1, 1), b3 + hstep, voffB);
            PG8_WAIT_V(6); PG8_BAR; PG8_MMA(1, 1, At, B1); PG8_BAR;
            }
        }
        if constexpr (ALIGN_EPI) { if (wr == 0) PG8_BAR; }
        if constexpr (!Epi::AFTER_DRAIN) { E(acc, cur, wr, wc, fr, fq); S.done(cur); }
        if (!has_next) break;
#pragma unroll
        for (int a = 0; a < 2; ++a)
#pragma unroll
            for (int b = 0; b < 2; ++b)
#pragma unroll
                for (int m = 0; m < 4; ++m)
#pragma unroll
                    for (int n = 0; n < 2; ++n) acc[a][b][m][n] = (f32x4){0.f, 0.f, 0.f, 0.f};
        cur = nxt; cA = nA; cB = nB; ++ui;
        if constexpr (ALIGN_EPI) { if (wr == 1) PG8_BAR; }
    }
    PG8_WAIT_V(0);
    if constexpr (!ALIGN_EPI) { if (wr == 0) PG8_BAR; }
    PG8_BAR;
#undef PG8_SA
#undef PG8_SB
#undef PG8_STAGE
#undef PG8_LDA
#undef PG8_LDB
#undef PG8_MMA
#undef PG8_WAIT_V
#undef PG8_WAIT_L
#undef PG8_BAR
#undef PG8_SCHED
}
}

namespace attn {
constexpr int D = 128;
constexpr float THR = 8.f;
constexpr bool WSKIP = false;
constexpr float SCALE = 0.08838834764831845f;
constexpr int NW = 8, QBLK = 32, KVBLK = 64, QB = NW * QBLK;
constexpr int SHM_V = KVBLK * D * 2, SHM_K = KVBLK * D * 2;
constexpr int LDS_BYTES = 2 * SHM_V + 2 * SHM_K + NW * 64 * 4;
constexpr int KM_OFF = 69632;
constexpr int LDO = 2048, LDG = 1024, STG_OFF = 73728;
#ifndef MOBA_ON
#define MOBA_ON 1
#endif
#ifndef GA_ON
#define GA_ON 1
#endif
using bf16 = __hip_bfloat16;
typedef short bf16x8 __attribute__((ext_vector_type(8)));
typedef short s16x4 __attribute__((ext_vector_type(4)));
typedef float f32x16 __attribute__((ext_vector_type(16)));
typedef float f32x4 __attribute__((ext_vector_type(4)));
typedef unsigned u32x4 __attribute__((ext_vector_type(4)));
template <class A, class Bt> struct same_t { static constexpr bool v = false; };
template <class A> struct same_t<A, A> { static constexpr bool v = true; };

#define KSWZ(row, colB) ((row) * 256 + ((colB) ^ (((row) & 7) << 4)))
#define SBAR() __builtin_amdgcn_sched_barrier(0)
__device__ __forceinline__ int v_st(int k, int c) { const int kk = (k & ~0xC) | ((k & 4) << 1) | ((k & 8) >> 1); return ((kk >> 3) * 4 + (c >> 5)) * 512 + ((kk & 7) * 32 + (c & 31)) * 2; }
__device__ __forceinline__ int v_rd_base(int lane) { return ((lane & 3) << 3) | (((lane >> 2) & 3) << 6) | (((lane >> 4) & 1) << 5) | (((lane >> 5) & 1) << 8); }
constexpr int v_rd_off(int d0, int ks, int half) { return d0 * 512 + ks * 4096 + half * 2048; }
__device__ __forceinline__ int crow(int r, int hi) { return (r & 3) + 8 * (r >> 2) + 4 * hi; }
__device__ __forceinline__ unsigned cvtpk(float lo, float hi) {
    unsigned r; asm volatile("v_cvt_pk_bf16_f32 %0, %1, %2" : "=v"(r) : "v"(lo), "v"(hi)); return r;
}
__device__ __forceinline__ bf16x8 pack8(f32x4 a, f32x4 b) {
    u32x4 w = {cvtpk(a[0], a[1]), cvtpk(a[2], a[3]), cvtpk(b[0], b[1]), cvtpk(b[2], b[3])};
    return *reinterpret_cast<bf16x8*>(&w);
}
template <class T> __device__ __forceinline__ bf16x8 load8(const T* p) {
    if constexpr (same_t<T, float>::v) { return pack8(*(const f32x4*)p, *(const f32x4*)(p + 4)); }
    else { return *reinterpret_cast<const bf16x8*>(p); }
}
__device__ __forceinline__ void mask_tile(f32x16& p0, f32x16& p1, int dq, unsigned W) {
    const float NEG = -__builtin_inff();
#pragma unroll
    for (int r = 0; r < 16; ++r) {
        const int c = (r & 3) + 8 * (r >> 2);
        if ((unsigned)(dq - c) >= W) p0[r] = NEG;
        if ((unsigned)(dq - c - 32) >= W) p1[r] = NEG;
    }
}
__device__ __forceinline__ void partialSM(f32x16& p0, f32x16& p1, float& m_reg, float& mn, float& alpha) {
    float pmax = p0[0]; for (int r = 1; r < 16; ++r) pmax = fmaxf(pmax, p0[r]); for (int r = 0; r < 16; ++r) pmax = fmaxf(pmax, p1[r]);
    { auto rr = __builtin_amdgcn_permlane32_swap(__float_as_uint(pmax), __float_as_uint(pmax), false, false);
      pmax = fmaxf(__uint_as_float(rr[0]), __uint_as_float(rr[1])); }
    constexpr float C2 = 1.4426950408889634f * SCALE;
    if (__builtin_expect(__all((pmax - m_reg) * SCALE <= THR), 1)) { mn = m_reg; alpha = 1.f; }
    else { mn = fmaxf(m_reg, pmax); alpha = __builtin_amdgcn_exp2f((m_reg - mn) * C2); m_reg = mn; }
    const float mnL = -mn * C2;
    for (int r = 0; r < 16; ++r) p0[r] = fmaf(p0[r], C2, mnL); for (int r = 0; r < 16; ++r) p1[r] = fmaf(p1[r], C2, mnL);
    for (int r = 0; r < 16; ++r) p0[r] = __builtin_amdgcn_exp2f(p0[r]);
}
__device__ __forceinline__ void finishSM(f32x16& p0, f32x16& p1, float alpha, float& l_reg, bf16x8& pa0, bf16x8& pa1, bf16x8& pa2, bf16x8& pa3) {
    for (int r = 0; r < 16; ++r) p1[r] = __builtin_amdgcn_exp2f(p1[r]);
    float ps = 0; for (int r = 0; r < 16; ++r) ps += p0[r]; for (int r = 0; r < 16; ++r) ps += p1[r];
    { auto rr = __builtin_amdgcn_permlane32_swap(__float_as_uint(ps), __float_as_uint(ps), false, false);
      ps = __uint_as_float(rr[0]) + __uint_as_float(rr[1]); }
    l_reg = l_reg * alpha + ps;
#define PK4(P, B_, OUT) do { unsigned a0 = cvtpk(P[B_+0], P[B_+1]), a1 = cvtpk(P[B_+2], P[B_+3]);                          \
        unsigned b0 = cvtpk(P[B_+4], P[B_+5]), b1 = cvtpk(P[B_+6], P[B_+7]);                                             \
        auto r0 = __builtin_amdgcn_permlane32_swap(a0, b0, false, false); auto r1 = __builtin_amdgcn_permlane32_swap(a1, b1, false, false); \
        u32x4 w = {r0[0], r1[0], r0[1], r1[1]}; OUT = *reinterpret_cast<bf16x8*>(&w); } while (0)
    PK4(p0, 0, pa0); PK4(p0, 8, pa1); PK4(p1, 0, pa2); PK4(p1, 8, pa3);
#undef PK4
}
template <int KB, bool SK>
__device__ __forceinline__ void qkt(f32x16& p0, f32x16& p1, const char* K_lds, int r32, int hi, const bf16x8* qr, bool act) {
    if (SK && !act) { const float NEG = -__builtin_inff();
#pragma unroll
        for (int r = 0; r < 16; ++r) { p0[r] = NEG; p1[r] = NEG; } return; }
    p0 = f32x16{}; p1 = f32x16{};
    const char* kb[4];
#pragma unroll
    for (int dd = 0; dd < 4; ++dd) kb[dd] = K_lds + KB * SHM_K + KSWZ(r32, (dd * 16 + hi * 8) * 2);
#pragma unroll
    for (int d0 = 0; d0 < 8; ++d0) { const char* a = kb[d0 & 3] + (d0 >> 2) * 128;
        bf16x8 b0 = *reinterpret_cast<const bf16x8*>(a);
        bf16x8 b1 = *reinterpret_cast<const bf16x8*>(a + 32 * 256);
        p0 = __builtin_amdgcn_mfma_f32_32x32x16_bf16(b0, qr[d0], p0, 0, 0, 0);
        p1 = __builtin_amdgcn_mfma_f32_32x32x16_bf16(b1, qr[d0], p1, 0, 0, 0); }
}
template <int VB, bool SK>
__device__ __forceinline__ void pv_tile(f32x16* o, int vb0, bf16x8 pa0, bf16x8 pa1, bf16x8 pa2, bf16x8 pa3, bool act) {
    if (SK && !act) return;
#define TRRD(dst, off) asm volatile("ds_read_b64_tr_b16 %0, %1 offset:%2" : "=&v"(dst) : "v"(vb0), "i"(off) : "memory")
#define PV_D0(d0) do { s16x4 l0, l1, l2, l3, h0, h1, h2, h3; constexpr int b_ = VB * SHM_V + v_rd_off(d0, 0, 0);     \
        TRRD(l0, b_); TRRD(h0, b_ + 2048); TRRD(l1, b_ + 4096); TRRD(h1, b_ + 6144); TRRD(l2, b_ + 8192); TRRD(h2, b_ + 10240); TRRD(l3, b_ + 12288); TRRD(h3, b_ + 14336); \
        asm volatile("s_waitcnt lgkmcnt(0)" ::: "memory"); SBAR();                 \
        o[d0] = __builtin_amdgcn_mfma_f32_32x32x16_bf16(pa0, (bf16x8){l0[0], l0[1], l0[2], l0[3], h0[0], h0[1], h0[2], h0[3]}, o[d0], 0, 0, 0);   \
        o[d0] = __builtin_amdgcn_mfma_f32_32x32x16_bf16(pa1, (bf16x8){l1[0], l1[1], l1[2], l1[3], h1[0], h1[1], h1[2], h1[3]}, o[d0], 0, 0, 0);   \
        o[d0] = __builtin_amdgcn_mfma_f32_32x32x16_bf16(pa2, (bf16x8){l2[0], l2[1], l2[2], l2[3], h2[0], h2[1], h2[2], h2[3]}, o[d0], 0, 0, 0);   \
        o[d0] = __builtin_amdgcn_mfma_f32_32x32x16_bf16(pa3, (bf16x8){l3[0], l3[1], l3[2], l3[3], h3[0], h3[1], h3[2], h3[3]}, o[d0], 0, 0, 0); } while (0)
    PV_D0(0); PV_D0(1); PV_D0(2); PV_D0(3);
#undef PV_D0
#undef TRRD
}

template <class TIn, class TOut> struct BlockRef { const TIn* Q; const TIn* K; const TIn* V; TOut* O; int P0; const unsigned short* GA; const float* KM; int qb; };
template <class TIn> struct Seam {
    bf16x8 qr[8];
    bf16x8 st_v0, st_v1, st_k0, st_k1; f32x4 sf0, sf1, sf2, sf3;
    f32x4 tq[16];
};
__device__ __forceinline__ int swa_jlo(int P0, int W) { const int lowk = P0 - W + 1; return lowk > 0 ? lowk / KVBLK : 0; }
#define ROW(p, k0, rr) ((p) + (size_t)((k0) + (rr)) * D + sc)
#define VMW() asm volatile("s_waitcnt vmcnt(0)" ::: "memory")
#define VMWN(n) asm volatile("s_waitcnt vmcnt(%0)" :: "i"(n) : "memory")
#define SLOAD_H(Kp, Vp, k0) do { S.st_v0 = load8<TIn>(ROW(Vp, k0, sr)); S.st_v1 = load8<TIn>(ROW(Vp, k0, 32 + sr));              \
                         S.st_k0 = load8<TIn>(ROW(Kp, k0, sr)); S.st_k1 = load8<TIn>(ROW(Kp, k0, 32 + sr)); } while (0)
#define SWRITE_HK(bf) do { *(bf16x8*)(K_lds + (bf) * SHM_K + kws) = S.st_k0; *(bf16x8*)(K_lds + (bf) * SHM_K + kws + 32 * 256) = S.st_k1; } while (0)
#define SWRITE_HV(bf) do { *(bf16x8*)(V_lds + (bf) * SHM_V + vst0) = S.st_v0; *(bf16x8*)(V_lds + (bf) * SHM_V + vst1) = S.st_v1; } while (0)
#define SWRITE_H(bf) do { SWRITE_HV(bf); SWRITE_HK(bf); } while (0)
#define SLOAD_F(p, k0) do { S.sf0 = *(const f32x4*)ROW(p, k0, sr); S.sf1 = *(const f32x4*)(ROW(p, k0, sr) + 4);                \
                            S.sf2 = *(const f32x4*)ROW(p, k0, 32 + sr); S.sf3 = *(const f32x4*)(ROW(p, k0, 32 + sr) + 4); } while (0)
#define SWRITE_KF(bf) do { *(bf16x8*)(K_lds + (bf) * SHM_K + kws) = pack8(S.sf0, S.sf1); *(bf16x8*)(K_lds + (bf) * SHM_K + kws + 32 * 256) = pack8(S.sf2, S.sf3); } while (0)
#define SWRITE_VF(bf) do { *(bf16x8*)(V_lds + (bf) * SHM_V + vst0) = pack8(S.sf0, S.sf1); *(bf16x8*)(V_lds + (bf) * SHM_V + vst1) = pack8(S.sf2, S.sf3); } while (0)
template <class TIn, class TOut>
__device__ __forceinline__ void causal_swa_prime(const BlockRef<TIn, TOut>& cur, int W, char* lds, Seam<TIn>& S) {
    constexpr bool F32 = same_t<TIn, float>::v;
    int tid_ = threadIdx.x; asm volatile("" : "+v"(tid_)); const int tid = tid_, wid = __builtin_amdgcn_readfirstlane(tid >> 6), lane = tid & 63, r32 = lane & 31, hi = lane >> 5;
    const int sr = tid >> 4, sc = (tid & 15) * 8, kws = KSWZ(sr, sc * 2); char* K_lds = lds + 2 * SHM_V;
    const int kb0 = swa_jlo(cur.P0, W) * KVBLK;
    for (int d0 = 0; d0 < 8; ++d0) S.qr[d0] = load8<TIn>(cur.Q + (size_t)(wid * QBLK + r32) * D + d0 * 16 + hi * 8);
    if constexpr (F32) { SLOAD_F((const float*)cur.K, kb0); VMW(); SWRITE_KF(0); SBAR(); SLOAD_F((const float*)cur.V, kb0); }
    else { SLOAD_H(cur.K, cur.V, kb0); VMW(); SWRITE_HK(0); }
    __syncthreads();
}
template <class TIn, class TOut>
__device__ __forceinline__ void causal_swa_block(const BlockRef<TIn, TOut>& cur, const BlockRef<TIn, TOut>& nxt, int skv, int W, char* lds, Seam<TIn>& S) {
    constexpr bool F32 = same_t<TIn, float>::v;
    int tid_ = threadIdx.x; asm volatile("" : "+v"(tid_)); const int tid = tid_, wid = __builtin_amdgcn_readfirstlane(tid >> 6), lane = tid & 63, r32 = lane & 31, hi = lane >> 5;
    const int j_lo = swa_jlo(cur.P0, W);
    int j_hi = (cur.P0 + QB - 1) / KVBLK + 1; if (j_hi > skv / KVBLK) j_hi = skv / KVBLK;
    const int NT = j_hi - j_lo;
    const int kbn = swa_jlo(nxt.P0, W) * KVBLK;
    const int qlo = cur.P0 + wid * QBLK, qm = qlo + r32 - 4 * hi;
    char* V_lds = lds; char* K_lds = lds + 2 * SHM_V;
    float* ws = (float*)(lds + 2 * SHM_V + 2 * SHM_K) + wid * 64; float* li_l = ws, * al_l = ws + 32;
    float m_reg = -1e30f, l_reg = 0; f32x16 o[4] = {};
    const int sr = tid >> 4, sc = (tid & 15) * 8, vst0 = v_st(sr, sc), vst1 = v_st(32 + sr, sc), kws = KSWZ(sr, sc * 2);
    const int vb0 = (int)(uintptr_t)V_lds + v_rd_base(lane);
    const TIn* Kh = cur.K; const TIn* Vh = cur.V;
    unsigned selmask = 0xffu; const bool moba = cur.qb >= 4;
    {
        float* kml = (float*)(lds + KM_OFF);
        for (int idx = tid; idx < 8 * 128; idx += 64 * NW) { const int n_ = idx >> 7, d_ = idx & 127; kml[idx] = (cur.KM[(size_t)n_ * 2048 + d_] + cur.KM[(size_t)n_ * 2048 + 1024 + d_]) * (1.0f / 256.0f); }
        __syncthreads();
        if (moba) {
            float g[7];
#pragma unroll
            for (int n_ = 0; n_ < 7; ++n_) { float s = 0.f;
                if (n_ < cur.qb) {
#pragma unroll
                    for (int d0 = 0; d0 < 8; ++d0) { const f32x4 k0 = *(const f32x4*)(kml + n_ * 128 + d0 * 16 + hi * 8), k1 = *(const f32x4*)(kml + n_ * 128 + d0 * 16 + hi * 8 + 4);
                        const bf16x8 qv = S.qr[d0];
#define B2F_(x) __uint_as_float(((unsigned)(unsigned short)(x)) << 16)
                        s += (B2F_(qv[0]) * k0[0] + B2F_(qv[1]) * k0[1]) + (B2F_(qv[2]) * k0[2] + B2F_(qv[3]) * k0[3]) + (B2F_(qv[4]) * k1[0] + B2F_(qv[5]) * k1[1]) + (B2F_(qv[6]) * k1[2] + B2F_(qv[7]) * k1[3]);
#undef B2F_
                    } }
                g[n_] = s + __shfl_xor(s, 32); }
            selmask = 0u;
#pragma unroll
            for (int rd = 0; rd < 3; ++rd) { float best = -__builtin_inff(); unsigned bi = 0u;
#pragma unroll
                for (int n_ = 0; n_ < 7; ++n_) { const bool ok = (n_ < cur.qb) && (((selmask >> n_) & 1u) == 0u) && (g[n_] > best); best = ok ? g[n_] : best; bi = ok ? (unsigned)n_ : bi; }
                selmask |= 1u << bi; }
        }
    }
#define RESC(a) do { if (__any((a) < 1.f)) { if (hi == 0) al_l[r32] = (a); asm volatile("s_waitcnt lgkmcnt(0)" ::: "memory");              \
                     for (int d_ = 0; d_ < 4; ++d_) for (int r = 0; r < 16; ++r) o[d_][r] *= al_l[crow(r, hi)]; } } while (0)
#define KBASE(t) ((j_lo + (t)) * KVBLK)
#define ACT(t) (KBASE(t) <= qlo + QBLK - 1 && KBASE(t) + KVBLK - 1 >= qlo - W + 1)
#define MASKT(P0_, P1_, t) do { const int kb_ = KBASE(t); if ((!SK || ACT(t)) && (kb_ + KVBLK - 1 > qlo || kb_ <= qlo + QBLK - 1 - W)) mask_tile(P0_, P1_, qm - kb_, (unsigned)W); \
        if (MOBA_ON && moba && kb_ < cur.P0) { const bool dead_ = ((selmask >> (kb_ >> 8)) & 1u) == 0u; const float NEG_ = -__builtin_inff(); \
            _Pragma("unroll") for (int r_ = 0; r_ < 16; ++r_) { P0_[r_] = dead_ ? NEG_ : P0_[r_]; P1_[r_] = dead_ ? NEG_ : P1_[r_]; } } } while (0)
    constexpr int NQL = F32 ? 16 : 8;
    constexpr bool SK = WSKIP && !F32;
#define SEAM_K0() do { VMWN(NQL); if constexpr (F32) { SWRITE_KF(0); SBAR(); SLOAD_F((const float*)nxt.V, kbn); } else { SWRITE_HK(0); } SBAR(); } while (0)
    f32x16 pA0, pA1, pB0, pB1; float mnA, mnB, alA, alB; bf16x8 pa0, pa1, pa2, pa3;
    if constexpr (F32) { VMW(); SWRITE_VF(0); SBAR(); } else { SWRITE_HV(0); SBAR(); }
    if (NT > 1) { if constexpr (F32) SLOAD_F((const float*)Kh, KBASE(1)); else SLOAD_H(Kh, Vh, KBASE(1)); }
    SBAR(); qkt<0, SK>(pA0, pA1, K_lds, r32, hi, S.qr, ACT(0));
    if constexpr (F32) { if (NT > 1) { VMW(); SWRITE_KF(1); SBAR(); SLOAD_F((const float*)Vh, KBASE(1)); } }
    MASKT(pA0, pA1, 0); partialSM(pA0, pA1, m_reg, mnA, alA);
    if (NT > 1) { VMW(); if constexpr (F32) { SWRITE_VF(1); SBAR(); if (NT > 2) SLOAD_F((const float*)Kh, KBASE(2)); } else SWRITE_H(1); }
    __syncthreads();
#define HALF_STEP(PX0, PX1, mnX, alX, PY0, PY1, alY, t, KB, VB, SB) do {                                                      \
        SBAR(); qkt<KB, SK>(PX0, PX1, K_lds, r32, hi, S.qr, ACT(t));                                             \
        finishSM(PY0, PY1, alY, l_reg, pa0, pa1, pa2, pa3); SBAR();                                                           \
        if ((t) + 1 < NT) { if constexpr (F32) { VMW(); SWRITE_KF(SB); SBAR(); SLOAD_F((const float*)Vh, KBASE((t) + 1)); }  \
                            else { SLOAD_H(Kh, Vh, KBASE((t) + 1)); } SBAR(); }                                               \
        pv_tile<VB, SK>(o, vb0, pa0, pa1, pa2, pa3, ACT((t) - 1)); MASKT(PX0, PX1, (t)); partialSM(PX0, PX1, m_reg, mnX, alX);                                        \
        __syncthreads();                                                                                                      \
        if ((t) + 1 < NT) { VMW(); if constexpr (F32) { SWRITE_VF(SB); SBAR(); if ((t) + 2 < NT) SLOAD_F((const float*)Kh, KBASE((t) + 2)); } \
                            else { SWRITE_H(SB); } }                                                                          \
        RESC(alX); __syncthreads(); } while (0)
    for (int t = 1; t + 1 < NT; t += 2) {
        HALF_STEP(pB0, pB1, mnB, alB, pA0, pA1, alA, t, 1, 0, 0);
        HALF_STEP(pA0, pA1, mnA, alA, pB0, pB1, alB, t + 1, 0, 1, 1);
    }
    const bool even = (NT & 1) == 0;
    if (even) { SBAR(); qkt<1, SK>(pB0, pB1, K_lds, r32, hi, S.qr, ACT(NT - 1)); SBAR(); }
#define QROW(e) (nxt.Q + (size_t)(wid * QBLK + r32) * D + ((e) >> 1) * 16 + hi * 8 + ((e) & 1) * 4)
    if constexpr (F32) { SLOAD_F((const float*)nxt.K, kbn); SBAR();
#pragma unroll
        for (int e = 0; e < 8; ++e) S.tq[e] = *(const f32x4*)QROW(e); }
    else { SLOAD_H(nxt.K, nxt.V, kbn); SBAR();
#pragma unroll
        for (int d0 = 0; d0 < 8; ++d0) S.qr[d0] = load8<TIn>(nxt.Q + (size_t)(wid * QBLK + r32) * D + d0 * 16 + hi * 8); }
    SBAR();
    finishSM(pA0, pA1, alA, l_reg, pa0, pa1, pa2, pa3); SBAR();
    if constexpr (F32) {
#pragma unroll
        for (int e = 8; e < 16; ++e) S.tq[e] = *(const f32x4*)QROW(e); SBAR(); }
#undef QROW
    pv_tile<0, SK>(o, vb0, pa0, pa1, pa2, pa3, ACT(even ? NT - 2 : NT - 1));
    if (even) { MASKT(pB0, pB1, NT - 1); partialSM(pB0, pB1, m_reg, mnB, alB); __syncthreads(); RESC(alB);
        finishSM(pB0, pB1, alB, l_reg, pa0, pa1, pa2, pa3); SBAR(); pv_tile<1, SK>(o, vb0, pa0, pa1, pa2, pa3, ACT(NT - 1)); }
    SBAR(); SEAM_K0();
    if (hi == 0) li_l[r32] = l_reg; asm volatile("s_waitcnt lgkmcnt(0)" ::: "memory");
    float rli[16];
#pragma unroll
    for (int r = 0; r < 16; ++r) rli[r] = __builtin_amdgcn_rcpf(li_l[crow(r, hi)]);
    { unsigned short* stg = (unsigned short*)(lds + STG_OFF) + wid * 4096;
#pragma unroll
      for (int r = 0; r < 16; ++r) { const int orow = crow(r, hi);
#pragma unroll
        for (int d0 = 0; d0 < 4; ++d0) { const float v = o[d0][r] * rli[r]; stg[orow * 128 + d0 * 32 + r32] = (unsigned short)(cvtpk(v, v) & 0xffffu); } }
      asm volatile("s_waitcnt lgkmcnt(0)" ::: "memory");
      unsigned short* Ow = (unsigned short*)cur.O + (size_t)(wid * QBLK) * LDO; const unsigned short* Gw = cur.GA + (size_t)(wid * QBLK) * LDG;
#pragma unroll
      for (int i = 0; i < 8; ++i) { const int row = i * 4 + (lane >> 4), ch = lane & 15;
          const u32x4 ov = *(const u32x4*)(stg + row * 128 + ch * 8); const u32x4 gv = *(const u32x4*)(Gw + (size_t)row * LDG + ch * 8);
          u32x4 w;
#define MULPK_(a, b) cvtpk(__uint_as_float((a) << 16) * __uint_as_float((b) << 16), __uint_as_float((a) & 0xffff0000u) * __uint_as_float((b) & 0xffff0000u))
          w.x = MULPK_(ov.x, gv.x); w.y = MULPK_(ov.y, gv.y); w.z = MULPK_(ov.z, gv.z); w.w = MULPK_(ov.w, gv.w);
#undef MULPK_
          *(u32x4*)(Ow + (size_t)row * LDO + ch * 8) = w; } }
    if constexpr (F32) {
#pragma unroll
        for (int d0 = 0; d0 < 8; ++d0) S.qr[d0] = pack8(S.tq[2 * d0], S.tq[2 * d0 + 1]); }
    __syncthreads();
#undef RESC
#undef KBASE
#undef ACT
#undef MASKT
#undef SEAM_K0
#undef HALF_STEP
}
#undef ROW
#undef VMW
#undef VMWN
#undef SLOAD_H
#undef SWRITE_HK
#undef SWRITE_HV
#undef SWRITE_H
#undef SLOAD_F
#undef SWRITE_KF
#undef SWRITE_VF


typedef BlockRef<bf16, bf16> Ref;
__device__ __forceinline__ Ref make_ref(int L, const bf16* Q, const bf16* K, const bf16* V, bf16* Y, const bf16* GA, const float* KMP) {
    const int bh = L >> 3, qb = L & 7, b = bh >> 3, h = bh & 7; Ref r;
    r.Q = Q + ((size_t)bh * 2048 + (size_t)qb * QB) * D; r.K = K + (size_t)bh * 2048 * D; r.V = V + (size_t)bh * 2048 * D;
    r.O = Y + ((size_t)b * 2048 + (size_t)qb * QB) * LDO + h * 128; r.GA = (const unsigned short*)GA + ((size_t)b * 2048 + (size_t)qb * QB) * LDG + h * 128;
    r.P0 = qb * QB; r.KM = KMP + (size_t)b * 16 * 1024 + h * 128; r.qb = qb; return r;
}
__device__ __forceinline__ void phase(char* lds, const bf16* Q, const bf16* K, const bf16* V, bf16* Y, const bf16* GA, const float* KMP, int vcu, int G) {
    int L = vcu; if (L >= 256) return;
    Ref cur = make_ref(L, Q, K, V, Y, GA, KMP);
    Seam<bf16> S;
    causal_swa_prime<bf16, bf16>(cur, 2048, lds, S);
    for (;;) {
        const int Ln = L + G; const bool last = Ln >= 256;
        const Ref nxt = last ? cur : make_ref(Ln, Q, K, V, Y, GA, KMP);
        causal_swa_block<bf16, bf16>(cur, nxt, 2048, 2048, lds, S);
        if (last) break;
        cur = nxt; L = Ln;
    }
}
#undef KSWZ
#undef SBAR
}
namespace lru {
#define LRU_LAS __attribute__((address_space(3)))
typedef short bf16x8 __attribute__((ext_vector_type(8)));
typedef float f32x4 __attribute__((ext_vector_type(4)));
typedef unsigned u32x4 __attribute__((ext_vector_type(4)));
typedef unsigned u32x2 __attribute__((ext_vector_type(2)));
constexpr int CH = 128  , XCP = 272  ;
constexpr int OFF_XC = 0, OFF_A = CH * XCP, OFF_U = OFF_A + CH * 32 * 4, OFF_SA = OFF_U + CH * 32 * 4, OFF_SH = OFF_SA + 16 * 32 * 4, OFF_C0 = OFF_SH + 16 * 32 * 4, LRU_LDS = OFF_C0 + 2 * 32 * 4;
__device__ __forceinline__ float b2f(unsigned short x) { return __uint_as_float(((unsigned)x) << 16); }
__device__ __forceinline__ unsigned cvtpk(float lo, float hi) { unsigned r; asm volatile("v_cvt_pk_bf16_f32 %0, %1, %2" : "=v"(r) : "v"(lo), "v"(hi)); return r; }
struct Tensors { const unsigned short* XR; const unsigned short* GL; unsigned short* Y; const unsigned short* WrT; const unsigned short* WiT;
                 const float *cw, *cb, *br, *bi, *lam; };
__device__ __forceinline__ void unit(LRU_LAS unsigned char* lds, const Tensors& T, int b, int n, int es) {
    int tid_ = threadIdx.x; asm volatile("" : "+v"(tid_)); const int tid = tid_, lane = tid & 63, wid = __builtin_amdgcn_readfirstlane(tid >> 6), fr = lane & 15, fq = lane >> 4;
    LRU_LAS float* LA = (LRU_LAS float*)(lds + OFF_A); LRU_LAS float* LU = (LRU_LAS float*)(lds + OFF_U);
    LRU_LAS float* SA = (LRU_LAS float*)(lds + OFF_SA); LRU_LAS float* SH = (LRU_LAS float*)(lds + OFF_SH); LRU_LAS float* C0 = (LRU_LAS float*)(lds + OFF_C0);
    const int cg = tid & 15, trow = tid >> 4;
    const int chb = n * 128 + cg * 8;
    float cw[4][8], cb[8];
#pragma unroll
    for (int k = 0; k < 4; ++k) { const f32x4 a = *(const f32x4*)(T.cw + k * 1024 + chb), c = *(const f32x4*)(T.cw + k * 1024 + chb + 4);
#pragma unroll
        for (int j = 0; j < 4; ++j) { cw[k][j] = a[j]; cw[k][4 + j] = c[j]; } }
    { const f32x4 a = *(const f32x4*)(T.cb + chb), c = *(const f32x4*)(T.cb + chb + 4);
#pragma unroll
      for (int j = 0; j < 4; ++j) { cb[j] = a[j]; cb[4 + j] = c[j]; } }
    bf16x8 Br[2][4], Bi[2][4];
#pragma unroll
    for (int nb = 0; nb < 2; ++nb)
#pragma unroll
        for (int ks = 0; ks < 4; ++ks) { const size_t o = ((size_t)n * 128 + es * 32 + nb * 16 + fr) * 128 + ks * 32 + fq * 8;
            Br[nb][ks] = *(const bf16x8*)(T.WrT + o); Bi[nb][ks] = *(const bf16x8*)(T.WiT + o); }
    float gbr[2][4], gbi[2][4], gsp[2][4];
#pragma unroll
    for (int nb = 0; nb < 2; ++nb)
#pragma unroll
        for (int j = 0; j < 4; ++j) { const int ch = n * 128 + es * 32 + nb * 16 + fq * 4 + j; gbr[nb][j] = T.br[ch]; gbi[nb][j] = T.bi[ch];
            const float x = -T.lam[ch]; gsp[nb][j] = 8.0f * (fmaxf(x, 0.f) + log1pf(__expf(-fabsf(x)))); }
    if (tid < 32) C0[tid] = 0.f;
    const int se = tid & 31, sg = tid >> 5;
    const size_t rowb = (size_t)b * 2048;
    for (int c = 0; c < 2048 / CH; ++c) {
#pragma unroll
        for (int i = 0; i < 4; ++i) { const int tok = trow + 32 * i, ta = c * CH + tok;
            float acc8[8];
#pragma unroll
            for (int j = 0; j < 8; ++j) acc8[j] = cb[j];
#pragma unroll
            for (int k = 0; k < 4; ++k) { const int tt = ta - 3 + k;
                u32x4 w = (u32x4){0u, 0u, 0u, 0u};
                if (tt >= 0) w = *(const u32x4*)(T.XR + (rowb + tt) * 1024 + chb);
                acc8[0] += cw[k][0] * __uint_as_float(w.x << 16); acc8[1] += cw[k][1] * __uint_as_float(w.x & 0xffff0000u);
                acc8[2] += cw[k][2] * __uint_as_float(w.y << 16); acc8[3] += cw[k][3] * __uint_as_float(w.y & 0xffff0000u);
                acc8[4] += cw[k][4] * __uint_as_float(w.z << 16); acc8[5] += cw[k][5] * __uint_as_float(w.z & 0xffff0000u);
                acc8[6] += cw[k][6] * __uint_as_float(w.w << 16); acc8[7] += cw[k][7] * __uint_as_float(w.w & 0xffff0000u); }
            u32x4 o; o.x = cvtpk(acc8[0], acc8[1]); o.y = cvtpk(acc8[2], acc8[3]); o.z = cvtpk(acc8[4], acc8[5]); o.w = cvtpk(acc8[6], acc8[7]);
            *(LRU_LAS u32x4*)(lds + OFF_XC + tok * XCP + cg * 16) = o; }
        __syncthreads();
        {
            f32x4 ar[2], ai_[2];
#pragma unroll
            for (int nb = 0; nb < 2; ++nb) { ar[nb] = (f32x4){0.f, 0.f, 0.f, 0.f}; ai_[nb] = (f32x4){0.f, 0.f, 0.f, 0.f}; }
            const int tok = 16 * wid + fr;
#pragma unroll
            for (int ks = 0; ks < 4; ++ks) { const bf16x8 af = *(const LRU_LAS bf16x8*)(lds + OFF_XC + tok * XCP + (ks * 32 + fq * 8) * 2);
#pragma unroll
                for (int nb = 0; nb < 2; ++nb) { ar[nb] = __builtin_amdgcn_mfma_f32_16x16x32_bf16(Br[nb][ks], af, ar[nb], 0, 0, 0);
                                                 ai_[nb] = __builtin_amdgcn_mfma_f32_16x16x32_bf16(Bi[nb][ks], af, ai_[nb], 0, 0, 0); } }
#pragma unroll
            for (int nb = 0; nb < 2; ++nb) {
                const u32x2 xw = *(const LRU_LAS u32x2*)(lds + OFF_XC + tok * XCP + (es * 32 + nb * 16 + fq * 4) * 2);
                const float xv[4] = {__uint_as_float(xw.x << 16), __uint_as_float(xw.x & 0xffff0000u), __uint_as_float(xw.y << 16), __uint_as_float(xw.y & 0xffff0000u)};
                f32x4 av, uv;
#pragma unroll
                for (int j = 0; j < 4; ++j) {
                    const float r = __builtin_amdgcn_rcpf(1.0f + __expf(-(ar[nb][j] + gbr[nb][j])));
                    const float ig = __builtin_amdgcn_rcpf(1.0f + __expf(-(ai_[nb][j] + gbi[nb][j])));
                    const float la = -r * gsp[nb][j];
                    av[j] = __expf(la);
                    uv[j] = sqrtf(-expm1f(2.0f * la)) * (ig * xv[j]);
                }
                *(LRU_LAS f32x4*)(LA + tok * 32 + nb * 16 + fq * 4) = av; *(LRU_LAS f32x4*)(LU + tok * 32 + nb * 16 + fq * 4) = uv;
            }
        }
        __syncthreads();
        float a8[8], u8[8];
        { float A = 1.f, Hh = 0.f;
#pragma unroll
          for (int j = 0; j < 8; ++j) { a8[j] = LA[(sg * 8 + j) * 32 + se]; u8[j] = LU[(sg * 8 + j) * 32 + se]; Hh = a8[j] * Hh + u8[j]; A *= a8[j]; }
          SA[sg * 32 + se] = A; SH[sg * 32 + se] = Hh; }
        __syncthreads();
        { float h = C0[(c & 1) * 32 + se];
          for (int s2 = 0; s2 < sg; ++s2) h = SA[s2 * 32 + se] * h + SH[s2 * 32 + se];
          const size_t chn = (size_t)n * 128 + es * 32 + se;
#pragma unroll
          for (int j = 0; j < 8; ++j) { h = a8[j] * h + u8[j]; const size_t row = rowb + c * CH + sg * 8 + j;
              const float gl = b2f(T.GL[row * 1024 + chn]);
              const float y = h * gl; const float yn = __shfl_xor(y, 1);
              if ((se & 1) == 0) *(unsigned*)(T.Y + row * 2048 + 1024 + chn) = cvtpk(y, yn); }
          if (sg == 15) C0[((c + 1) & 1) * 32 + se] = h; }
    }
    __syncthreads();
}
}

namespace cg = cooperative_groups;
#ifndef REP_P0
#define REP_P0 1
#endif
#ifndef REP_P1
#define REP_P1 1
#endif
#ifndef REP_P2
#define REP_P2 1
#endif
#ifndef REP_P3
#define REP_P3 1
#endif
#ifndef REP_P4
#define REP_P4 1
#endif
#ifndef EXTRA_SYNC
#define EXTRA_SYNC 0
#endif
constexpr int NWAVES = 8;
constexpr int BATCH = 4, SEQ = 2048, DM = 2048, M = BATCH * SEQ, DIN = 10240, AW = 1024, LW = 1024, PLE = 256, NH = 8, HD = 128;
constexpr size_t MiB = 1u << 20;
constexpr size_t WS_BAR = 512 * 1024, BAR_BYTES = 16384;
constexpr size_t WS_KMP = 0, WS_SSQ = 1 * MiB, WS_WRT = 2 * MiB, WS_WIT = 2 * MiB + 256 * 1024, WS_WPLE = 3 * MiB, WS_W2 = 4 * MiB, WS_WOUT = 12 * MiB, WS_WG = 20 * MiB, WS_WIN = 28 * MiB,
                 WS_H = 68 * MiB, WS_MG = 68 * MiB, WS_PB = 100 * MiB, WS_Q = 104 * MiB, WS_K = 120 * MiB, WS_V = 136 * MiB, WS_GA = 152 * MiB, WS_XR = 168 * MiB, WS_GL = 184 * MiB,
                 WS_SA = 200 * MiB, WS_SL = 232 * MiB, WS_Y = 264 * MiB, WS_X1G = 104 * MiB, WS_PL = 136 * MiB, WS_END = 296 * MiB;
static_assert(WS_K == WS_Q + 16 * MiB && WS_V == WS_Q + 32 * MiB && WS_GA == WS_Q + 48 * MiB && WS_XR == WS_Q + 64 * MiB && WS_GL == WS_Q + 80 * MiB && WS_SA == WS_Q + 96 * MiB && WS_SL == WS_SA + 32 * MiB, "EpiG1 destination arithmetic");
constexpr int RING_BYTES = 131072, SCR_OFF = RING_BYTES, KM_LDS_OFF = 69632;
constexpr int LDS_BYTES = 147456, MISC_OFF = LDS_BYTES - 64;
static_assert(attn::STG_OFF + 65536 <= LDS_BYTES && attn::KM_OFF == KM_LDS_OFF && attn::KM_OFF + 4096 <= attn::STG_OFF, "attention LDS map");
static_assert(attn::LDS_BYTES <= KM_LDS_OFF && KM_LDS_OFF + 4096 <= RING_BYTES && lru::LRU_LDS <= RING_BYTES && SCR_OFF + 8192 <= LDS_BYTES, "LDS map");

#define GAS __attribute__((address_space(1)))
#define LAS __attribute__((address_space(3)))
typedef unsigned short bf16;
typedef unsigned v4u __attribute__((ext_vector_type(4)));
typedef float f32x4 __attribute__((ext_vector_type(4)));
#define LDS_WAIT() asm volatile("s_waitcnt lgkmcnt(0)" ::: "memory")
__device__ __forceinline__ unsigned f2bf(float f) { unsigned u = __builtin_bit_cast(unsigned, f); return (u + 0x7fffu + ((u >> 16) & 1u)) >> 16; }
__device__ __forceinline__ unsigned pk2(float lo, float hi) { return f2bf(lo) | (f2bf(hi) << 16); }
__device__ __forceinline__ float wave_sum(float v) {
#pragma unroll
    for (int o = 1; o < 64; o <<= 1) v += __shfl_xor(v, o);
    return v;
}
__device__ __forceinline__ void p0_transpose_item(const float* W, int N, bf16* WT, int ldk, int row_off, int k_off, LAS float* scr, int kb, int nb, int lane) {
    const int k0 = 64 * kb, n0 = 32 * nb;
#pragma unroll 8
    for (int i = 0; i < 32; ++i) { const int kk = 2 * i + (lane >> 5); scr[kk * 33 + (lane & 31)] = W[(size_t)(k0 + kk) * N + n0 + (lane & 31)]; }
    LDS_WAIT(); asm volatile("" ::: "memory");
    const int c = lane & 7;
#pragma unroll
    for (int j = 0; j < 4; ++j) { const int n = (lane >> 3) + 8 * j; const LAS float* s = scr + (8 * c) * 33 + n;
        v4u o; o.x = pk2(s[0 * 33], s[1 * 33]); o.y = pk2(s[2 * 33], s[3 * 33]); o.z = pk2(s[4 * 33], s[5 * 33]); o.w = pk2(s[6 * 33], s[7 * 33]);
        *(GAS v4u*)(WT + (size_t)(row_off + n0 + n) * ldk + k_off + k0 + 8 * c) = o; }
    LDS_WAIT(); asm volatile("" ::: "memory");
}

#define RLX_AGENT __ATOMIC_RELAXED, __HIP_MEMORY_SCOPE_AGENT
#define XB_TMO      128
#define XB_XCNT(j)  (256  + 64 * (j))
#define XB_XSUB(j)  (1280 + 64 * (j))
#define XB_XGEN(j)  (2304 + 64 * (j))
#define XB_TOP      3328
#define XB_TOPGEN   3392
#define XCD_BAR_WORDS 3456
#define XB_SPIN_CAP (1u << 18)

__device__ __forceinline__ unsigned xb_ld(unsigned* p)              { return __hip_atomic_load(p, __ATOMIC_RELAXED, __HIP_MEMORY_SCOPE_AGENT); }
__device__ __forceinline__ unsigned xb_add(unsigned* p, unsigned v) { return __hip_atomic_fetch_add(p, v, __ATOMIC_RELAXED, __HIP_MEMORY_SCOPE_AGENT); }
__device__ __forceinline__ unsigned xb_xcc_id() { return (unsigned)__builtin_amdgcn_s_getreg((3 << 11) | 20) & 0xFu; }
#define XB_SPIN(cond, bar) do { unsigned _sp = 0; while (cond) { __builtin_amdgcn_s_sleep(1); \
    if ((++_sp & 255u) == 0u) { if (xb_ld(&(bar)[XB_TMO])) break; if (_sp > XB_SPIN_CAP) { atomicAdd(&(bar)[XB_TMO], 1u); break; } } } } while (0)

struct XcdBarrier {
    unsigned* bar; unsigned x;
    volatile LAS unsigned* st;
};

__device__ __forceinline__ XcdBarrier xcd_barrier_post(unsigned* bar, volatile LAS unsigned* st) {
    XcdBarrier b; b.bar = bar; b.x = xb_xcc_id(); b.st = st;
    if (threadIdx.x == 0) (void)xb_add(&bar[XB_XCNT(b.x)], 1u);
    return b;
}
__device__ __forceinline__ void xcd_barrier_complete(unsigned* bar, unsigned x, unsigned& nloc, unsigned& nx) {
    const unsigned G = gridDim.x * gridDim.y * gridDim.z;
    unsigned sum, cnt, mine, sp = 0u;
    for (;;) {
        sum = 0u; cnt = 0u; mine = 0u;
#pragma unroll
        for (unsigned j = 0; j < 16; ++j) { const unsigned c = xb_ld(&bar[XB_XCNT(j)]); sum += c; cnt += (c > 0u) ? 1u : 0u; mine = (j == x) ? c : mine; }
        if (sum == G) break;
        __builtin_amdgcn_s_sleep(1);
        if ((++sp & 255u) == 0u) { if (xb_ld(&bar[XB_TMO])) break; if (sp > XB_SPIN_CAP) { atomicAdd(&bar[XB_TMO], 1u); break; } }
    }
    nloc = mine > 0u ? mine : 1u; nx = cnt > 0u ? cnt : 1u;
}

__device__ __forceinline__ void xcd_barrier(const XcdBarrier& b) {
    asm volatile("s_waitcnt vmcnt(0)" ::: "memory");
    __syncthreads();
    if (threadIdx.x == 0) {
        unsigned* bar = b.bar;
        __builtin_amdgcn_s_waitcnt(0);
        unsigned nloc = b.st[0], nx = b.st[1];
        if (nloc == 0u) { xcd_barrier_complete(bar, b.x, nloc, nx); b.st[0] = nloc; b.st[1] = nx; }
        const unsigned old = xb_add(&bar[XB_XSUB(b.x)], 1u);
        const unsigned gen = old / nloc;
        if (old + 1u == (gen + 1u) * nloc) {
            __builtin_amdgcn_fence(__ATOMIC_RELEASE, "agent");
            asm volatile("s_waitcnt vmcnt(0)" ::: "memory");
            const unsigned og = xb_add(&bar[XB_TOP], 1u);
            const unsigned tg = og / nx;
            if (og + 1u == (tg + 1u) * nx) xb_add(&bar[XB_TOPGEN], 1u);
            else XB_SPIN(xb_ld(&bar[XB_TOPGEN]) == tg, bar);
            __builtin_amdgcn_fence(__ATOMIC_ACQUIRE, "agent");
            xb_add(&bar[XB_XGEN(b.x)], 1u);
            asm volatile("s_waitcnt vmcnt(0)" ::: "memory");
        } else {
            XB_SPIN(xb_ld(&bar[XB_XGEN(b.x)]) == gen, bar);
            __builtin_amdgcn_fence(__ATOMIC_ACQUIRE, "agent");
            asm volatile("s_waitcnt vmcnt(0)" ::: "memory");
        }
    }
    __syncthreads();
}

struct Args { const float* in[20]; float* out; unsigned char* ws; };

__global__ void __launch_bounds__(NWAVES * 64, 2) moba_rglru_fwd(Args args) {
    extern __shared__ __attribute__((aligned(16))) unsigned char lds[];
    cg::grid_group grid = cg::this_grid();
    LAS unsigned char* ldsl = (LAS unsigned char*)lds;
    const int tid = threadIdx.x, lane = tid & 63, wave = __builtin_amdgcn_readfirstlane(tid >> 6);
    const int G = gridDim.x; const int bx = blockIdx.x; const int vcu = (G % 8 == 0) ? (bx % 8) * (G / 8) + bx / 8 : bx;
    unsigned char* ws = args.ws;
    volatile LAS unsigned* MISC = (volatile LAS unsigned*)(ldsl + MISC_OFF);
    if (tid < 16) MISC[tid] = 0u;
    __syncthreads();
    XcdBarrier bar = xcd_barrier_post((unsigned*)(ws + WS_BAR), MISC);
    if (G > (1 << 20)) grid.sync();
#define GRID_BAR() xcd_barrier(bar)
    bf16* Win_t = (bf16*)(ws + WS_WIN); bf16* W2_t = (bf16*)(ws + WS_W2); bf16* Wout_t = (bf16*)(ws + WS_WOUT); bf16* Wg_t = (bf16*)(ws + WS_WG); bf16* Wple_t = (bf16*)(ws + WS_WPLE);
    bf16* Wr_t = (bf16*)(ws + WS_WRT); bf16* Wi_t = (bf16*)(ws + WS_WIT);
    bf16* Hb = (bf16*)(ws + WS_H); bf16* MG = (bf16*)(ws + WS_MG); bf16* PB = (bf16*)(ws + WS_PB);
    bf16* Qb = (bf16*)(ws + WS_Q); bf16* Kb = (bf16*)(ws + WS_K); bf16* Vb = (bf16*)(ws + WS_V); bf16* GA = (bf16*)(ws + WS_GA); bf16* XR = (bf16*)(ws + WS_XR); bf16* GL = (bf16*)(ws + WS_GL);
    bf16* SAb = (bf16*)(ws + WS_SA); bf16* SLb = (bf16*)(ws + WS_SL); bf16* Yb = (bf16*)(ws + WS_Y); bf16* X1G = (bf16*)(ws + WS_X1G); bf16* PL = (bf16*)(ws + WS_PL);
    float* KMP = (float*)(ws + WS_KMP); float* SSQ = (float*)(ws + WS_SSQ);

#ifndef SKIP_P0
    for (int rep_ = 0; rep_ < REP_P0; ++rep_) {
    {
        LAS float* scr = (LAS float*)(ldsl + wave * 16384);
        const int gw = vcu * NWAVES + wave, NGW = G * NWAVES;
        constexpr int I0 = 32 * 320, I1 = 16 * 64, I2 = 16 * 64, I3 = 32 * 64, I4 = 32 * 64, I5 = 4 * 64, I6 = 64, I7 = 64;
        constexpr int NITEMS = I0 + I1 + I2 + I3 + I4 + I5 + I6 + I7;
        for (int it = gw; it < NITEMS; it += NGW) {
            int r = it;
            if (r < I0) { p0_transpose_item(args.in[3], DIN, Win_t, 2048, 0, 0, scr, r / 320, r % 320, lane); continue; } r -= I0;
            if (r < I1) { p0_transpose_item(args.in[13], DM, W2_t, 2048, 0, 0, scr, r / 64, r % 64, lane); continue; } r -= I1;
            if (r < I2) { p0_transpose_item(args.in[14], DM, W2_t, 2048, 0, 1024, scr, r / 64, r % 64, lane); continue; } r -= I2;
            if (r < I3) { p0_transpose_item(args.in[15], DM, Wout_t, 2048, 0, 0, scr, r / 64, r % 64, lane); continue; } r -= I3;
            if (r < I4) { p0_transpose_item(args.in[17], DM, Wg_t, 2048, 0, 0, scr, r / 64, r % 64, lane); continue; } r -= I4;
            if (r < I5) { p0_transpose_item(args.in[19], DM, Wple_t, 256, 0, 0, scr, r / 64, r % 64, lane); continue; } r -= I5;
            if (r < I6) { const int n = r >> 3, s = r & 7; p0_transpose_item(args.in[8] + (size_t)n * 16384, 128, Wr_t, 128, n * 128, 0, scr, s >> 2, s & 3, lane); continue; } r -= I6;
            { const int n = r >> 3, s = r & 7; p0_transpose_item(args.in[10] + (size_t)n * 16384, 128, Wi_t, 128, n * 128, 0, scr, s >> 2, s & 3, lane); }
        }
        const float* x = args.in[0]; const float* ng = args.in[2];
        for (int m = gw; m < M; m += NGW) {
            const GAS f32x4* xr = (const GAS f32x4*)(x + (size_t)m * DM) + lane; const GAS f32x4* gr = (const GAS f32x4*)ng + lane;
            f32x4 v[8]; float s = 0.f;
#pragma unroll
            for (int j = 0; j < 8; ++j) { v[j] = xr[64 * j]; s += (v[j].x * v[j].x + v[j].y * v[j].y) + (v[j].z * v[j].z + v[j].w * v[j].w); }
            const float rstd = 1.0f / sqrtf(wave_sum(s) * (1.0f / DM) + 1e-6f);
            GAS unsigned long long* o8 = (GAS unsigned long long*)(Hb + (size_t)m * DM) + lane;
#pragma unroll
            for (int j = 0; j < 8; ++j) { const f32x4 g = gr[64 * j];
                o8[64 * j] = (unsigned long long)pk2(v[j].x * rstd * g.x, v[j].y * rstd * g.y) | ((unsigned long long)pk2(v[j].z * rstd * g.z, v[j].w * rstd * g.w) << 32); }
        }
        const float* p = args.in[1];
        for (int m = gw; m < M; m += NGW) {
            const f32x4 v = ((const GAS f32x4*)(p + (size_t)m * PLE))[lane];
            ((GAS unsigned long long*)(PB + (size_t)m * PLE))[lane] = (unsigned long long)pk2(v.x, v.y) | ((unsigned long long)pk2(v.z, v.w) << 32);
        }
    }
    }
#endif
    GRID_BAR();

    for (int es_ = 0; es_ < EXTRA_SYNC; ++es_) GRID_BAR();
#ifndef SKIP_P1
    for (int rep_ = 0; rep_ < REP_P1; ++rep_) {
    {
        pg8::Gemm g{Hb, Win_t, M, DIN, DM}; pg8::StaticOrder S; S.init(M, DIN, G, bx);
        pg8::EpiG1 E{ws + WS_Q, KMP, args.in[4], args.in[5], (LAS float*)(ldsl + SCR_OFF), 0};
        pg8::gemm_phase<pg8::EpiG1, pg8::StaticOrder, true, true>(ldsl, g, S, E);
    }
    }
#endif
    GRID_BAR();

#ifndef SKIP_P2
    for (int rep_ = 0; rep_ < REP_P2; ++rep_) {
    {
#ifndef SKIP_LRU
        for (int L = vcu; L < 256; L += G) {
            if ((L & 7) < 4) { const int idx = (L >> 3) * 4 + (L & 7);
                lru::Tensors T{XR, GL, Yb, Wr_t, Wi_t, args.in[6], args.in[7], args.in[9], args.in[11], args.in[12]};
                lru::unit(ldsl, T, idx >> 5, (idx >> 2) & 7, idx & 3); }
        }
#endif
#ifndef SKIP_ATTN
        attn::phase((char*)lds, (const attn::bf16*)Qb, (const attn::bf16*)Kb, (const attn::bf16*)Vb, (attn::bf16*)Yb, (const attn::bf16*)GA, KMP, vcu, G);
#endif
    }
    }
#endif
    GRID_BAR();

#ifndef SKIP_P3
    for (int rep_ = 0; rep_ < REP_P3; ++rep_) {
    {
        pg8::Gemm g{Yb, W2_t, M, DM, DM}; pg8::StaticOrder S; S.init(M, DM, G, bx);
        pg8::EpiG2 E{SAb, SLb, MG, 16};
        pg8::gemm_phase<pg8::EpiG2, pg8::StaticOrder, true, true>(ldsl, g, S, E);
    }
    }
#endif
    GRID_BAR();

#ifndef SKIP_P4
    for (int rep_ = 0; rep_ < REP_P4; ++rep_) {
    {
        pg8::Gemm g{MG, Wout_t, M, DM, DM}; pg8::StaticOrder S; S.init(M, DM, G, bx);
        pg8::EpiG3 E{args.in[0], args.out, X1G, SSQ, args.in[16], 0};
        pg8::gemm_phase<pg8::EpiG3, pg8::StaticOrder, true, true>(ldsl, g, S, E);
    }
    }
#endif
    GRID_BAR();

#ifndef SKIP_P5
    {
        { pg8::Gemm g{PB, Wple_t, M, DM, PLE}; pg8::StaticOrder S; S.init(M, DM, G, bx);
          pg8::EpiG4a E{PL, 0};
          pg8::gemm_phase<pg8::EpiG4a, pg8::StaticOrder, true, true>(ldsl, g, S, E); }
        asm volatile("s_waitcnt vmcnt(0)" ::: "memory"); __syncthreads();
        { pg8::Gemm g{X1G, Wg_t, M, DM, DM}; pg8::StaticOrder S; S.init(M, DM, G, bx);
          pg8::EpiG4b E{args.out, PL, SSQ, args.in[18], (LAS float*)(ldsl + SCR_OFF), 0};
          pg8::gemm_phase<pg8::EpiG4b, pg8::StaticOrder, true, true>(ldsl, g, S, E); }
    }
#endif
}

extern "C" void kernel_launch(void* const* d_in, const int* in_sizes, int n_in, void* d_out, int out_size, void* d_ws, size_t ws_size, hipStream_t stream) {
    static int grid_blocks = 0;
    if (grid_blocks == 0) {
        if (n_in != 20 || in_sizes[0] != M * DM || out_size != M * DM || ws_size < WS_END) { fprintf(stderr, "kernel_launch: unexpected shapes (n_in %d, in0 %d, out %d, ws %zu)\n", n_in, n_in > 0 ? in_sizes[0] : -1, out_size, ws_size); grid_blocks = -1; return; }
        int dev = 0, cus = 0, per_cu = 0;
        (void)hipGetDevice(&dev);
        (void)hipDeviceGetAttribute(&cus, hipDeviceAttributeMultiprocessorCount, dev);
        if (hipFuncSetAttribute((const void*)moba_rglru_fwd, hipFuncAttributeMaxDynamicSharedMemorySize, LDS_BYTES) != hipSuccess) { fprintf(stderr, "kernel_launch: hipFuncSetAttribute failed\n"); }
        if (hipOccupancyMaxActiveBlocksPerMultiprocessor(&per_cu, (const void*)moba_rglru_fwd, NWAVES * 64, LDS_BYTES) != hipSuccess || per_cu < 1) { fprintf(stderr, "kernel_launch: occupancy query failed (%d)\n", per_cu); per_cu = 1; }
        (void)hipGetLastError();
        if (per_cu > 1) per_cu = 1;
        grid_blocks = cus * per_cu;
        if (grid_blocks > 256) grid_blocks = 256;
    }
    if (grid_blocks < 0) return;
    if (hipMemsetAsync((char*)d_ws + WS_BAR, 0, BAR_BYTES, stream) != hipSuccess) { fprintf(stderr, "kernel_launch: hipMemsetAsync failed\n"); return; }
    Args a{};
    for (int i = 0; i < 20; ++i) a.in[i] = (const float*)d_in[i];
    a.out = (float*)d_out; a.ws = (unsigned char*)d_ws;
    void* kargs[] = {&a};
    hipError_t e = hipLaunchCooperativeKernel((const void*)moba_rglru_fwd, dim3(grid_blocks), dim3(NWAVES * 64), kargs, LDS_BYTES, stream);
    if (e != hipSuccess) fprintf(stderr, "cooperative launch failed: %s (grid %d)\n", hipGetErrorString(e), grid_blocks);
}
```

```cpp
#include <hip/hip_runtime.h>
#include <hip/hip_bf16.h>
#include <hip/hip_cooperative_groups.h>
#include <cstdio>
#include <cstdint>
#include <cmath>
namespace pg8 {
#define PG8_LAS __attribute__((address_space(3)))
typedef unsigned short bf16_t;
typedef short bf16x8 __attribute__((ext_vector_type(8)));
typedef float f32x4 __attribute__((ext_vector_type(4)));
typedef unsigned u32x4 __attribute__((ext_vector_type(4)));
constexpr int BM = 256, BK = 64, HALF = 128, HTB = HALF * BK * 2  , STAGE_BYTES = 8 * HTB, NXCD = 8, WGM = 8;

__host__ __device__ __forceinline__ int lds_byte(int r, int c) { const int st = (r >> 4) * 2 + (c >> 5), rr = r & 15, cc = c & 31, ob = rr * 64 + cc * 2; return st * 1024 + (ob ^ (((ob >> 9) & 1) << 5)); }
__host__ __device__ __forceinline__ void stage_rc(int b, int& R, int& C) { const int st = b / 1024, sb = b % 1024, swz = sb ^ (((sb >> 9) & 1) << 5); R = (st >> 1) * 16 + swz / 64; C = (st & 1) * 32 + (swz % 64) / 2; }
__host__ __device__ __forceinline__ int perm32(int rho) { const int n = rho >> 4, i = rho & 15; return 8 * (i >> 2) + 4 * n + (i & 3); }

struct Unit { int pm, pn; };
struct Gemm { const bf16_t* A; const bf16_t* Bt; int M, N, K; };

struct StaticOrder {
    int nM, nN, nwg, G, c;
    __host__ __device__ void init(int M, int N, int G_, int c_) { nM = M / BM; nN = N / BM; nwg = nM * nN; G = G_; c = c_; }
    __host__ __device__ bool next(int i, Unit& u) const {
        const long L = (long)i * G + c; if (L >= nwg) return false;
        int wgid = (int)L; { const int q = nwg / NXCD, r = nwg % NXCD, xcd = wgid % NXCD, off = wgid / NXCD; wgid = (xcd < r ? xcd * (q + 1) : r * (q + 1) + (xcd - r) * q) + off; }
        const int nig = WGM * nN, gid = wgid / nig, fm = gid * WGM, gsz = (nM - fm) < WGM ? (nM - fm) : WGM;
        u.pm = fm + ((wgid % nig) % gsz); u.pn = (wgid % nig) / gsz; return true;
    }
    __device__ __forceinline__ void a_ready(const Unit&) const {}
    __device__ __forceinline__ void done(const Unit&) const {}
};

__device__ __forceinline__ unsigned cvt_pk_bf16(float lo, float hi) { unsigned r; asm volatile("v_cvt_pk_bf16_f32 %0, %1, %2" : "=v"(r) : "v"(lo), "v"(hi)); return r; }
__device__ __forceinline__ float bf_lo(unsigned w) { return __uint_as_float(w << 16); }
__device__ __forceinline__ float bf_hi(unsigned w) { return __uint_as_float(w & 0xffff0000u); }
__device__ __forceinline__ float sigmoidf_(float x) { return __builtin_amdgcn_rcpf(1.0f + __expf(-x)); }
__device__ __forceinline__ float siluf_(float x) { return x * __builtin_amdgcn_rcpf(1.0f + __expf(-x)); }
__device__ __forceinline__ u32x4 pack8bf(const f32x4& v0, const f32x4& v1) { u32x4 w; w.x = cvt_pk_bf16(v0[0], v0[1]); w.y = cvt_pk_bf16(v0[2], v0[3]); w.z = cvt_pk_bf16(v1[0], v1[1]); w.w = cvt_pk_bf16(v1[2], v1[3]); return w; }
__device__ __forceinline__ void unpack8bf(const u32x4& w, f32x4& v0, f32x4& v1) { v0 = (f32x4){bf_lo(w.x), bf_hi(w.x), bf_lo(w.y), bf_hi(w.y)}; v1 = (f32x4){bf_lo(w.z), bf_hi(w.z), bf_lo(w.w), bf_hi(w.w)}; }

constexpr int SEQ_ = 2048, NHEAD_ = 8;
struct EpiG1 {
    static constexpr bool PERM = true, AFTER_DRAIN = false, HOOK = false;
    unsigned char* wsQ; float* KMP; const float *qg, *kg; PG8_LAS float* scr; int hook_t;
    __device__ __forceinline__ void mid(f32x4 (&acc)[2][2][4][2], const Unit& u, int wr, int wc, int fr, int fq) const {}
    __device__ __forceinline__ void operator()(f32x4 (&acc)[2][2][4][2], const Unit& u, int wr, int wc, int fr, int fq) const {
        const int pn = u.pn; asm volatile("" : "+v"(fr), "+v"(fq));
        if (pn < 12) {
            if (pn < 8) {
#pragma unroll
                for (int ai = 0; ai < 2; ++ai)
#pragma unroll
                    for (int m = 0; m < 4; ++m)
#pragma unroll
                        for (int bj = 0; bj < 2; ++bj) {
                            const f32x4 a = acc[ai][bj][m][0], b = acc[ai][bj][m][1];
                            float s = (a[0] * a[0] + a[1] * a[1]) + (a[2] * a[2] + a[3] * a[3]) + (b[0] * b[0] + b[1] * b[1]) + (b[2] * b[2] + b[3] * b[3]);
                            s += __shfl_xor(s, 16); s += __shfl_xor(s, 32);
                            if (fq == 0) scr[((ai * HALF + wr * 64 + m * 16 + fr) * 2 + bj) * 4 + wc] = s;
                        }
                asm volatile("s_waitcnt lgkmcnt(0)" ::: "memory"); __builtin_amdgcn_s_barrier(); asm volatile("" ::: "memory");
                const f32x4 gq0 = *(const f32x4*)(qg + wc * 32 + 8 * fq), gq1 = *(const f32x4*)(qg + wc * 32 + 8 * fq + 4);
                const f32x4 gk0 = *(const f32x4*)(kg + wc * 32 + 8 * fq), gk1 = *(const f32x4*)(kg + wc * 32 + 8 * fq + 4);
                const f32x4 g0 = (pn < 4) ? gq0 : gk0, g1 = (pn < 4) ? gq1 : gk1;
#pragma unroll
                for (int ai = 0; ai < 2; ++ai)
#pragma unroll
                    for (int m = 0; m < 4; ++m)
#pragma unroll
                        for (int bj = 0; bj < 2; ++bj) {
                            const f32x4 p = *(const PG8_LAS f32x4*)(scr + ((ai * HALF + wr * 64 + m * 16 + fr) * 2 + bj) * 4);
                            const float rstd = __builtin_amdgcn_rsqf(((p[0] + p[1]) + (p[2] + p[3])) * (1.0f / 128.0f) + 1e-6f);
                            acc[ai][bj][m][0] = acc[ai][bj][m][0] * rstd * g0; acc[ai][bj][m][1] = acc[ai][bj][m][1] * rstd * g1;
                        }
                if (pn >= 4) {
#pragma unroll
                    for (int bj = 0; bj < 2; ++bj)
#pragma unroll
                        for (int n = 0; n < 2; ++n) {
                            f32x4 cs = (f32x4){0.f, 0.f, 0.f, 0.f};
#pragma unroll
                            for (int ai = 0; ai < 2; ++ai)
#pragma unroll
                                for (int m = 0; m < 4; ++m) cs += acc[ai][bj][m][n];
#pragma unroll
                            for (int o = 1; o < 16; o <<= 1) { cs[0] += __shfl_xor(cs[0], o); cs[1] += __shfl_xor(cs[1], o); cs[2] += __shfl_xor(cs[2], o); cs[3] += __shfl_xor(cs[3], o); }
                            if (fr == 0) *(f32x4*)(KMP + (size_t)(u.pm * 2 + wr) * 1024 + (pn - 4) * 256 + bj * HALF + wc * 32 + 8 * fq + 4 * n) = cs;
                        }
                }
            }
            bf16_t* base = (bf16_t*)(wsQ + (size_t)(pn >> 2) * (16u << 20));
            const int b = u.pm >> 3, s0 = (u.pm & 7) * 256 + wr * 64 + fr;
#pragma unroll
            for (int bj = 0; bj < 2; ++bj) {
                const int h = 2 * (pn & 3) + bj;
                bf16_t* hp = base + ((size_t)(b * NHEAD_ + h) * SEQ_ + s0) * 128 + wc * 32 + 8 * fq;
#pragma unroll
                for (int ai = 0; ai < 2; ++ai)
#pragma unroll
                    for (int m = 0; m < 4; ++m) *(u32x4*)(hp + (size_t)(ai * HALF + m * 16) * 128) = pack8bf(acc[ai][bj][m][0], acc[ai][bj][m][1]);
            }
        } else {
            bf16_t* base; int ldc, colt, act;
            if (pn < 24) { base = (bf16_t*)(wsQ + (size_t)(pn >> 2) * (16u << 20)); ldc = 1024; colt = (pn & 3) * 256; act = ((pn >> 2) == 4) ? 0 : 1; }
            else { base = (bf16_t*)(wsQ + (size_t)(96u << 20) + (size_t)((pn - 24) >> 3) * (32u << 20)); ldc = 2048; colt = ((pn - 24) & 7) * 256; act = 2; }
            const int row0 = u.pm * BM + wr * 64 + fr, col0 = colt + wc * 32 + 8 * fq;
#pragma unroll
            for (int ai = 0; ai < 2; ++ai)
#pragma unroll
                for (int m = 0; m < 4; ++m) { bf16_t* rowp = base + (size_t)(row0 + ai * HALF + m * 16) * ldc + col0;
#pragma unroll
                    for (int bj = 0; bj < 2; ++bj) { f32x4 v0 = acc[ai][bj][m][0], v1 = acc[ai][bj][m][1];
                        if (act != 0) {
#pragma unroll
                            for (int j = 0; j < 4; ++j) { const float e0 = __builtin_amdgcn_rcpf(1.0f + __expf(-v0[j])), e1 = __builtin_amdgcn_rcpf(1.0f + __expf(-v1[j]));
                                v0[j] = (act == 1) ? v0[j] * e0 : e0; v1[j] = (act == 1) ? v1[j] * e1 : e1; } }
                        *(u32x4*)(rowp + bj * HALF) = pack8bf(v0, v1); } }
        }
    }
};

struct EpiG2 {
    static constexpr bool PERM = true, AFTER_DRAIN = false, HOOK = true;
    const bf16_t *SA, *SL; bf16_t* MG; int hook_t;
    __device__ __forceinline__ void mid(f32x4 (&acc)[2][2][4][2], const Unit& u, int wr, int wc, int fr, int fq) const {
        asm volatile("" : "+v"(fr), "+v"(fq)); const int row0 = u.pm * BM + wr * 64 + fr, col0 = u.pn * BM + wc * 32 + 8 * fq;
#pragma unroll
        for (int ai = 0; ai < 2; ++ai)
#pragma unroll
            for (int m = 0; m < 4; ++m) { const size_t off = (size_t)(row0 + ai * HALF + m * 16) * 2048 + col0;
#pragma unroll
                for (int bj = 0; bj < 2; ++bj) {
                    const u32x4 wa = *(const u32x4*)(SA + off + bj * HALF), wl = *(const u32x4*)(SL + off + bj * HALF);
                    f32x4 a0, a1, l0, l1; unpack8bf(wa, a0, a1); unpack8bf(wl, l0, l1);
#pragma unroll
                    for (int j = 0; j < 4; ++j) { acc[ai][bj][m][0][j] *= a0[j] * __builtin_amdgcn_rcpf(l0[j]); acc[ai][bj][m][1][j] *= a1[j] * __builtin_amdgcn_rcpf(l1[j]); }
                }
                if (m & 1) asm volatile("" ::: "memory"); }
    }
    __device__ __forceinline__ void operator()(f32x4 (&acc)[2][2][4][2], const Unit& u, int wr, int wc, int fr, int fq) const {
        asm volatile("" : "+v"(fr), "+v"(fq)); const int row0 = u.pm * BM + wr * 64 + fr, col0 = u.pn * BM + wc * 32 + 8 * fq;
#pragma unroll
        for (int ai = 0; ai < 2; ++ai)
#pragma unroll
            for (int m = 0; m < 4; ++m) { const size_t off = (size_t)(row0 + ai * HALF + m * 16) * 2048 + col0;
#pragma unroll
                for (int bj = 0; bj < 2; ++bj) {
                    const u32x4 wl = *(const u32x4*)(SL + off + bj * HALF);
                    f32x4 l0, l1; unpack8bf(wl, l0, l1);
                    *(u32x4*)(MG + off + bj * HALF) = pack8bf(acc[ai][bj][m][0] * l0, acc[ai][bj][m][1] * l1);
                } }
    }
};

struct EpiG3 {
    static constexpr bool PERM = true, AFTER_DRAIN = false, HOOK = false;
    const float* X; float* OUT; bf16_t* X1G; float* SSQ; const float* gple; int hook_t;
    __device__ __forceinline__ void mid(f32x4 (&acc)[2][2][4][2], const Unit& u, int wr, int wc, int fr, int fq) const {}
    __device__ __forceinline__ void operator()(f32x4 (&acc)[2][2][4][2], const Unit& u, int wr, int wc, int fr, int fq) const {
        asm volatile("" : "+v"(fr), "+v"(fq)); const int row0 = u.pm * BM + wr * 64 + fr, col0 = u.pn * BM + wc * 32 + 8 * fq;
        f32x4 gv[2][2];
#pragma unroll
        for (int bj = 0; bj < 2; ++bj) { gv[bj][0] = *(const f32x4*)(gple + col0 + bj * HALF); gv[bj][1] = *(const f32x4*)(gple + col0 + bj * HALF + 4); }
#pragma unroll
        for (int ai = 0; ai < 2; ++ai)
#pragma unroll
            for (int m = 0; m < 4; ++m) { const int row = row0 + ai * HALF + m * 16; const size_t off = (size_t)row * 2048 + col0; float s = 0.f;
#pragma unroll
                for (int bj = 0; bj < 2; ++bj) {
                    const f32x4 x0 = *(const f32x4*)(X + off + bj * HALF) + acc[ai][bj][m][0], x1 = *(const f32x4*)(X + off + bj * HALF + 4) + acc[ai][bj][m][1];
                    *(f32x4*)(OUT + off + bj * HALF) = x0; *(f32x4*)(OUT + off + bj * HALF + 4) = x1;
                    s += (x0[0] * x0[0] + x0[1] * x0[1]) + (x0[2] * x0[2] + x0[3] * x0[3]) + (x1[0] * x1[0] + x1[1] * x1[1]) + (x1[2] * x1[2] + x1[3] * x1[3]);
                    *(u32x4*)(X1G + off + bj * HALF) = pack8bf(x0 * gv[bj][0], x1 * gv[bj][1]);
                }
                s += __shfl_xor(s, 16); s += __shfl_xor(s, 32);
                if (fq == 0) SSQ[(size_t)row * 32 + u.pn * 4 + wc] = s;
            }
    }
};

struct EpiG4a {
    static constexpr bool PERM = true, AFTER_DRAIN = false, HOOK = false;
    bf16_t* PL; int hook_t;
    __device__ __forceinline__ void mid(f32x4 (&acc)[2][2][4][2], const Unit& u, int wr, int wc, int fr, int fq) const {}
    __device__ __forceinline__ void operator()(f32x4 (&acc)[2][2][4][2], const Unit& u, int wr, int wc, int fr, int fq) const {
        asm volatile("" : "+v"(fr), "+v"(fq)); const int row0 = u.pm * BM + wr * 64 + fr, col0 = u.pn * BM + wc * 32 + 8 * fq;
#pragma unroll
        for (int ai = 0; ai < 2; ++ai)
#pragma unroll
            for (int m = 0; m < 4; ++m) { const size_t off = (size_t)(row0 + ai * HALF + m * 16) * 2048 + col0;
#pragma unroll
                for (int bj = 0; bj < 2; ++bj) *(u32x4*)(PL + off + bj * HALF) = pack8bf(acc[ai][bj][m][0], acc[ai][bj][m][1]); }
    }
};

struct EpiG4b {
    static constexpr bool PERM = true, AFTER_DRAIN = false, HOOK = false;
    float* OUT; const bf16_t* PL; const float* SSQ; const float* bias; PG8_LAS float* scr; int hook_t;
    __device__ __forceinline__ void mid(f32x4 (&acc)[2][2][4][2], const Unit& u, int wr, int wc, int fr, int fq) const {}
    __device__ __forceinline__ void operator()(f32x4 (&acc)[2][2][4][2], const Unit& u, int wr, int wc, int fr, int fq) const {
        asm volatile("" : "+v"(fr), "+v"(fq)); const int row0 = u.pm * BM + wr * 64 + fr, col0 = u.pn * BM + wc * 32 + 8 * fq;
        {
            const int tid = threadIdx.x, hf = tid & 1; int rr = tid >> 1; asm volatile("" : "+v"(rr));
            f32x4 t = (f32x4){0.f, 0.f, 0.f, 0.f};
#pragma unroll
            for (int i = 0; i < 4; ++i) t += *(const f32x4*)(SSQ + (size_t)(u.pm * BM + rr) * 32 + hf * 16 + 4 * i);
            float s = (t[0] + t[1]) + (t[2] + t[3]); s += __shfl_xor(s, 1);
            if (hf == 0) scr[rr] = __builtin_amdgcn_rsqf(s * (1.0f / 2048.0f) + 1e-6f);
            asm volatile("s_waitcnt lgkmcnt(0)" ::: "memory"); __builtin_amdgcn_s_barrier(); asm volatile("" ::: "memory");
        }
        f32x4 bv[2][2];
#pragma unroll
        for (int bj = 0; bj < 2; ++bj) { bv[bj][0] = *(const f32x4*)(bias + col0 + bj * HALF); bv[bj][1] = *(const f32x4*)(bias + col0 + bj * HALF + 4); }
#pragma unroll
        for (int ai = 0; ai < 2; ++ai)
#pragma unroll
            for (int m = 0; m < 4; ++m) { const int row = row0 + ai * HALF + m * 16; const size_t off = (size_t)row * 2048 + col0;
                const float rstd = scr[ai * HALF + wr * 64 + m * 16 + fr];
#pragma unroll
                for (int bj = 0; bj < 2; ++bj) {
                    const u32x4 wp = *(const u32x4*)(PL + off + bj * HALF); f32x4 p0, p1; unpack8bf(wp, p0, p1);
                    f32x4 x0 = *(const f32x4*)(OUT + off + bj * HALF), x1 = *(const f32x4*)(OUT + off + bj * HALF + 4);
                    const f32x4 z0 = acc[ai][bj][m][0] * rstd + bv[bj][0], z1 = acc[ai][bj][m][1] * rstd + bv[bj][1];
#pragma unroll
                    for (int j = 0; j < 4; ++j) { x0[j] += p0[j] * sigmoidf_(z0[j]); x1[j] += p1[j] * sigmoidf_(z1[j]); }
                    *(f32x4*)(OUT + off + bj * HALF) = x0; *(f32x4*)(OUT + off + bj * HALF + 4) = x1;
                }
                if (m & 1) asm volatile("" ::: "memory"); }
    }
};
template <class Epi, class Sched, bool ALIGN_EPI = false, bool SP2 = false>
__device__ __forceinline__ void gemm_phase(PG8_LAS unsigned char* lds, const Gemm g, const Sched& S, const Epi& E) {
    int tid_ = threadIdx.x; asm volatile("" : "+v"(tid_)); const int tid = tid_, wid = __builtin_amdgcn_readfirstlane(tid >> 6), lane = tid & 63, wr = wid >> 2, wc = wid & 3, fr = lane & 15, fq = lane >> 4;
    const int K = g.K, nt = K / BK;
    unsigned voffA[2], voffB[2];
#pragma unroll
    for (int i = 0; i < 2; ++i) { int R, C; stage_rc(tid * 16 + i * 8192, R, C); const int Rb = Epi::PERM ? ((R & ~31) + perm32(R & 31)) : R;
        voffA[i] = (unsigned)(R * K + C) * 2u; voffB[i] = (unsigned)(Rb * K + C) * 2u; }
    const size_t kstep = (size_t)(BK * 2);
    const size_t hstep = (size_t)HALF * K * 2;
    const size_t tstep = 2 * hstep;
    const unsigned ldsw = (unsigned)wid * 1024u;
    const int aoff = lds_byte(wr * 64 + fr, fq * 8), boff = lds_byte(wc * 32 + fr, fq * 8);
#define PG8_SA(b, h) (((b) * 2 + (h)) * HTB)
#define PG8_SB(b, h) ((4 + (b) * 2 + (h)) * HTB)
#define PG8_STAGE(bufoff, gbase, voff) do { _Pragma("unroll") for (int _i = 0; _i < 2; ++_i) \
        __builtin_amdgcn_global_load_lds((const unsigned*)((const char*)(gbase) + (voff)[_i]), (PG8_LAS unsigned*)(lds + (bufoff) + ldsw + _i * 8192), 16, 0, 0); } while (0)
#define PG8_LDA(dst, b, h) do { _Pragma("unroll") for (int m = 0; m < 4; ++m) _Pragma("unroll") for (int k = 0; k < 2; ++k) dst[m][k] = *(const PG8_LAS bf16x8*)(lds + PG8_SA(b, h) + aoff + m * 2048 + k * 1024); } while (0)
#define PG8_LDB(dst, b, h) do { _Pragma("unroll") for (int n = 0; n < 2; ++n) _Pragma("unroll") for (int k = 0; k < 2; ++k) dst[n][k] = *(const PG8_LAS bf16x8*)(lds + PG8_SB(b, h) + boff + n * 2048 + k * 1024); } while (0)
#define PG8_MMA(ai, bj, At, Bt) do { __builtin_amdgcn_s_setprio(1); _Pragma("unroll") for (int m = 0; m < 4; ++m) _Pragma("unroll") for (int n = 0; n < 2; ++n) _Pragma("unroll") for (int k = 0; k < 2; ++k) \
        acc[ai][bj][m][n] = __builtin_amdgcn_mfma_f32_16x16x32_bf16(Bt[n][k], At[m][k], acc[ai][bj][m][n], 0, 0, 0); __builtin_amdgcn_s_setprio(0); } while (0)
#define PG8_WAIT_V(n) asm volatile("s_waitcnt vmcnt(" #n ")" ::: "memory")
#define PG8_WAIT_L(n) asm volatile("s_waitcnt lgkmcnt(" #n ")" ::: "memory")
#define PG8_BAR __builtin_amdgcn_s_barrier()
#define PG8_SCHED __builtin_amdgcn_sched_barrier(0)
    Unit cur, nxt; int ui = 0;
    if (!S.next(0, cur)) return;
    f32x4 acc[2][2][4][2];
#pragma unroll
    for (int a = 0; a < 2; ++a)
#pragma unroll
        for (int b = 0; b < 2; ++b)
#pragma unroll
            for (int m = 0; m < 4; ++m)
#pragma unroll
                for (int n = 0; n < 2; ++n) acc[a][b][m][n] = (f32x4){0.f, 0.f, 0.f, 0.f};
    bf16x8 At[4][2], B0[2][2], B1[2][2];
    const char* cA = (const char*)g.A + (size_t)cur.pm * tstep; const char* cB = (const char*)g.Bt + (size_t)cur.pn * tstep;
    S.a_ready(cur);
    if constexpr (SP2) {
        PG8_STAGE(PG8_SB(0, 0), cB, voffB); PG8_STAGE(PG8_SB(0, 1), cB + hstep, voffB); PG8_STAGE(PG8_SA(0, 0), cA, voffA); PG8_STAGE(PG8_SA(0, 1), cA + hstep, voffA);
        if (wr == 1) PG8_BAR;
        PG8_WAIT_V(2); PG8_BAR;
        PG8_STAGE(PG8_SB(1, 0), cB + kstep, voffB); PG8_STAGE(PG8_SA(1, 0), cA + kstep, voffA); PG8_STAGE(PG8_SB(1, 1), cB + hstep + kstep, voffB);
        PG8_WAIT_V(6); PG8_BAR;
    } else {
        PG8_STAGE(PG8_SB(0, 0), cB, voffB); PG8_STAGE(PG8_SA(0, 0), cA, voffA); PG8_STAGE(PG8_SB(0, 1), cB + hstep, voffB); PG8_STAGE(PG8_SA(0, 1), cA + hstep, voffA);
        if (wr == 1) PG8_BAR;
        PG8_WAIT_V(4); PG8_BAR;
        PG8_STAGE(PG8_SB(1, 0), cB + kstep, voffB); PG8_STAGE(PG8_SA(1, 0), cA + kstep, voffA); PG8_STAGE(PG8_SB(1, 1), cB + hstep + kstep, voffB);
        PG8_WAIT_V(6); PG8_BAR;
    }
    for (;;) {
        const bool has_next = S.next(ui + 1, nxt);
        const char* nA = has_next ? (const char*)g.A + (size_t)nxt.pm * tstep : cA; const char* nB = has_next ? (const char*)g.Bt + (size_t)nxt.pn * tstep : cB;
        for (int t = 0; t < nt; t += 2) {
            const bool last = (t == nt - 2);
            if constexpr (Epi::HOOK) { if (t == E.hook_t) E.mid(acc, cur, wr, wc, fr, fq); }
            const char* a1 = cA + (size_t)(t + 1) * kstep;
            const char* a2 = last ? nA : cA + (size_t)(t + 2) * kstep; const char* b2 = last ? nB : cB + (size_t)(t + 2) * kstep;
            const char* a3 = a2 + kstep; const char* b3 = b2 + kstep;
            if (last && has_next) S.a_ready(nxt);
            if constexpr (SP2) {
            PG8_LDB(B0, 0, 0); PG8_LDB(B1, 0, 1); PG8_SCHED; PG8_LDA(At, 0, 0); PG8_STAGE(PG8_SA(1, 1), a1 + hstep, voffA);
            PG8_WAIT_V(8); PG8_WAIT_L(0); PG8_BAR; PG8_MMA(0, 0, At, B0); PG8_MMA(0, 1, At, B1); PG8_BAR; PG8_SCHED;
            PG8_LDA(At, 0, 1); PG8_STAGE(PG8_SB(0, 0), b2, voffB); PG8_STAGE(PG8_SB(0, 1), b2 + hstep, voffB); PG8_STAGE(PG8_SA(0, 0), a2, voffA);
            PG8_WAIT_V(8); PG8_WAIT_L(0); PG8_BAR; PG8_MMA(1, 0, At, B0); PG8_MMA(1, 1, At, B1); PG8_BAR; PG8_SCHED;
            PG8_LDB(B0, 1, 0); PG8_LDB(B1, 1, 1); PG8_SCHED; PG8_LDA(At, 1, 0); PG8_STAGE(PG8_SA(0, 1), a2 + hstep, voffA);
            PG8_WAIT_V(8); PG8_WAIT_L(0); PG8_BAR; PG8_MMA(0, 0, At, B0); PG8_MMA(0, 1, At, B1); PG8_BAR; PG8_SCHED;
            PG8_LDA(At, 1, 1); PG8_STAGE(PG8_SB(1, 0), b3, voffB); PG8_STAGE(PG8_SB(1, 1), b3 + hstep, voffB); PG8_STAGE(PG8_SA(1, 0), a3, voffA);
            PG8_WAIT_V(8); PG8_WAIT_L(0); PG8_BAR; PG8_MMA(1, 0, At, B0); PG8_MMA(1, 1, At, B1); PG8_BAR; PG8_SCHED;
            } else {
            PG8_LDB(B0, 0, 0); PG8_SCHED; PG8_LDA(At, 0, 0); PG8_STAGE(PG8_SA(1, 1), a1 + hstep, voffA);
            PG8_WAIT_L(8); PG8_BAR; PG8_WAIT_L(0); PG8_MMA(0, 0, At, B0); PG8_BAR; PG8_SCHED;
            PG8_LDB(B1, 0, 1); PG8_STAGE(PG8_SB(0, 0), b2, voffB);
            PG8_BAR; PG8_WAIT_L(0); PG8_MMA(0, 1, At, B1); PG8_BAR;
            PG8_LDA(At, 0, 1); PG8_STAGE(PG8_SA(0, 0), a2, voffA);
            PG8_BAR; PG8_WAIT_L(0); PG8_MMA(1, 0, At, B0); PG8_BAR; PG8_SCHED;
            PG8_STAGE(PG8_SB(0, 1), b2 + hstep, voffB);
            PG8_WAIT_V(6); PG8_BAR; PG8_MMA(1, 1, At, B1); PG8_BAR;
            PG8_LDB(B0, 1, 0); PG8_SCHED; PG8_LDA(At, 1, 0); PG8_STAGE(PG8_SA(0, 1), a2 + hstep, voffA);
            PG8_WAIT_L(8); PG8_BAR; PG8_WAIT_L(0); PG8_MMA(0, 0, At, B0); PG8_BAR; PG8_SCHED;
            PG8_LDB(B1, 1, 1); PG8_STAGE(PG8_SB(1, 0), b3, voffB);
            PG8_BAR; PG8_WAIT_L(0); PG8_MMA(0, 1, At, B1); PG8_BAR;
            PG8_LDA(At, 1, 1); PG8_STAGE(PG8_SA(1, 0), a3, voffA);
            PG8_BAR; PG8_WAIT_L(0); PG8_MMA(1, 0, At, B0); PG8_BAR; PG8_SCHED;
            PG8_STAGE(PG8_SB(1, 1), b3 + hstep, voffB);
            PG8_WAIT_V(6); PG8_BAR; PG8_MMA(1, 1, At, B1); PG8_BAR;
            }
        }
        if constexpr (ALIGN_EPI) { if (wr == 0) PG8_BAR; }
        if constexpr (!Epi::AFTER_DRAIN) { E(acc, cur, wr, wc, fr, fq); S.done(cur); }
        if (!has_next) break;
#pragma unroll
        for (int a = 0; a < 2; ++a)
#pragma unroll
            for (int b = 0; b < 2; ++b)
#pragma unroll
                for (int m = 0; m < 4; ++m)
#pragma unroll
                    for (int n = 0; n < 2; ++n) acc[a][b][m][n] = (f32x4){0.f, 0.f, 0.f, 0.f};
        cur = nxt; cA = nA; cB = nB; ++ui;
        if constexpr (ALIGN_EPI) { if (wr == 1) PG8_BAR; }
    }
    PG8_WAIT_V(0);
    if constexpr (!ALIGN_EPI) { if (wr == 0) PG8_BAR; }
    PG8_BAR;
#undef PG8_SA
#undef PG8_SB
#undef PG8_STAGE
#undef PG8_LDA
#undef PG8_LDB
#undef PG8_MMA
#undef PG8_WAIT_V
#undef PG8_WAIT_L
#undef PG8_BAR
#undef PG8_SCHED
}
}

namespace attn {
constexpr int D = 128;
constexpr float THR = 8.f;
constexpr bool WSKIP = false;
constexpr float SCALE = 0.08838834764831845f;
constexpr int NW = 8, QBLK = 32, KVBLK = 64, QB = NW * QBLK;
constexpr int SHM_V = KVBLK * D * 2, SHM_K = KVBLK * D * 2;
constexpr int LDS_BYTES = 2 * SHM_V + 2 * SHM_K + NW * 64 * 4;
constexpr int KM_OFF = 69632;
constexpr int LDO = 2048, LDG = 1024, STG_OFF = 73728;
#ifndef MOBA_ON
#define MOBA_ON 1
#endif
#ifndef GA_ON
#define GA_ON 1
#endif
using bf16 = __hip_bfloat16;
typedef short bf16x8 __attribute__((ext_vector_type(8)));
typedef short s16x4 __attribute__((ext_vector_type(4)));
typedef float f32x16 __attribute__((ext_vector_type(16)));
typedef float f32x4 __attribute__((ext_vector_type(4)));
typedef unsigned u32x4 __attribute__((ext_vector_type(4)));
template <class A, class Bt> struct same_t { static constexpr bool v = false; };
template <class A> struct same_t<A, A> { static constexpr bool v = true; };

#define KSWZ(row, colB) ((row) * 256 + ((colB) ^ (((row) & 7) << 4)))
#define SBAR() __builtin_amdgcn_sched_barrier(0)
__device__ __forceinline__ int v_st(int k, int c) { const int kk = (k & ~0xC) | ((k & 4) << 1) | ((k & 8) >> 1); return ((kk >> 3) * 4 + (c >> 5)) * 512 + ((kk & 7) * 32 + (c & 31)) * 2; }
__device__ __forceinline__ int v_rd_base(int lane) { return ((lane & 3) << 3) | (((lane >> 2) & 3) << 6) | (((lane >> 4) & 1) << 5) | (((lane >> 5) & 1) << 8); }
constexpr int v_rd_off(int d0, int ks, int half) { return d0 * 512 + ks * 4096 + half * 2048; }
__device__ __forceinline__ int crow(int r, int hi) { return (r & 3) + 8 * (r >> 2) + 4 * hi; }
__device__ __forceinline__ unsigned cvtpk(float lo, float hi) {
    unsigned r; asm volatile("v_cvt_pk_bf16_f32 %0, %1, %2" : "=v"(r) : "v"(lo), "v"(hi)); return r;
}
__device__ __forceinline__ bf16x8 pack8(f32x4 a, f32x4 b) {
    u32x4 w = {cvtpk(a[0], a[1]), cvtpk(a[2], a[3]), cvtpk(b[0], b[1]), cvtpk(b[2], b[3])};
    return *reinterpret_cast<bf16x8*>(&w);
}
template <class T> __device__ __forceinline__ bf16x8 load8(const T* p) {
    if constexpr (same_t<T, float>::v) { return pack8(*(const f32x4*)p, *(const f32x4*)(p + 4)); }
    else { return *reinterpret_cast<const bf16x8*>(p); }
}
__device__ __forceinline__ void mask_tile(f32x16& p0, f32x16& p1, int dq, unsigned W) {
    const float NEG = -__builtin_inff();
#pragma unroll
    for (int r = 0; r < 16; ++r) {
        const int c = (r & 3) + 8 * (r >> 2);
        if ((unsigned)(dq - c) >= W) p0[r] = NEG;
        if ((unsigned)(dq - c - 32) >= W) p1[r] = NEG;
    }
}
__device__ __forceinline__ void partialSM(f32x16& p0, f32x16& p1, float& m_reg, float& mn, float& alpha) {
    float pmax = p0[0]; for (int r = 1; r < 16; ++r) pmax = fmaxf(pmax, p0[r]); for (int r = 0; r < 16; ++r) pmax = fmaxf(pmax, p1[r]);
    { auto rr = __builtin_amdgcn_permlane32_swap(__float_as_uint(pmax), __float_as_uint(pmax), false, false);
      pmax = fmaxf(__uint_as_float(rr[0]), __uint_as_float(rr[1])); }
    constexpr float C2 = 1.4426950408889634f * SCALE;
    if (__builtin_expect(__all((pmax - m_reg) * SCALE <= THR), 1)) { mn = m_reg; alpha = 1.f; }
    else { mn = fmaxf(m_reg, pmax); alpha = __builtin_amdgcn_exp2f((m_reg - mn) * C2); m_reg = mn; }
    const float mnL = -mn * C2;
    for (int r = 0; r < 16; ++r) p0[r] = fmaf(p0[r], C2, mnL); for (int r = 0; r < 16; ++r) p1[r] = fmaf(p1[r], C2, mnL);
    for (int r = 0; r < 16; ++r) p0[r] = __builtin_amdgcn_exp2f(p0[r]);
}
__device__ __forceinline__ void finishSM(f32x16& p0, f32x16& p1, float alpha, float& l_reg, bf16x8& pa0, bf16x8& pa1, bf16x8& pa2, bf16x8& pa3) {
    for (int r = 0; r < 16; ++r) p1[r] = __builtin_amdgcn_exp2f(p1[r]);
    float ps = 0; for (int r = 0; r < 16; ++r) ps += p0[r]; for (int r = 0; r < 16; ++r) ps += p1[r];
    { auto rr = __builtin_amdgcn_permlane32_swap(__float_as_uint(ps), __float_as_uint(ps), false, false);
      ps = __uint_as_float(rr[0]) + __uint_as_float(rr[1]); }
    l_reg = l_reg * alpha + ps;
#define PK4(P, B_, OUT) do { unsigned a0 = cvtpk(P[B_+0], P[B_+1]), a1 = cvtpk(P[B_+2], P[B_+3]);                          \
        unsigned b0 = cvtpk(P[B_+4], P[B_+5]), b1 = cvtpk(P[B_+6], P[B_+7]);                                             \
        auto r0 = __builtin_amdgcn_permlane32_swap(a0, b0, false, false); auto r1 = __builtin_amdgcn_permlane32_swap(a1, b1, false, false); \
        u32x4 w = {r0[0], r1[0], r0[1], r1[1]}; OUT = *reinterpret_cast<bf16x8*>(&w); } while (0)
    PK4(p0, 0, pa0); PK4(p0, 8, pa1); PK4(p1, 0, pa2); PK4(p1, 8, pa3);
#undef PK4
}
template <int KB, bool SK>
__device__ __forceinline__ void qkt(f32x16& p0, f32x16& p1, const char* K_lds, int r32, int hi, const bf16x8* qr, bool act) {
    if (SK && !act) { const float NEG = -__builtin_inff();
#pragma unroll
        for (int r = 0; r < 16; ++r) { p0[r] = NEG; p1[r] = NEG; } return; }
    p0 = f32x16{}; p1 = f32x16{};
    const char* kb[4];
#pragma unroll
    for (int dd = 0; dd < 4; ++dd) kb[dd] = K_lds + KB * SHM_K + KSWZ(r32, (dd * 16 + hi * 8) * 2);
#pragma unroll
    for (int d0 = 0; d0 < 8; ++d0) { const char* a = kb[d0 & 3] + (d0 >> 2) * 128;
        bf16x8 b0 = *reinterpret_cast<const bf16x8*>(a);
        bf16x8 b1 = *reinterpret_cast<const bf16x8*>(a + 32 * 256);
        p0 = __builtin_amdgcn_mfma_f32_32x32x16_bf16(b0, qr[d0], p0, 0, 0, 0);
        p1 = __builtin_amdgcn_mfma_f32_32x32x16_bf16(b1, qr[d0], p1, 0, 0, 0); }
}
template <int VB, bool SK>
__device__ __forceinline__ void pv_tile(f32x16* o, int vb0, bf16x8 pa0, bf16x8 pa1, bf16x8 pa2, bf16x8 pa3, bool act) {
    if (SK && !act) return;
#define TRRD(dst, off) asm volatile("ds_read_b64_tr_b16 %0, %1 offset:%2" : "=&v"(dst) : "v"(vb0), "i"(off) : "memory")
#define PV_D0(d0) do { s16x4 l0, l1, l2, l3, h0, h1, h2, h3; constexpr int b_ = VB * SHM_V + v_rd_off(d0, 0, 0);     \
        TRRD(l0, b_); TRRD(h0, b_ + 2048); TRRD(l1, b_ + 4096); TRRD(h1, b_ + 6144); TRRD(l2, b_ + 8192); TRRD(h2, b_ + 10240); TRRD(l3, b_ + 12288); TRRD(h3, b_ + 14336); \
        asm volatile("s_waitcnt lgkmcnt(0)" ::: "memory"); SBAR();                 \
        o[d0] = __builtin_amdgcn_mfma_f32_32x32x16_bf16(pa0, (bf16x8){l0[0], l0[1], l0[2], l0[3], h0[0], h0[1], h0[2], h0[3]}, o[d0], 0, 0, 0);   \
        o[d0] = __builtin_amdgcn_mfma_f32_32x32x16_bf16(pa1, (bf16x8){l1[0], l1[1], l1[2], l1[3], h1[0], h1[1], h1[2], h1[3]}, o[d0], 0, 0, 0);   \
        o[d0] = __builtin_amdgcn_mfma_f32_32x32x16_bf16(pa2, (bf16x8){l2[0], l2[1], l2[2], l2[3], h2[0], h2[1], h2[2], h2[3]}, o[d0], 0, 0, 0);   \
        o[d0] = __builtin_amdgcn_mfma_f32_32x32x16_bf16(pa3, (bf16x8){l3[0], l3[1], l3[2], l3[3], h3[0], h3[1], h3[2], h3[3]}, o[d0], 0, 0, 0); } while (0)
    PV_D0(0); PV_D0(1); PV_D0(2); PV_D0(3);
#undef PV_D0
#undef TRRD
}

template <class TIn, class TOut> struct BlockRef { const TIn* Q; const TIn* K; const TIn* V; TOut* O; int P0; const unsigned short* GA; const float* KM; int qb; };
template <class TIn> struct Seam {
    bf16x8 qr[8];
    bf16x8 st_v0, st_v1, st_k0, st_k1; f32x4 sf0, sf1, sf2, sf3;
    f32x4 tq[16];
};
__device__ __forceinline__ int swa_jlo(int P0, int W) { const int lowk = P0 - W + 1; return lowk > 0 ? lowk / KVBLK : 0; }
#define ROW(p, k0, rr) ((p) + (size_t)((k0) + (rr)) * D + sc)
#define VMW() asm volatile("s_waitcnt vmcnt(0)" ::: "memory")
#define VMWN(n) asm volatile("s_waitcnt vmcnt(%0)" :: "i"(n) : "memory")
#define SLOAD_H(Kp, Vp, k0) do { S.st_v0 = load8<TIn>(ROW(Vp, k0, sr)); S.st_v1 = load8<TIn>(ROW(Vp, k0, 32 + sr));              \
                         S.st_k0 = load8<TIn>(ROW(Kp, k0, sr)); S.st_k1 = load8<TIn>(ROW(Kp, k0, 32 + sr)); } while (0)
#define SWRITE_HK(bf) do { *(bf16x8*)(K_lds + (bf) * SHM_K + kws) = S.st_k0; *(bf16x8*)(K_lds + (bf) * SHM_K + kws + 32 * 256) = S.st_k1; } while (0)
#define SWRITE_HV(bf) do { *(bf16x8*)(V_lds + (bf) * SHM_V + vst0) = S.st_v0; *(bf16x8*)(V_lds + (bf) * SHM_V + vst1) = S.st_v1; } while (0)
#define SWRITE_H(bf) do { SWRITE_HV(bf); SWRITE_HK(bf); } while (0)
#define SLOAD_F(p, k0) do { S.sf0 = *(const f32x4*)ROW(p, k0, sr); S.sf1 = *(const f32x4*)(ROW(p, k0, sr) + 4);                \
                            S.sf2 = *(const f32x4*)ROW(p, k0, 32 + sr); S.sf3 = *(const f32x4*)(ROW(p, k0, 32 + sr) + 4); } while (0)
#define SWRITE_KF(bf) do { *(bf16x8*)(K_lds + (bf) * SHM_K + kws) = pack8(S.sf0, S.sf1); *(bf16x8*)(K_lds + (bf) * SHM_K + kws + 32 * 256) = pack8(S.sf2, S.sf3); } while (0)
#define SWRITE_VF(bf) do { *(bf16x8*)(V_lds + (bf) * SHM_V + vst0) = pack8(S.sf0, S.sf1); *(bf16x8*)(V_lds + (bf) * SHM_V + vst1) = pack8(S.sf2, S.sf3); } while (0)
template <class TIn, class TOut>
__device__ __forceinline__ void causal_swa_prime(const BlockRef<TIn, TOut>& cur, int W, char* lds, Seam<TIn>& S) {
    constexpr bool F32 = same_t<TIn, float>::v;
    int tid_ = threadIdx.x; asm volatile("" : "+v"(tid_)); const int tid = tid_, wid = __builtin_amdgcn_readfirstlane(tid >> 6), lane = tid & 63, r32 = lane & 31, hi = lane >> 5;
    const int sr = tid >> 4, sc = (tid & 15) * 8, kws = KSWZ(sr, sc * 2); char* K_lds = lds + 2 * SHM_V;
    const int kb0 = swa_jlo(cur.P0, W) * KVBLK;
    for (int d0 = 0; d0 < 8; ++d0) S.qr[d0] = load8<TIn>(cur.Q + (size_t)(wid * QBLK + r32) * D + d0 * 16 + hi * 8);
    if constexpr (F32) { SLOAD_F((const float*)cur.K, kb0); VMW(); SWRITE_KF(0); SBAR(); SLOAD_F((const float*)cur.V, kb0); }
    else { SLOAD_H(cur.K, cur.V, kb0); VMW(); SWRITE_HK(0); }
    __syncthreads();
}
template <class TIn, class TOut>
__device__ __forceinline__ void causal_swa_block(const BlockRef<TIn, TOut>& cur, const BlockRef<TIn, TOut>& nxt, int skv, int W, char* lds, Seam<TIn>& S) {
    constexpr bool F32 = same_t<TIn, float>::v;
    int tid_ = threadIdx.x; asm volatile("" : "+v"(tid_)); const int tid = tid_, wid = __builtin_amdgcn_readfirstlane(tid >> 6), lane = tid & 63, r32 = lane & 31, hi = lane >> 5;
    const int j_lo = swa_jlo(cur.P0, W);
    int j_hi = (cur.P0 + QB - 1) / KVBLK + 1; if (j_hi > skv / KVBLK) j_hi = skv / KVBLK;
    const int NT = j_hi - j_lo;
    const int kbn = swa_jlo(nxt.P0, W) * KVBLK;
    const int qlo = cur.P0 + wid * QBLK, qm = qlo + r32 - 4 * hi;
    char* V_lds = lds; char* K_lds = lds + 2 * SHM_V;
    float* ws = (float*)(lds + 2 * SHM_V + 2 * SHM_K) + wid * 64; float* li_l = ws, * al_l = ws + 32;
    float m_reg = -1e30f, l_reg = 0; f32x16 o[4] = {};
    const int sr = tid >> 4, sc = (tid & 15) * 8, vst0 = v_st(sr, sc), vst1 = v_st(32 + sr, sc), kws = KSWZ(sr, sc * 2);
    const int vb0 = (int)(uintptr_t)V_lds + v_rd_base(lane);
    const TIn* Kh = cur.K; const TIn* Vh = cur.V;
    unsigned selmask = 0xffu; const bool moba = cur.qb >= 4;
    {
        float* kml = (float*)(lds + KM_OFF);
        for (int idx = tid; idx < 8 * 128; idx += 64 * NW) { const int n_ = idx >> 7, d_ = idx & 127; kml[idx] = (cur.KM[(size_t)n_ * 2048 + d_] + cur.KM[(size_t)n_ * 2048 + 1024 + d_]) * (1.0f / 256.0f); }
        __syncthreads();
        if (moba) {
            float g[7];
#pragma unroll
            for (int n_ = 0; n_ < 7; ++n_) { float s = 0.f;
                if (n_ < cur.qb) {
#pragma unroll
                    for (int d0 = 0; d0 < 8; ++d0) { const f32x4 k0 = *(const f32x4*)(kml + n_ * 128 + d0 * 16 + hi * 8), k1 = *(const f32x4*)(kml + n_ * 128 + d0 * 16 + hi * 8 + 4);
                        const bf16x8 qv = S.qr[d0];
#define B2F_(x) __uint_as_float(((unsigned)(unsigned short)(x)) << 16)
                        s += (B2F_(qv[0]) * k0[0] + B2F_(qv[1]) * k0[1]) + (B2F_(qv[2]) * k0[2] + B2F_(qv[3]) * k0[3]) + (B2F_(qv[4]) * k1[0] + B2F_(qv[5]) * k1[1]) + (B2F_(qv[6]) * k1[2] + B2F_(qv[7]) * k1[3]);
#undef B2F_
                    } }
                g[n_] = s + __shfl_xor(s, 32); }
            selmask = 0u;
#pragma unroll
            for (int rd = 0; rd < 3; ++rd) { float best = -__builtin_inff(); unsigned bi = 0u;
#pragma unroll
                for (int n_ = 0; n_ < 7; ++n_) { const bool ok = (n_ < cur.qb) && (((selmask >> n_) & 1u) == 0u) && (g[n_] > best); best = ok ? g[n_] : best; bi = ok ? (unsigned)n_ : bi; }
                selmask |= 1u << bi; }
        }
    }
#define RESC(a) do { if (__any((a) < 1.f)) { if (hi == 0) al_l[r32] = (a); asm volatile("s_waitcnt lgkmcnt(0)" ::: "memory");              \
                     for (int d_ = 0; d_ < 4; ++d_) for (int r = 0; r < 16; ++r) o[d_][r] *= al_l[crow(r, hi)]; } } while (0)
#define KBASE(t) ((j_lo + (t)) * KVBLK)
#define ACT(t) (KBASE(t) <= qlo + QBLK - 1 && KBASE(t) + KVBLK - 1 >= qlo - W + 1)
#define MASKT(P0_, P1_, t) do { const int kb_ = KBASE(t); if ((!SK || ACT(t)) && (kb_ + KVBLK - 1 > qlo || kb_ <= qlo + QBLK - 1 - W)) mask_tile(P0_, P1_, qm - kb_, (unsigned)W); \
        if (MOBA_ON && moba && kb_ < cur.P0) { const bool dead_ = ((selmask >> (kb_ >> 8)) & 1u) == 0u; const float NEG_ = -__builtin_inff(); \
            _Pragma("unroll") for (int r_ = 0; r_ < 16; ++r_) { P0_[r_] = dead_ ? NEG_ : P0_[r_]; P1_[r_] = dead_ ? NEG_ : P1_[r_]; } } } while (0)
    constexpr int NQL = F32 ? 16 : 8;
    constexpr bool SK = WSKIP && !F32;
#define SEAM_K0() do { VMWN(NQL); if constexpr (F32) { SWRITE_KF(0); SBAR(); SLOAD_F((const float*)nxt.V, kbn); } else { SWRITE_HK(0); } SBAR(); } while (0)
    f32x16 pA0, pA1, pB0, pB1; float mnA, mnB, alA, alB; bf16x8 pa0, pa1, pa2, pa3;
    if constexpr (F32) { VMW(); SWRITE_VF(0); SBAR(); } else { SWRITE_HV(0); SBAR(); }
    if (NT > 1) { if constexpr (F32) SLOAD_F((const float*)Kh, KBASE(1)); else SLOAD_H(Kh, Vh, KBASE(1)); }
    SBAR(); qkt<0, SK>(pA0, pA1, K_lds, r32, hi, S.qr, ACT(0));
    if constexpr (F32) { if (NT > 1) { VMW(); SWRITE_KF(1); SBAR(); SLOAD_F((const float*)Vh, KBASE(1)); } }
    MASKT(pA0, pA1, 0); partialSM(pA0, pA1, m_reg, mnA, alA);
    if (NT > 1) { VMW(); if constexpr (F32) { SWRITE_VF(1); SBAR(); if (NT > 2) SLOAD_F((const float*)Kh, KBASE(2)); } else SWRITE_H(1); }
    __syncthreads();
#define HALF_STEP(PX0, PX1, mnX, alX, PY0, PY1, alY, t, KB, VB, SB) do {                                                      \
        SBAR(); qkt<KB, SK>(PX0, PX1, K_lds, r32, hi, S.qr, ACT(t));                                             \
        finishSM(PY0, PY1, alY, l_reg, pa0, pa1, pa2, pa3); SBAR();                                                           \
        if ((t) + 1 < NT) { if constexpr (F32) { VMW(); SWRITE_KF(SB); SBAR(); SLOAD_F((const float*)Vh, KBASE((t) + 1)); }  \
                            else { SLOAD_H(Kh, Vh, KBASE((t) + 1)); } SBAR(); }                                               \
        pv_tile<VB, SK>(o, vb0, pa0, pa1, pa2, pa3, ACT((t) - 1)); MASKT(PX0, PX1, (t)); partialSM(PX0, PX1, m_reg, mnX, alX);                                        \
        __syncthreads();                                                                                                      \
        if ((t) + 1 < NT) { VMW(); if constexpr (F32) { SWRITE_VF(SB); SBAR(); if ((t) + 2 < NT) SLOAD_F((const float*)Kh, KBASE((t) + 2)); } \
                            else { SWRITE_H(SB); } }                                                                          \
        RESC(alX); __syncthreads(); } while (0)
    for (int t = 1; t + 1 < NT; t += 2) {
        HALF_STEP(pB0, pB1, mnB, alB, pA0, pA1, alA, t, 1, 0, 0);
        HALF_STEP(pA0, pA1, mnA, alA, pB0, pB1, alB, t + 1, 0, 1, 1);
    }
    const bool even = (NT & 1) == 0;
    if (even) { SBAR(); qkt<1, SK>(pB0, pB1, K_lds, r32, hi, S.qr, ACT(NT - 1)); SBAR(); }
#define QROW(e) (nxt.Q + (size_t)(wid * QBLK + r32) * D + ((e) >> 1) * 16 + hi * 8 + ((e) & 1) * 4)
    if constexpr (F32) { SLOAD_F((const float*)nxt.K, kbn); SBAR();
#pragma unroll
        for (int e = 0; e < 8; ++e) S.tq[e] = *(const f32x4*)QROW(e); }
    else { SLOAD_H(nxt.K, nxt.V, kbn); SBAR();
#pragma unroll
        for (int d0 = 0; d0 < 8; ++d0) S.qr[d0] = load8<TIn>(nxt.Q + (size_t)(wid * QBLK + r32) * D + d0 * 16 + hi * 8); }
    SBAR();
    finishSM(pA0, pA1, alA, l_reg, pa0, pa1, pa2, pa3); SBAR();
    if constexpr (F32) {
#pragma unroll
        for (int e = 8; e < 16; ++e) S.tq[e] = *(const f32x4*)QROW(e); SBAR(); }
#undef QROW
    pv_tile<0, SK>(o, vb0, pa0, pa1, pa2, pa3, ACT(even ? NT - 2 : NT - 1));
    if (even) { MASKT(pB0, pB1, NT - 1); partialSM(pB0, pB1, m_reg, mnB, alB); __syncthreads(); RESC(alB);
        finishSM(pB0, pB1, alB, l_reg, pa0, pa1, pa2, pa3); SBAR(); pv_tile<1, SK>(o, vb0, pa0, pa1, pa2, pa3, ACT(NT - 1)); }
    SBAR(); SEAM_K0();
    if (hi == 0) li_l[r32] = l_reg; asm volatile("s_waitcnt lgkmcnt(0)" ::: "memory");
    float rli[16];
#pragma unroll
    for (int r = 0; r < 16; ++r) rli[r] = __builtin_amdgcn_rcpf(li_l[crow(r, hi)]);
    { unsigned short* stg = (unsigned short*)(lds + STG_OFF) + wid * 4096;
#pragma unroll
      for (int r = 0; r < 16; ++r) { const int orow = crow(r, hi);
#pragma unroll
        for (int d0 = 0; d0 < 4; ++d0) { const float v = o[d0][r] * rli[r]; stg[orow * 128 + d0 * 32 + r32] = (unsigned short)(cvtpk(v, v) & 0xffffu); } }
      asm volatile("s_waitcnt lgkmcnt(0)" ::: "memory");
      unsigned short* Ow = (unsigned short*)cur.O + (size_t)(wid * QBLK) * LDO; const unsigned short* Gw = cur.GA + (size_t)(wid * QBLK) * LDG;
#pragma unroll
      for (int i = 0; i < 8; ++i) { const int row = i * 4 + (lane >> 4), ch = lane & 15;
          const u32x4 ov = *(const u32x4*)(stg + row * 128 + ch * 8); const u32x4 gv = *(const u32x4*)(Gw + (size_t)row * LDG + ch * 8);
          u32x4 w;
#define MULPK_(a, b) cvtpk(__uint_as_float((a) << 16) * __uint_as_float((b) << 16), __uint_as_float((a) & 0xffff0000u) * __uint_as_float((b) & 0xffff0000u))
          w.x = MULPK_(ov.x, gv.x); w.y = MULPK_(ov.y, gv.y); w.z = MULPK_(ov.z, gv.z); w.w = MULPK_(ov.w, gv.w);
#undef MULPK_
          *(u32x4*)(Ow + (size_t)row * LDO + ch * 8) = w; } }
    if constexpr (F32) {
#pragma unroll
        for (int d0 = 0; d0 < 8; ++d0) S.qr[d0] = pack8(S.tq[2 * d0], S.tq[2 * d0 + 1]); }
    __syncthreads();
#undef RESC
#undef KBASE
#undef ACT
#undef MASKT
#undef SEAM_K0
#undef HALF_STEP
}
#undef ROW
#undef VMW
#undef VMWN
#undef SLOAD_H
#undef SWRITE_HK
#undef SWRITE_HV
#undef SWRITE_H
#undef SLOAD_F
#undef SWRITE_KF
#undef SWRITE_VF


typedef BlockRef<bf16, bf16> Ref;
__device__ __forceinline__ Ref make_ref(int L, const bf16* Q, const bf16* K, const bf16* V, bf16* Y, const bf16* GA, const float* KMP) {
    const int bh = L >> 3, qb = L & 7, b = bh >> 3, h = bh & 7; Ref r;
    r.Q = Q + ((size_t)bh * 2048 + (size_t)qb * QB) * D; r.K = K + (size_t)bh * 2048 * D; r.V = V + (size_t)bh * 2048 * D;
    r.O = Y + ((size_t)b * 2048 + (size_t)qb * QB) * LDO + h * 128; r.GA = (const unsigned short*)GA + ((size_t)b * 2048 + (size_t)qb * QB) * LDG + h * 128;
    r.P0 = qb * QB; r.KM = KMP + (size_t)b * 16 * 1024 + h * 128; r.qb = qb; return r;
}
__device__ __forceinline__ void phase(char* lds, const bf16* Q, const bf16* K, const bf16* V, bf16* Y, const bf16* GA, const float* KMP, int vcu, int G) {
    int L = vcu; if (L >= 256) return;
    Ref cur = make_ref(L, Q, K, V, Y, GA, KMP);
    Seam<bf16> S;
    causal_swa_prime<bf16, bf16>(cur, 2048, lds, S);
    for (;;) {
        const int Ln = L + G; const bool last = Ln >= 256;
        const Ref nxt = last ? cur : make_ref(Ln, Q, K, V, Y, GA, KMP);
        causal_swa_block<bf16, bf16>(cur, nxt, 2048, 2048, lds, S);
        if (last) break;
        cur = nxt; L = Ln;
    }
}
#undef KSWZ
#undef SBAR
}
namespace lru {
#define LRU_LAS __attribute__((address_space(3)))
typedef short bf16x8 __attribute__((ext_vector_type(8)));
typedef float f32x4 __attribute__((ext_vector_type(4)));
typedef unsigned u32x4 __attribute__((ext_vector_type(4)));
typedef unsigned u32x2 __attribute__((ext_vector_type(2)));
constexpr int CH = 128  , XCP = 272  ;
constexpr int OFF_XC = 0, OFF_WB = CH * XCP, OFF_A = OFF_WB + 256 * XCP, OFF_U = OFF_A + CH * 32 * 4, OFF_SA = OFF_U + CH * 32 * 4, OFF_SH = OFF_SA + 16 * 32 * 4, OFF_TA = OFF_SH + 16 * 32 * 4,
              OFF_TH = OFF_TA + 128 * 4, OFF_CR = OFF_TH + 128 * 4, LRU_LDS = OFF_CR + 128 * 4;
__device__ __forceinline__ float b2f(unsigned short x) { return __uint_as_float(((unsigned)x) << 16); }
__device__ __forceinline__ unsigned cvtpk(float lo, float hi) { unsigned r; asm volatile("v_cvt_pk_bf16_f32 %0, %1, %2" : "=v"(r) : "v"(lo), "v"(hi)); return r; }
struct Tensors { const unsigned short* XR; const unsigned short* GL; unsigned short* Y; unsigned short* Q1; const unsigned short* WrT; const unsigned short* WiT;
                 const float *cw, *cb, *br, *bi, *c8; float* PUB; unsigned* FLG; };
__device__ __forceinline__ int unit_tc(int q, int r) { const int base = (r == 0) ? 0 : (r == 1) ? 7 : (r == 2) ? 12 : 15, width = (r == 0) ? 7 : (r == 1) ? 5 : (r == 2) ? 3 : 1; return q < width ? base + q : -1; }

__device__ __forceinline__ void load_weights(LRU_LAS unsigned char* lds, const Tensors& T, int n) {
    const int tid = threadIdx.x;
#pragma unroll
    for (int i = 0; i < 8; ++i) { const int p = tid + 512 * i, o = p >> 4, c = p & 15;
        const unsigned short* src = (o < 128 ? T.WrT : T.WiT) + ((size_t)n * 128 + (o & 127)) * 128 + c * 8;
        *(LRU_LAS u32x4*)(lds + OFF_WB + o * XCP + c * 16) = *(const u32x4*)src; }
}

__device__ __forceinline__ void unit(LRU_LAS unsigned char* lds, const Tensors& T, int g, int tc) {
    int tid_ = threadIdx.x; asm volatile("" : "+v"(tid_)); const int tid = tid_, lane = tid & 63, wid = __builtin_amdgcn_readfirstlane(tid >> 6), fr = lane & 15, fq = lane >> 4;
    const int b = g >> 3, n = g & 7;
    LRU_LAS float* LA = (LRU_LAS float*)(lds + OFF_A); LRU_LAS float* LU = (LRU_LAS float*)(lds + OFF_U);
    LRU_LAS float* SA = (LRU_LAS float*)(lds + OFF_SA); LRU_LAS float* SH = (LRU_LAS float*)(lds + OFF_SH);
    LRU_LAS float* TA = (LRU_LAS float*)(lds + OFF_TA); LRU_LAS float* TH = (LRU_LAS float*)(lds + OFF_TH);
    const size_t rowb = (size_t)b * 2048; const int t0 = tc * CH;
    {
        const int cg = tid & 15, trow = tid >> 4; const int chb = n * 128 + cg * 8;
        float cw[4][8], cb[8];
#pragma unroll
        for (int k = 0; k < 4; ++k) { const f32x4 a = *(const f32x4*)(T.cw + k * 1024 + chb), c = *(const f32x4*)(T.cw + k * 1024 + chb + 4);
#pragma unroll
            for (int j = 0; j < 4; ++j) { cw[k][j] = a[j]; cw[k][4 + j] = c[j]; } }
        { const f32x4 a = *(const f32x4*)(T.cb + chb), c = *(const f32x4*)(T.cb + chb + 4);
#pragma unroll
          for (int j = 0; j < 4; ++j) { cb[j] = a[j]; cb[4 + j] = c[j]; } }
#pragma unroll
        for (int i = 0; i < 4; ++i) { const int tok = trow + 32 * i, ta = t0 + tok;
            float acc8[8];
#pragma unroll
            for (int j = 0; j < 8; ++j) acc8[j] = cb[j];
#pragma unroll
            for (int k = 0; k < 4; ++k) { const int tt = ta - 3 + k;
                u32x4 w = (u32x4){0u, 0u, 0u, 0u};
                if (tt >= 0) w = *(const u32x4*)(T.XR + (rowb + tt) * 1024 + chb);
                acc8[0] += cw[k][0] * __uint_as_float(w.x << 16); acc8[1] += cw[k][1] * __uint_as_float(w.x & 0xffff0000u);
                acc8[2] += cw[k][2] * __uint_as_float(w.y << 16); acc8[3] += cw[k][3] * __uint_as_float(w.y & 0xffff0000u);
                acc8[4] += cw[k][4] * __uint_as_float(w.z << 16); acc8[5] += cw[k][5] * __uint_as_float(w.z & 0xffff0000u);
                acc8[6] += cw[k][6] * __uint_as_float(w.w << 16); acc8[7] += cw[k][7] * __uint_as_float(w.w & 0xffff0000u); }
            u32x4 o; o.x = cvtpk(acc8[0], acc8[1]); o.y = cvtpk(acc8[2], acc8[3]); o.z = cvtpk(acc8[4], acc8[5]); o.w = cvtpk(acc8[6], acc8[7]);
            *(LRU_LAS u32x4*)(lds + OFF_XC + tok * XCP + cg * 16) = o; }
    }
    __syncthreads();
    const int tok = 16 * wid + fr;
    bf16x8 af[4];
#pragma unroll
    for (int ks = 0; ks < 4; ++ks) af[ks] = *(const LRU_LAS bf16x8*)(lds + OFF_XC + tok * XCP + (ks * 32 + fq * 8) * 2);
    const int se = tid & 31, sg = tid >> 5;
#pragma unroll 1
    for (int es = 0; es < 4; ++es) {
        const size_t chn = (size_t)n * 128 + es * 32 + se;
        unsigned short glr[8];
#pragma unroll
        for (int j = 0; j < 8; ++j) glr[j] = T.GL[(rowb + t0 + sg * 8 + j) * 1024 + chn];
        {
            f32x4 ar[2], ai_[2];
#pragma unroll
            for (int nb = 0; nb < 2; ++nb) { ar[nb] = (f32x4){0.f, 0.f, 0.f, 0.f}; ai_[nb] = (f32x4){0.f, 0.f, 0.f, 0.f}; }
#pragma unroll
            for (int ks = 0; ks < 4; ++ks)
#pragma unroll
                for (int nb = 0; nb < 2; ++nb) {
                    const bf16x8 wr_ = *(const LRU_LAS bf16x8*)(lds + OFF_WB + (es * 32 + nb * 16 + fr) * XCP + (ks * 32 + fq * 8) * 2);
                    const bf16x8 wi_ = *(const LRU_LAS bf16x8*)(lds + OFF_WB + (128 + es * 32 + nb * 16 + fr) * XCP + (ks * 32 + fq * 8) * 2);
                    ar[nb] = __builtin_amdgcn_mfma_f32_16x16x32_bf16(wr_, af[ks], ar[nb], 0, 0, 0);
                    ai_[nb] = __builtin_amdgcn_mfma_f32_16x16x32_bf16(wi_, af[ks], ai_[nb], 0, 0, 0); }
#pragma unroll
            for (int nb = 0; nb < 2; ++nb) {
                const int ch = n * 128 + es * 32 + nb * 16 + fq * 4;
                const f32x4 vbr = *(const f32x4*)(T.br + ch), vbi = *(const f32x4*)(T.bi + ch), vc8 = *(const f32x4*)(T.c8 + ch);
                const u32x2 xw = *(const LRU_LAS u32x2*)(lds + OFF_XC + tok * XCP + (es * 32 + nb * 16 + fq * 4) * 2);
                const float xv[4] = {__uint_as_float(xw.x << 16), __uint_as_float(xw.x & 0xffff0000u), __uint_as_float(xw.y << 16), __uint_as_float(xw.y & 0xffff0000u)};
                f32x4 av, uv;
#pragma unroll
                for (int j = 0; j < 4; ++j) {
                    const float r = __builtin_amdgcn_rcpf(1.0f + __expf(-(ar[nb][j] + vbr[j])));
                    const float ig = __builtin_amdgcn_rcpf(1.0f + __expf(-(ai_[nb][j] + vbi[j])));
                    const float la = -r * vc8[j];
                    const float a = __expf(la);
                    const float y = -2.0f * la;
                    const float poly = y * (1.0f - y * 0.5f * (1.0f - y * (1.0f / 3.0f) * (1.0f - y * 0.25f * (1.0f - y * 0.2f * (1.0f - y * (1.0f / 6.0f))))));
                    const float om = (y < 0.25f) ? poly : (1.0f - a * a);
                    av[j] = a;
                    uv[j] = __builtin_amdgcn_sqrtf(om) * (ig * xv[j]);
                }
                *(LRU_LAS f32x4*)(LA + tok * 32 + nb * 16 + fq * 4) = av; *(LRU_LAS f32x4*)(LU + tok * 32 + nb * 16 + fq * 4) = uv;
            }
        }
        __syncthreads();
        float a8[8], u8[8];
        { float A = 1.f, Hh = 0.f;
#pragma unroll
          for (int j = 0; j < 8; ++j) { a8[j] = LA[(sg * 8 + j) * 32 + se]; u8[j] = LU[(sg * 8 + j) * 32 + se]; Hh = a8[j] * Hh + u8[j]; A *= a8[j]; }
          SA[sg * 32 + se] = A; SH[sg * 32 + se] = Hh; }
        __syncthreads();
        { float h = 0.f, Ap = 1.f;
#pragma unroll
          for (int s2 = 0; s2 < 15; ++s2) { const float sa = SA[s2 * 32 + se], sh = SH[s2 * 32 + se]; if (s2 < sg) { h = sa * h + sh; Ap *= sa; } }
#pragma unroll
          for (int j = 0; j < 8; ++j) { h = a8[j] * h + u8[j]; Ap *= a8[j]; const size_t row = rowb + t0 + sg * 8 + j;
              const float gl = b2f(glr[j]);
              const float y = h * gl, q = Ap * gl; const float yn = __shfl_xor(y, 1), qn = __shfl_xor(q, 1);
              if ((se & 1) == 0) { *(unsigned*)(T.Y + row * 2048 + 1024 + chn) = cvtpk(y, yn); *(unsigned*)(T.Q1 + row * 1024 + chn) = cvtpk(q, qn); } }
          if (sg == 15) { TA[es * 32 + se] = Ap; TH[es * 32 + se] = h; } }
    }
    __syncthreads();
    if (tid < 128) { float* pub = T.PUB + (size_t)(g * 16 + tc) * 256;
        __hip_atomic_store(pub + tid, TA[tid], __ATOMIC_RELAXED, __HIP_MEMORY_SCOPE_AGENT); __hip_atomic_store(pub + 128 + tid, TH[tid], __ATOMIC_RELAXED, __HIP_MEMORY_SCOPE_AGENT); }
    asm volatile("s_waitcnt vmcnt(0)" ::: "memory");
    __syncthreads();
    if (tid == 0) __hip_atomic_store(T.FLG + (size_t)(g * 16 + tc) * 16, 1u, __ATOMIC_RELEASE, __HIP_MEMORY_SCOPE_AGENT);
}

__device__ __forceinline__ void fix(LRU_LAS unsigned char* lds, const Tensors& T, int g, int tc) {
    if (tc == 0) return;
    const int tid = threadIdx.x; LRU_LAS float* CR = (LRU_LAS float*)(lds + OFF_CR);
    if (tid < tc) { unsigned sp = 0; while (__hip_atomic_load(T.FLG + (size_t)(g * 16 + tid) * 16, __ATOMIC_ACQUIRE, __HIP_MEMORY_SCOPE_AGENT) == 0u) { __builtin_amdgcn_s_sleep(2); if (++sp > (1u << 22)) break; } }
    __syncthreads();
    if (tid < 128) { float c = 0.f;
        for (int t2 = 0; t2 < tc; ++t2) { const float* pub = T.PUB + (size_t)(g * 16 + t2) * 256;
            const float pa = __hip_atomic_load(pub + tid, __ATOMIC_RELAXED, __HIP_MEMORY_SCOPE_AGENT), ph = __hip_atomic_load(pub + 128 + tid, __ATOMIC_RELAXED, __HIP_MEMORY_SCOPE_AGENT);
            c = pa * c + ph; }
        CR[tid] = c; }
    __syncthreads();
    const int b = g >> 3, n = g & 7; const size_t rowb = (size_t)b * 2048 + tc * CH;
    const int cg = tid & 15, trow = tid >> 4;
    f32x4 c0 = *(const LRU_LAS f32x4*)(CR + cg * 8), c1 = *(const LRU_LAS f32x4*)(CR + cg * 8 + 4);
#pragma unroll
    for (int i = 0; i < 4; ++i) { const size_t row = rowb + trow + 32 * i;
        unsigned short* yp = T.Y + row * 2048 + 1024 + n * 128 + cg * 8; const unsigned short* qp = T.Q1 + row * 1024 + n * 128 + cg * 8;
        const u32x4 yv = *(const u32x4*)yp, qv = *(const u32x4*)qp; u32x4 o;
#define FIX2_(y, q, ca, cb_) cvtpk(__uint_as_float((y) << 16) + __uint_as_float((q) << 16) * (ca), __uint_as_float((y) & 0xffff0000u) + __uint_as_float((q) & 0xffff0000u) * (cb_))
        o.x = FIX2_(yv.x, qv.x, c0[0], c0[1]); o.y = FIX2_(yv.y, qv.y, c0[2], c0[3]); o.z = FIX2_(yv.z, qv.z, c1[0], c1[1]); o.w = FIX2_(yv.w, qv.w, c1[2], c1[3]);
#undef FIX2_
        *(u32x4*)yp = o; }
    __syncthreads();
}
}

namespace cg = cooperative_groups;
#ifndef REP_P0
#define REP_P0 1
#endif
#ifndef REP_P1
#define REP_P1 1
#endif
#ifndef REP_LRU
#define REP_LRU 1
#endif
#ifndef REP_ATT
#define REP_ATT 1
#endif
#ifndef REP_P3
#define REP_P3 1
#endif
#ifndef REP_P4
#define REP_P4 1
#endif
#ifndef EXTRA_SYNC
#define EXTRA_SYNC 0
#endif
constexpr int NWAVES = 8;
constexpr int BATCH = 4, SEQ = 2048, DM = 2048, M = BATCH * SEQ, DIN = 10240, AW = 1024, LW = 1024, PLE = 256, NH = 8, HD = 128;
constexpr size_t MiB = 1u << 20;
constexpr size_t WS_BAR = 512 * 1024, BAR_BYTES = 16384, WS_FLG = WS_BAR + BAR_BYTES, FLG_BYTES = 32768, WS_C8 = 576 * 1024, WS_PUB = 2 * MiB + 512 * 1024, WS_Q1 = 296 * MiB;
constexpr size_t WS_KMP = 0, WS_SSQ = 1 * MiB, WS_WRT = 2 * MiB, WS_WIT = 2 * MiB + 256 * 1024, WS_WPLE = 3 * MiB, WS_W2 = 4 * MiB, WS_WOUT = 12 * MiB, WS_WG = 20 * MiB, WS_WIN = 28 * MiB,
                 WS_H = 68 * MiB, WS_MG = 68 * MiB, WS_PB = 100 * MiB, WS_Q = 104 * MiB, WS_K = 120 * MiB, WS_V = 136 * MiB, WS_GA = 152 * MiB, WS_XR = 168 * MiB, WS_GL = 184 * MiB,
                 WS_SA = 200 * MiB, WS_SL = 232 * MiB, WS_Y = 264 * MiB, WS_X1G = 104 * MiB, WS_PL = 136 * MiB, WS_END = 312 * MiB;
static_assert(WS_K == WS_Q + 16 * MiB && WS_V == WS_Q + 32 * MiB && WS_GA == WS_Q + 48 * MiB && WS_XR == WS_Q + 64 * MiB && WS_GL == WS_Q + 80 * MiB && WS_SA == WS_Q + 96 * MiB && WS_SL == WS_SA + 32 * MiB, "EpiG1 destination arithmetic");
constexpr int RING_BYTES = 131072, SCR_OFF = RING_BYTES, KM_LDS_OFF = 69632;
constexpr int LDS_BYTES = 147456, MISC_OFF = LDS_BYTES - 64;
static_assert(attn::STG_OFF + 65536 <= LDS_BYTES && attn::KM_OFF == KM_LDS_OFF && attn::KM_OFF + 4096 <= attn::STG_OFF, "attention LDS map");
static_assert(attn::LDS_BYTES <= KM_LDS_OFF && KM_LDS_OFF + 4096 <= RING_BYTES && lru::LRU_LDS <= MISC_OFF && SCR_OFF + 8192 <= LDS_BYTES, "LDS map");

#define GAS __attribute__((address_space(1)))
#define LAS __attribute__((address_space(3)))
typedef unsigned short bf16;
typedef unsigned v4u __attribute__((ext_vector_type(4)));
typedef float f32x4 __attribute__((ext_vector_type(4)));
#define LDS_WAIT() asm volatile("s_waitcnt lgkmcnt(0)" ::: "memory")
__device__ __forceinline__ unsigned f2bf(float f) { unsigned u = __builtin_bit_cast(unsigned, f); return (u + 0x7fffu + ((u >> 16) & 1u)) >> 16; }
__device__ __forceinline__ unsigned pk2(float lo, float hi) { return f2bf(lo) | (f2bf(hi) << 16); }
__device__ __forceinline__ float wave_sum(float v) {
#pragma unroll
    for (int o = 1; o < 64; o <<= 1) v += __shfl_xor(v, o);
    return v;
}
__device__ __forceinline__ void p0_transpose_item(const float* W, int N, bf16* WT, int ldk, int row_off, int k_off, LAS float* scr, int kb, int nb, int lane) {
    const int k0 = 64 * kb, n0 = 32 * nb;
#pragma unroll 8
    for (int i = 0; i < 32; ++i) { const int kk = 2 * i + (lane >> 5); scr[kk * 33 + (lane & 31)] = W[(size_t)(k0 + kk) * N + n0 + (lane & 31)]; }
    LDS_WAIT(); asm volatile("" ::: "memory");
    const int c = lane & 7;
#pragma unroll
    for (int j = 0; j < 4; ++j) { const int n = (lane >> 3) + 8 * j; const LAS float* s = scr + (8 * c) * 33 + n;
        v4u o; o.x = pk2(s[0 * 33], s[1 * 33]); o.y = pk2(s[2 * 33], s[3 * 33]); o.z = pk2(s[4 * 33], s[5 * 33]); o.w = pk2(s[6 * 33], s[7 * 33]);
        *(GAS v4u*)(WT + (size_t)(row_off + n0 + n) * ldk + k_off + k0 + 8 * c) = o; }
    LDS_WAIT(); asm volatile("" ::: "memory");
}

#define RLX_AGENT __ATOMIC_RELAXED, __HIP_MEMORY_SCOPE_AGENT
#define XB_TMO      128
#define XB_XCNT(j)  (256  + 64 * (j))
#define XB_XSUB(j)  (1280 + 64 * (j))
#define XB_XGEN(j)  (2304 + 64 * (j))
#define XB_TOP      3328
#define XB_TOPGEN   3392
#define XCD_BAR_WORDS 3456
#define XB_SPIN_CAP (1u << 18)

__device__ __forceinline__ unsigned xb_ld(unsigned* p)              { return __hip_atomic_load(p, __ATOMIC_RELAXED, __HIP_MEMORY_SCOPE_AGENT); }
__device__ __forceinline__ unsigned xb_add(unsigned* p, unsigned v) { return __hip_atomic_fetch_add(p, v, __ATOMIC_RELAXED, __HIP_MEMORY_SCOPE_AGENT); }
__device__ __forceinline__ unsigned xb_xcc_id() { return (unsigned)__builtin_amdgcn_s_getreg((3 << 11) | 20) & 0xFu; }
#define XB_SPIN(cond, bar) do { unsigned _sp = 0; while (cond) { __builtin_amdgcn_s_sleep(1); \
    if ((++_sp & 255u) == 0u) { if (xb_ld(&(bar)[XB_TMO])) break; if (_sp > XB_SPIN_CAP) { atomicAdd(&(bar)[XB_TMO], 1u); break; } } } } while (0)

struct XcdBarrier {
    unsigned* bar; unsigned x;
    volatile LAS unsigned* st;
};

__device__ __forceinline__ XcdBarrier xcd_barrier_post(unsigned* bar, volatile LAS unsigned* st) {
    XcdBarrier b; b.bar = bar; b.x = xb_xcc_id(); b.st = st;
    if (threadIdx.x == 0) (void)xb_add(&bar[XB_XCNT(b.x)], 1u);
    return b;
}
__device__ __forceinline__ void xcd_barrier_complete(unsigned* bar, unsigned x, unsigned& nloc, unsigned& nx) {
    const unsigned G = gridDim.x * gridDim.y * gridDim.z;
    unsigned sum, cnt, mine, sp = 0u;
    for (;;) {
        sum = 0u; cnt = 0u; mine = 0u;
#pragma unroll
        for (unsigned j = 0; j < 16; ++j) { const unsigned c = xb_ld(&bar[XB_XCNT(j)]); sum += c; cnt += (c > 0u) ? 1u : 0u; mine = (j == x) ? c : mine; }
        if (sum == G) break;
        __builtin_amdgcn_s_sleep(1);
        if ((++sp & 255u) == 0u) { if (xb_ld(&bar[XB_TMO])) break; if (sp > XB_SPIN_CAP) { atomicAdd(&bar[XB_TMO], 1u); break; } }
    }
    nloc = mine > 0u ? mine : 1u; nx = cnt > 0u ? cnt : 1u;
}

__device__ __forceinline__ void xcd_barrier(const XcdBarrier& b) {
    asm volatile("s_waitcnt vmcnt(0)" ::: "memory");
    __syncthreads();
    if (threadIdx.x == 0) {
        unsigned* bar = b.bar;
        __builtin_amdgcn_s_waitcnt(0);
        unsigned nloc = b.st[0], nx = b.st[1];
        if (nloc == 0u) { xcd_barrier_complete(bar, b.x, nloc, nx); b.st[0] = nloc; b.st[1] = nx; }
        const unsigned old = xb_add(&bar[XB_XSUB(b.x)], 1u);
        const unsigned gen = old / nloc;
        if (old + 1u == (gen + 1u) * nloc) {
            __builtin_amdgcn_fence(__ATOMIC_RELEASE, "agent");
            asm volatile("s_waitcnt vmcnt(0)" ::: "memory");
            const unsigned og = xb_add(&bar[XB_TOP], 1u);
            const unsigned tg = og / nx;
            if (og + 1u == (tg + 1u) * nx) xb_add(&bar[XB_TOPGEN], 1u);
            else XB_SPIN(xb_ld(&bar[XB_TOPGEN]) == tg, bar);
            __builtin_amdgcn_fence(__ATOMIC_ACQUIRE, "agent");
            xb_add(&bar[XB_XGEN(b.x)], 1u);
            asm volatile("s_waitcnt vmcnt(0)" ::: "memory");
        } else {
            XB_SPIN(xb_ld(&bar[XB_XGEN(b.x)]) == gen, bar);
            __builtin_amdgcn_fence(__ATOMIC_ACQUIRE, "agent");
            asm volatile("s_waitcnt vmcnt(0)" ::: "memory");
        }
    }
    __syncthreads();
}

struct Args { const float* in[20]; float* out; unsigned char* ws; };

__device__ __forceinline__ void p0_prologue(const Args& args, LAS unsigned char* ldsl, int vcu, int G, int wave, int lane, bf16* Win_t, bf16* W2_t, bf16* Wout_t, bf16* Wg_t, bf16* Wple_t, bf16* Wr_t, bf16* Wi_t, bf16* Hb, bf16* PB, float* C8) {
    {
        LAS float* scr = (LAS float*)(ldsl + wave * 16384);
        const int gw = vcu * NWAVES + wave, NGW = G * NWAVES;
        constexpr int I0 = 32 * 320, I1 = 16 * 64, I2 = 16 * 64, I3 = 32 * 64, I4 = 32 * 64, I5 = 4 * 64, I6 = 64, I7 = 64;
        constexpr int NITEMS = I0 + I1 + I2 + I3 + I4 + I5 + I6 + I7;
        for (int it = gw; it < NITEMS; it += NGW) {
            int r = it;
            if (r < I0) { p0_transpose_item(args.in[3], DIN, Win_t, 2048, 0, 0, scr, r / 320, r % 320, lane); continue; } r -= I0;
            if (r < I1) { p0_transpose_item(args.in[13], DM, W2_t, 2048, 0, 0, scr, r / 64, r % 64, lane); continue; } r -= I1;
            if (r < I2) { p0_transpose_item(args.in[14], DM, W2_t, 2048, 0, 1024, scr, r / 64, r % 64, lane); continue; } r -= I2;
            if (r < I3) { p0_transpose_item(args.in[15], DM, Wout_t, 2048, 0, 0, scr, r / 64, r % 64, lane); continue; } r -= I3;
            if (r < I4) { p0_transpose_item(args.in[17], DM, Wg_t, 2048, 0, 0, scr, r / 64, r % 64, lane); continue; } r -= I4;
            if (r < I5) { p0_transpose_item(args.in[19], DM, Wple_t, 256, 0, 0, scr, r / 64, r % 64, lane); continue; } r -= I5;
            if (r < I6) { const int n = r >> 3, s = r & 7; p0_transpose_item(args.in[8] + (size_t)n * 16384, 128, Wr_t, 128, n * 128, 0, scr, s >> 2, s & 3, lane); continue; } r -= I6;
            { const int n = r >> 3, s = r & 7; p0_transpose_item(args.in[10] + (size_t)n * 16384, 128, Wi_t, 128, n * 128, 0, scr, s >> 2, s & 3, lane); }
        }
        const float* x = args.in[0]; const float* ng = args.in[2];
        for (int m = gw; m < M; m += NGW) {
            const GAS f32x4* xr = (const GAS f32x4*)(x + (size_t)m * DM) + lane; const GAS f32x4* gr = (const GAS f32x4*)ng + lane;
            f32x4 v[8]; float s = 0.f;
#pragma unroll
            for (int j = 0; j < 8; ++j) { v[j] = xr[64 * j]; s += (v[j].x * v[j].x + v[j].y * v[j].y) + (v[j].z * v[j].z + v[j].w * v[j].w); }
            const float rstd = 1.0f / sqrtf(wave_sum(s) * (1.0f / DM) + 1e-6f);
            GAS unsigned long long* o8 = (GAS unsigned long long*)(Hb + (size_t)m * DM) + lane;
#pragma unroll
            for (int j = 0; j < 8; ++j) { const f32x4 g = gr[64 * j];
                o8[64 * j] = (unsigned long long)pk2(v[j].x * rstd * g.x, v[j].y * rstd * g.y) | ((unsigned long long)pk2(v[j].z * rstd * g.z, v[j].w * rstd * g.w) << 32); }
        }
        if (gw < 16) { const int i = gw * 64 + lane; const float x = -args.in[12][i]; C8[i] = 8.0f * (fmaxf(x, 0.f) + log1pf(expf(-fabsf(x)))); }
        const float* p = args.in[1];
        for (int m = gw; m < M; m += NGW) {
            const f32x4 v = ((const GAS f32x4*)(p + (size_t)m * PLE))[lane];
            ((GAS unsigned long long*)(PB + (size_t)m * PLE))[lane] = (unsigned long long)pk2(v.x, v.y) | ((unsigned long long)pk2(v.z, v.w) << 32);
        }
    }
}

template <bool DO_LRU, bool DO_ATT> __device__ __forceinline__ void p2_phase(const Args& args, unsigned char* lds, LAS unsigned char* ldsl, int vcu, int G, bf16* Qb, bf16* Kb, bf16* Vb, bf16* GA, bf16* XR, bf16* GL, bf16* Yb, bf16* Wr_t, bf16* Wi_t, float* KMP, bf16* Q1b, float* PUB, unsigned* FLG, const float* C8) {
    const lru::Tensors T{XR, GL, Yb, Q1b, Wr_t, Wi_t, args.in[6], args.in[7], args.in[9], args.in[11], C8, PUB, FLG};
#ifndef SKIP_LRU
    if constexpr (DO_LRU)
    for (int L = vcu; L < 256; L += G) { const int g = L >> 3, q = L & 7;
        if (q < 7) { lru::load_weights(ldsl, T, g & 7); __syncthreads();
#pragma unroll 1
            for (int r = 0; r < 4; ++r) { const int tc = lru::unit_tc(q, r); if (tc >= 0) lru::unit(ldsl, T, g, tc); } }
    }
#endif
#ifndef SKIP_ATTN
    if constexpr (DO_ATT)
    attn::phase((char*)lds, (const attn::bf16*)Qb, (const attn::bf16*)Kb, (const attn::bf16*)Vb, (attn::bf16*)Yb, (const attn::bf16*)GA, KMP, vcu, G);
#endif
#ifndef SKIP_LRU
    if constexpr (DO_LRU)
    for (int L = vcu; L < 256; L += G) { const int g = L >> 3, q = L & 7;
#pragma unroll 1
        for (int r = 0; r < 4; ++r) { const int tc = lru::unit_tc(q, r); if (tc > 0) lru::fix(ldsl, T, g, tc); }
    }
#endif
}

__global__ void __launch_bounds__(NWAVES * 64, 2) moba_rglru_fwd(Args args) {
    extern __shared__ __attribute__((aligned(16))) unsigned char lds[];
    cg::grid_group grid = cg::this_grid();
    LAS unsigned char* ldsl = (LAS unsigned char*)lds;
    const int tid = threadIdx.x, lane = tid & 63, wave = __builtin_amdgcn_readfirstlane(tid >> 6);
    const int G = gridDim.x; const int bx = blockIdx.x; const int vcu = (G % 8 == 0) ? (bx % 8) * (G / 8) + bx / 8 : bx;
    unsigned char* ws = args.ws;
    volatile LAS unsigned* MISC = (volatile LAS unsigned*)(ldsl + MISC_OFF);
    if (tid < 16) MISC[tid] = 0u;
    __syncthreads();
    XcdBarrier bar = xcd_barrier_post((unsigned*)(ws + WS_BAR), MISC);
    if (G > (1 << 20)) grid.sync();
#define GRID_BAR() xcd_barrier(bar)
    bf16* Win_t = (bf16*)(ws + WS_WIN); bf16* W2_t = (bf16*)(ws + WS_W2); bf16* Wout_t = (bf16*)(ws + WS_WOUT); bf16* Wg_t = (bf16*)(ws + WS_WG); bf16* Wple_t = (bf16*)(ws + WS_WPLE);
    bf16* Wr_t = (bf16*)(ws + WS_WRT); bf16* Wi_t = (bf16*)(ws + WS_WIT);
    bf16* Hb = (bf16*)(ws + WS_H); bf16* MG = (bf16*)(ws + WS_MG); bf16* PB = (bf16*)(ws + WS_PB);
    bf16* Qb = (bf16*)(ws + WS_Q); bf16* Kb = (bf16*)(ws + WS_K); bf16* Vb = (bf16*)(ws + WS_V); bf16* GA = (bf16*)(ws + WS_GA); bf16* XR = (bf16*)(ws + WS_XR); bf16* GL = (bf16*)(ws + WS_GL);
    bf16* SAb = (bf16*)(ws + WS_SA); bf16* SLb = (bf16*)(ws + WS_SL); bf16* Yb = (bf16*)(ws + WS_Y); bf16* X1G = (bf16*)(ws + WS_X1G); bf16* PL = (bf16*)(ws + WS_PL);
    float* KMP = (float*)(ws + WS_KMP); float* SSQ = (float*)(ws + WS_SSQ);
    bf16* Q1b = (bf16*)(ws + WS_Q1); float* PUB = (float*)(ws + WS_PUB); unsigned* FLG = (unsigned*)(ws + WS_FLG); float* C8 = (float*)(ws + WS_C8);

#ifndef SKIP_P0
    p0_prologue(args, ldsl, vcu, G, wave, lane, Win_t, W2_t, Wout_t, Wg_t, Wple_t, Wr_t, Wi_t, Hb, PB, C8);
#if REP_P0 >= 2
    p0_prologue(args, ldsl, vcu, G, wave, lane, Win_t, W2_t, Wout_t, Wg_t, Wple_t, Wr_t, Wi_t, Hb, PB, C8);
#endif
#if REP_P0 >= 3
    p0_prologue(args, ldsl, vcu, G, wave, lane, Win_t, W2_t, Wout_t, Wg_t, Wple_t, Wr_t, Wi_t, Hb, PB, C8);
#endif
#endif
    GRID_BAR();

    for (int es_ = 0; es_ < EXTRA_SYNC; ++es_) GRID_BAR();
#ifndef SKIP_P1
    for (int rep_ = 0; rep_ < REP_P1; ++rep_) {
    {
        pg8::Gemm g{Hb, Win_t, M, DIN, DM}; pg8::StaticOrder S; S.init(M, DIN, G, bx);
        pg8::EpiG1 E{ws + WS_Q, KMP, args.in[4], args.in[5], (LAS float*)(ldsl + SCR_OFF), 0};
        pg8::gemm_phase<pg8::EpiG1, pg8::StaticOrder, true, true>(ldsl, g, S, E);
    }
    }
#endif
    GRID_BAR();

#ifndef SKIP_P2
    p2_phase<true, true>(args, lds, ldsl, vcu, G, Qb, Kb, Vb, GA, XR, GL, Yb, Wr_t, Wi_t, KMP, Q1b, PUB, FLG, C8);
#if REP_LRU >= 2
    p2_phase<true, false>(args, lds, ldsl, vcu, G, Qb, Kb, Vb, GA, XR, GL, Yb, Wr_t, Wi_t, KMP, Q1b, PUB, FLG, C8);
#endif
#if REP_ATT >= 2
    p2_phase<false, true>(args, lds, ldsl, vcu, G, Qb, Kb, Vb, GA, XR, GL, Yb, Wr_t, Wi_t, KMP, Q1b, PUB, FLG, C8);
#endif
#if REP_LRU >= 3
    p2_phase<true, false>(args, lds, ldsl, vcu, G, Qb, Kb, Vb, GA, XR, GL, Yb, Wr_t, Wi_t, KMP, Q1b, PUB, FLG, C8);
#endif
#if REP_ATT >= 3
    p2_phase<false, true>(args, lds, ldsl, vcu, G, Qb, Kb, Vb, GA, XR, GL, Yb, Wr_t, Wi_t, KMP, Q1b, PUB, FLG, C8);
#endif
#endif
    GRID_BAR();

#ifndef SKIP_P3
    for (int rep_ = 0; rep_ < REP_P3; ++rep_) {
    {
        pg8::Gemm g{Yb, W2_t, M, DM, DM}; pg8::StaticOrder S; S.init(M, DM, G, bx);
        pg8::EpiG2 E{SAb, SLb, MG, 16};
        pg8::gemm_phase<pg8::EpiG2, pg8::StaticOrder, true, true>(ldsl, g, S, E);
    }
    }
#endif
    GRID_BAR();

#ifndef SKIP_P4
    for (int rep_ = 0; rep_ < REP_P4; ++rep_) {
    {
        pg8::Gemm g{MG, Wout_t, M, DM, DM}; pg8::StaticOrder S; S.init(M, DM, G, bx);
        pg8::EpiG3 E{args.in[0], args.out, X1G, SSQ, args.in[16], 0};
        pg8::gemm_phase<pg8::EpiG3, pg8::StaticOrder, true, true>(ldsl, g, S, E);
    }
    }
#endif
    GRID_BAR();

#ifndef SKIP_P5
    {
        { pg8::Gemm g{PB, Wple_t, M, DM, PLE}; pg8::StaticOrder S; S.init(M, DM, G, bx);
          pg8::EpiG4a E{PL, 0};
          pg8::gemm_phase<pg8::EpiG4a, pg8::StaticOrder, true, true>(ldsl, g, S, E); }
        asm volatile("s_waitcnt vmcnt(0)" ::: "memory"); __syncthreads();
        { pg8::Gemm g{X1G, Wg_t, M, DM, DM}; pg8::StaticOrder S; S.init(M, DM, G, bx);
          pg8::EpiG4b E{args.out, PL, SSQ, args.in[18], (LAS float*)(ldsl + SCR_OFF), 0};
          pg8::gemm_phase<pg8::EpiG4b, pg8::StaticOrder, true, true>(ldsl, g, S, E); }
    }
#endif
}

extern "C" void kernel_launch(void* const* d_in, const int* in_sizes, int n_in, void* d_out, int out_size, void* d_ws, size_t ws_size, hipStream_t stream) {
    static int grid_blocks = 0;
    if (grid_blocks == 0) {
        if (n_in != 20 || in_sizes[0] != M * DM || out_size != M * DM || ws_size < WS_END) { fprintf(stderr, "kernel_launch: unexpected shapes (n_in %d, in0 %d, out %d, ws %zu)\n", n_in, n_in > 0 ? in_sizes[0] : -1, out_size, ws_size); grid_blocks = -1; return; }
        int dev = 0, cus = 0, per_cu = 0;
        (void)hipGetDevice(&dev);
        (void)hipDeviceGetAttribute(&cus, hipDeviceAttributeMultiprocessorCount, dev);
        if (hipFuncSetAttribute((const void*)moba_rglru_fwd, hipFuncAttributeMaxDynamicSharedMemorySize, LDS_BYTES) != hipSuccess) { fprintf(stderr, "kernel_launch: hipFuncSetAttribute failed\n"); }
        if (hipOccupancyMaxActiveBlocksPerMultiprocessor(&per_cu, (const void*)moba_rglru_fwd, NWAVES * 64, LDS_BYTES) != hipSuccess || per_cu < 1) { fprintf(stderr, "kernel_launch: occupancy query failed (%d)\n", per_cu); per_cu = 1; }
        (void)hipGetLastError();
        if (per_cu > 1) per_cu = 1;
        grid_blocks = cus * per_cu;
        if (grid_blocks > 256) grid_blocks = 256;
    }
    if (grid_blocks < 0) return;
    if (hipMemsetAsync((char*)d_ws + WS_BAR, 0, BAR_BYTES + FLG_BYTES, stream) != hipSuccess) { fprintf(stderr, "kernel_launch: hipMemsetAsync failed\n"); return; }
    Args a{};
    for (int i = 0; i < 20; ++i) a.in[i] = (const float*)d_in[i];
    a.out = (float*)d_out; a.ws = (unsigned char*)d_ws;
    void* kargs[] = {&a};
    hipError_t e = hipLaunchCooperativeKernel((const void*)moba_rglru_fwd, dim3(grid_blocks), dim3(NWAVES * 64), kargs, LDS_BYTES, stream);
    if (e != hipSuccess) fprintf(stderr, "cooperative launch failed: %s (grid %d)\n", hipGetErrorString(e), grid_blocks);
}
```

```cpp
#include <hip/hip_runtime.h>
#include <hip/hip_bf16.h>
#include <hip/hip_cooperative_groups.h>
#include <cstdio>
#include <cstdint>
#include <cmath>
namespace pg8 {
#define PG8_LAS __attribute__((address_space(3)))
typedef unsigned short bf16_t;
typedef short bf16x8 __attribute__((ext_vector_type(8)));
typedef float f32x4 __attribute__((ext_vector_type(4)));
typedef unsigned u32x4 __attribute__((ext_vector_type(4)));
constexpr int BM = 256, BK = 64, HALF = 128, HTB = HALF * BK * 2  , STAGE_BYTES = 8 * HTB, NXCD = 8, WGM = 8;

__host__ __device__ __forceinline__ int lds_byte(int r, int c) { const int st = (r >> 4) * 2 + (c >> 5), rr = r & 15, cc = c & 31, ob = rr * 64 + cc * 2; return st * 1024 + (ob ^ (((ob >> 9) & 1) << 5)); }
__host__ __device__ __forceinline__ void stage_rc(int b, int& R, int& C) { const int st = b / 1024, sb = b % 1024, swz = sb ^ (((sb >> 9) & 1) << 5); R = (st >> 1) * 16 + swz / 64; C = (st & 1) * 32 + (swz % 64) / 2; }
__host__ __device__ __forceinline__ int perm32(int rho) { const int n = rho >> 4, i = rho & 15; return 8 * (i >> 2) + 4 * n + (i & 3); }

struct Unit { int pm, pn; };
struct Gemm { const bf16_t* A; const bf16_t* Bt; int M, N, K; };

struct StaticOrder {
    int nM, nN, nwg, G, c;
    __host__ __device__ void init(int M, int N, int G_, int c_) { nM = M / BM; nN = N / BM; nwg = nM * nN; G = G_; c = c_; }
    __host__ __device__ bool next(int i, Unit& u) const {
        const long L = (long)i * G + c; if (L >= nwg) return false;
        int wgid = (int)L; { const int q = nwg / NXCD, r = nwg % NXCD, xcd = wgid % NXCD, off = wgid / NXCD; wgid = (xcd < r ? xcd * (q + 1) : r * (q + 1) + (xcd - r) * q) + off; }
        const int nig = WGM * nN, gid = wgid / nig, fm = gid * WGM, gsz = (nM - fm) < WGM ? (nM - fm) : WGM;
        u.pm = fm + ((wgid % nig) % gsz); u.pn = (wgid % nig) / gsz; return true;
    }
    __device__ __forceinline__ void a_ready(const Unit&) const {}
    __device__ __forceinline__ void done(const Unit&) const {}
};

__device__ __forceinline__ unsigned cvt_pk_bf16(float lo, float hi) { unsigned r; asm volatile("v_cvt_pk_bf16_f32 %0, %1, %2" : "=v"(r) : "v"(lo), "v"(hi)); return r; }
__device__ __forceinline__ float bf_lo(unsigned w) { return __uint_as_float(w << 16); }
__device__ __forceinline__ float bf_hi(unsigned w) { return __uint_as_float(w & 0xffff0000u); }
__device__ __forceinline__ float sigmoidf_(float x) { return __builtin_amdgcn_rcpf(1.0f + __expf(-x)); }
__device__ __forceinline__ float siluf_(float x) { return x * __builtin_amdgcn_rcpf(1.0f + __expf(-x)); }
__device__ __forceinline__ u32x4 pack8bf(const f32x4& v0, const f32x4& v1) { u32x4 w; w.x = cvt_pk_bf16(v0[0], v0[1]); w.y = cvt_pk_bf16(v0[2], v0[3]); w.z = cvt_pk_bf16(v1[0], v1[1]); w.w = cvt_pk_bf16(v1[2], v1[3]); return w; }
__device__ __forceinline__ void unpack8bf(const u32x4& w, f32x4& v0, f32x4& v1) { v0 = (f32x4){bf_lo(w.x), bf_hi(w.x), bf_lo(w.y), bf_hi(w.y)}; v1 = (f32x4){bf_lo(w.z), bf_hi(w.z), bf_lo(w.w), bf_hi(w.w)}; }

#ifndef WT_STORES
#define WT_STORES 0
#endif
__device__ __forceinline__ void st16(void* p, const u32x4& v) {
#if WT_STORES
    asm volatile("global_store_dwordx4 %0, %1, off sc1\n\ts_nop 1" :: "v"(p), "v"(v) : "memory");
#else
    *(u32x4*)p = v;
#endif
}
__device__ __forceinline__ void st16p(void* p, const u32x4& v) { *(u32x4*)p = v; }
__device__ __forceinline__ void st16f(void* p, const f32x4& v) { *(f32x4*)p = v; }
constexpr int SEQ_ = 2048, NHEAD_ = 8;
struct EpiG1 {
    static constexpr bool PERM = true, AFTER_DRAIN = false, HOOK = false;
    unsigned char* wsQ; float* KMP; const float *qg, *kg; PG8_LAS float* scr; int hook_t;
    __device__ __forceinline__ void mid(f32x4 (&acc)[2][2][4][2], const Unit& u, int wr, int wc, int fr, int fq) const {}
    __device__ __forceinline__ void operator()(f32x4 (&acc)[2][2][4][2], const Unit& u, int wr, int wc, int fr, int fq) const {
        const int pn = u.pn; asm volatile("" : "+v"(fr), "+v"(fq));
        if (pn < 12) {
            if (pn < 8) {
#pragma unroll
                for (int ai = 0; ai < 2; ++ai)
#pragma unroll
                    for (int m = 0; m < 4; ++m)
#pragma unroll
                        for (int bj = 0; bj < 2; ++bj) {
                            const f32x4 a = acc[ai][bj][m][0], b = acc[ai][bj][m][1];
                            float s = (a[0] * a[0] + a[1] * a[1]) + (a[2] * a[2] + a[3] * a[3]) + (b[0] * b[0] + b[1] * b[1]) + (b[2] * b[2] + b[3] * b[3]);
                            s += __shfl_xor(s, 16); s += __shfl_xor(s, 32);
                            if (fq == 0) scr[((ai * HALF + wr * 64 + m * 16 + fr) * 2 + bj) * 4 + wc] = s;
                        }
                const f32x4 gq0 = *(const f32x4*)(qg + wc * 32 + 8 * fq), gq1 = *(const f32x4*)(qg + wc * 32 + 8 * fq + 4);
                const f32x4 gk0 = *(const f32x4*)(kg + wc * 32 + 8 * fq), gk1 = *(const f32x4*)(kg + wc * 32 + 8 * fq + 4);
                asm volatile("s_waitcnt lgkmcnt(0)" ::: "memory"); __builtin_amdgcn_s_barrier(); asm volatile("" ::: "memory");
                const f32x4 g0 = (pn < 4) ? gq0 : gk0, g1 = (pn < 4) ? gq1 : gk1;
#pragma unroll
                for (int ai = 0; ai < 2; ++ai)
#pragma unroll
                    for (int m = 0; m < 4; ++m)
#pragma unroll
                        for (int bj = 0; bj < 2; ++bj) {
                            const f32x4 p = *(const PG8_LAS f32x4*)(scr + ((ai * HALF + wr * 64 + m * 16 + fr) * 2 + bj) * 4);
                            const float rstd = __builtin_amdgcn_rsqf(((p[0] + p[1]) + (p[2] + p[3])) * (1.0f / 128.0f) + 1e-6f);
                            acc[ai][bj][m][0] = acc[ai][bj][m][0] * rstd * g0; acc[ai][bj][m][1] = acc[ai][bj][m][1] * rstd * g1;
                        }
                if (pn >= 4) {
#pragma unroll
                    for (int bj = 0; bj < 2; ++bj)
#pragma unroll
                        for (int n = 0; n < 2; ++n) {
                            f32x4 cs = (f32x4){0.f, 0.f, 0.f, 0.f};
#pragma unroll
                            for (int ai = 0; ai < 2; ++ai)
#pragma unroll
                                for (int m = 0; m < 4; ++m) cs += acc[ai][bj][m][n];
#pragma unroll
                            for (int o = 1; o < 16; o <<= 1) { cs[0] += __shfl_xor(cs[0], o); cs[1] += __shfl_xor(cs[1], o); cs[2] += __shfl_xor(cs[2], o); cs[3] += __shfl_xor(cs[3], o); }
                            if (fr == 0) *(f32x4*)(KMP + (size_t)(u.pm * 2 + wr) * 1024 + (pn - 4) * 256 + bj * HALF + wc * 32 + 8 * fq + 4 * n) = cs;
                        }
                }
            }
            bf16_t* base = (bf16_t*)(wsQ + (size_t)(pn >> 2) * (16u << 20));
            const int b = u.pm >> 3, s0 = (u.pm & 7) * 256 + wr * 64 + fr;
#pragma unroll
            for (int bj = 0; bj < 2; ++bj) {
                const int h = 2 * (pn & 3) + bj;
                bf16_t* hp = base + ((size_t)(b * NHEAD_ + h) * SEQ_ + s0) * 128 + wc * 32 + 8 * fq;
#pragma unroll
                for (int ai = 0; ai < 2; ++ai)
#pragma unroll
                    for (int m = 0; m < 4; ++m) st16p(hp + (size_t)(ai * HALF + m * 16) * 128, pack8bf(acc[ai][bj][m][0], acc[ai][bj][m][1]));
            }
        } else {
            bf16_t* base; int ldc, colt, act;
            if (pn < 24) { base = (bf16_t*)(wsQ + (size_t)(pn >> 2) * (16u << 20)); ldc = 1024; colt = (pn & 3) * 256; act = ((pn >> 2) == 4) ? 0 : 1; }
            else { base = (bf16_t*)(wsQ + (size_t)(96u << 20) + (size_t)((pn - 24) >> 3) * (32u << 20)); ldc = 2048; colt = ((pn - 24) & 7) * 256; act = 2; }
            const int row0 = u.pm * BM + wr * 64 + fr, col0 = colt + wc * 32 + 8 * fq;
#pragma unroll
            for (int ai = 0; ai < 2; ++ai)
#pragma unroll
                for (int m = 0; m < 4; ++m) { bf16_t* rowp = base + (size_t)(row0 + ai * HALF + m * 16) * ldc + col0;
#pragma unroll
                    for (int bj = 0; bj < 2; ++bj) { f32x4 v0 = acc[ai][bj][m][0], v1 = acc[ai][bj][m][1];
                        if (act != 0) {
#pragma unroll
                            for (int j = 0; j < 4; ++j) { const float e0 = __builtin_amdgcn_rcpf(1.0f + __expf(-v0[j])), e1 = __builtin_amdgcn_rcpf(1.0f + __expf(-v1[j]));
                                v0[j] = (act == 1) ? v0[j] * e0 : e0; v1[j] = (act == 1) ? v1[j] * e1 : e1; } }
                        st16p(rowp + bj * HALF, pack8bf(v0, v1)); } }
        }
    }
};

struct EpiG2 {
    static constexpr bool PERM = true, AFTER_DRAIN = false, HOOK = true;
    const bf16_t *SA, *SL; bf16_t* MG; int hook_t;
    __device__ __forceinline__ void mid(f32x4 (&acc)[2][2][4][2], const Unit& u, int wr, int wc, int fr, int fq) const {
        asm volatile("" : "+v"(fr), "+v"(fq)); const int row0 = u.pm * BM + wr * 64 + fr, col0 = u.pn * BM + wc * 32 + 8 * fq;
#pragma unroll
        for (int ai = 0; ai < 2; ++ai)
#pragma unroll
            for (int m = 0; m < 4; ++m) { const size_t off = (size_t)(row0 + ai * HALF + m * 16) * 2048 + col0;
#pragma unroll
                for (int bj = 0; bj < 2; ++bj) {
                    const u32x4 wa = *(const u32x4*)(SA + off + bj * HALF), wl = *(const u32x4*)(SL + off + bj * HALF);
                    f32x4 a0, a1, l0, l1; unpack8bf(wa, a0, a1); unpack8bf(wl, l0, l1);
#pragma unroll
                    for (int j = 0; j < 4; ++j) { acc[ai][bj][m][0][j] *= a0[j] * __builtin_amdgcn_rcpf(l0[j]); acc[ai][bj][m][1][j] *= a1[j] * __builtin_amdgcn_rcpf(l1[j]); }
                }
                if (m == 3) asm volatile("" ::: "memory"); }
    }
    __device__ __forceinline__ void operator()(f32x4 (&acc)[2][2][4][2], const Unit& u, int wr, int wc, int fr, int fq) const {
        asm volatile("" : "+v"(fr), "+v"(fq)); const int row0 = u.pm * BM + wr * 64 + fr, col0 = u.pn * BM + wc * 32 + 8 * fq;
        u32x4 wl[2][4][2];
#pragma unroll
        for (int ai = 0; ai < 2; ++ai)
#pragma unroll
            for (int m = 0; m < 4; ++m) { const size_t off = (size_t)(row0 + ai * HALF + m * 16) * 2048 + col0;
#pragma unroll
                for (int bj = 0; bj < 2; ++bj) wl[ai][m][bj] = *(const u32x4*)(SL + off + bj * HALF); }
        asm volatile("" ::: "memory");
#pragma unroll
        for (int ai = 0; ai < 2; ++ai)
#pragma unroll
            for (int m = 0; m < 4; ++m) { const size_t off = (size_t)(row0 + ai * HALF + m * 16) * 2048 + col0;
#pragma unroll
                for (int bj = 0; bj < 2; ++bj) {
                    f32x4 l0, l1; unpack8bf(wl[ai][m][bj], l0, l1);
                    st16(MG + off + bj * HALF, pack8bf(acc[ai][bj][m][0] * l0, acc[ai][bj][m][1] * l1));
                } }
    }
};

struct EpiG3 {
    static constexpr bool PERM = true, AFTER_DRAIN = false, HOOK = false;
    const float* X; float* OUT; bf16_t* X1G; float* SSQ; const float* gple; int hook_t;
    __device__ __forceinline__ void mid(f32x4 (&acc)[2][2][4][2], const Unit& u, int wr, int wc, int fr, int fq) const {}
    __device__ __forceinline__ void operator()(f32x4 (&acc)[2][2][4][2], const Unit& u, int wr, int wc, int fr, int fq) const {
        asm volatile("" : "+v"(fr), "+v"(fq)); const int row0 = u.pm * BM + wr * 64 + fr, col0 = u.pn * BM + wc * 32 + 8 * fq;
        f32x4 gv[2][2];
#pragma unroll
        for (int bj = 0; bj < 2; ++bj) { gv[bj][0] = *(const f32x4*)(gple + col0 + bj * HALF); gv[bj][1] = *(const f32x4*)(gple + col0 + bj * HALF + 4); }
#pragma unroll
        for (int ai = 0; ai < 2; ++ai) {
            f32x4 xl[4][2][2];
#pragma unroll
            for (int m = 0; m < 4; ++m) { const size_t off = (size_t)(row0 + ai * HALF + m * 16) * 2048 + col0;
#pragma unroll
                for (int bj = 0; bj < 2; ++bj) { xl[m][bj][0] = *(const f32x4*)(X + off + bj * HALF); xl[m][bj][1] = *(const f32x4*)(X + off + bj * HALF + 4); } }
            asm volatile("" ::: "memory");
#pragma unroll
            for (int m = 0; m < 4; ++m) { const int row = row0 + ai * HALF + m * 16; const size_t off = (size_t)row * 2048 + col0; float s = 0.f;
#pragma unroll
                for (int bj = 0; bj < 2; ++bj) {
                    const f32x4 x0 = xl[m][bj][0] + acc[ai][bj][m][0], x1 = xl[m][bj][1] + acc[ai][bj][m][1];
                    st16f(OUT + off + bj * HALF, x0); st16f(OUT + off + bj * HALF + 4, x1);
                    s += (x0[0] * x0[0] + x0[1] * x0[1]) + (x0[2] * x0[2] + x0[3] * x0[3]) + (x1[0] * x1[0] + x1[1] * x1[1]) + (x1[2] * x1[2] + x1[3] * x1[3]);
                    st16(X1G + off + bj * HALF, pack8bf(x0 * gv[bj][0], x1 * gv[bj][1]));
                }
                s += __shfl_xor(s, 16); s += __shfl_xor(s, 32);
                if (fq == 0) SSQ[(size_t)row * 32 + u.pn * 4 + wc] = s;
            }
            asm volatile("" ::: "memory");
        }
    }
};

struct EpiG4a {
    static constexpr bool PERM = true, AFTER_DRAIN = false, HOOK = false;
    bf16_t* PL; int hook_t;
    __device__ __forceinline__ void mid(f32x4 (&acc)[2][2][4][2], const Unit& u, int wr, int wc, int fr, int fq) const {}
    __device__ __forceinline__ void operator()(f32x4 (&acc)[2][2][4][2], const Unit& u, int wr, int wc, int fr, int fq) const {
        asm volatile("" : "+v"(fr), "+v"(fq)); const int row0 = u.pm * BM + wr * 64 + fr, col0 = u.pn * BM + wc * 32 + 8 * fq;
#pragma unroll
        for (int ai = 0; ai < 2; ++ai)
#pragma unroll
            for (int m = 0; m < 4; ++m) { const size_t off = (size_t)(row0 + ai * HALF + m * 16) * 2048 + col0;
#pragma unroll
                for (int bj = 0; bj < 2; ++bj) st16p(PL + off + bj * HALF, pack8bf(acc[ai][bj][m][0], acc[ai][bj][m][1])); }
    }
};

struct EpiG4b {
    static constexpr bool PERM = true, AFTER_DRAIN = false, HOOK = false;
    float* OUT; const bf16_t* PL; const float* SSQ; const float* bias; PG8_LAS float* scr; int hook_t;
    __device__ __forceinline__ void mid(f32x4 (&acc)[2][2][4][2], const Unit& u, int wr, int wc, int fr, int fq) const {}
    __device__ __forceinline__ void operator()(f32x4 (&acc)[2][2][4][2], const Unit& u, int wr, int wc, int fr, int fq) const {
        asm volatile("" : "+v"(fr), "+v"(fq)); const int row0 = u.pm * BM + wr * 64 + fr, col0 = u.pn * BM + wc * 32 + 8 * fq;
        {
            const int tid = threadIdx.x, hf = tid & 1; int rr = tid >> 1; asm volatile("" : "+v"(rr));
            f32x4 t = (f32x4){0.f, 0.f, 0.f, 0.f};
#pragma unroll
            for (int i = 0; i < 4; ++i) t += *(const f32x4*)(SSQ + (size_t)(u.pm * BM + rr) * 32 + hf * 16 + 4 * i);
            float s = (t[0] + t[1]) + (t[2] + t[3]); s += __shfl_xor(s, 1);
            if (hf == 0) scr[rr] = __builtin_amdgcn_rsqf(s * (1.0f / 2048.0f) + 1e-6f);
            asm volatile("s_waitcnt lgkmcnt(0)" ::: "memory"); __builtin_amdgcn_s_barrier(); asm volatile("" ::: "memory");
        }
        f32x4 bv[2][2];
#pragma unroll
        for (int bj = 0; bj < 2; ++bj) { bv[bj][0] = *(const f32x4*)(bias + col0 + bj * HALF); bv[bj][1] = *(const f32x4*)(bias + col0 + bj * HALF + 4); }
#pragma unroll
        for (int ai = 0; ai < 2; ++ai)
#pragma unroll
            for (int mp = 0; mp < 2; ++mp) {
                u32x4 wp[2][2]; f32x4 xo[2][2][2];
#pragma unroll
                for (int mm = 0; mm < 2; ++mm) { const size_t off = (size_t)(row0 + ai * HALF + (2 * mp + mm) * 16) * 2048 + col0;
#pragma unroll
                    for (int bj = 0; bj < 2; ++bj) { wp[mm][bj] = *(const u32x4*)(PL + off + bj * HALF); xo[mm][bj][0] = *(const f32x4*)(OUT + off + bj * HALF); xo[mm][bj][1] = *(const f32x4*)(OUT + off + bj * HALF + 4); } }
                asm volatile("" ::: "memory");
#pragma unroll
                for (int mm = 0; mm < 2; ++mm) { const int m = 2 * mp + mm; const size_t off = (size_t)(row0 + ai * HALF + m * 16) * 2048 + col0;
                    const float rstd = scr[ai * HALF + wr * 64 + m * 16 + fr];
#pragma unroll
                    for (int bj = 0; bj < 2; ++bj) {
                        f32x4 p0, p1; unpack8bf(wp[mm][bj], p0, p1);
                        f32x4 x0 = xo[mm][bj][0], x1 = xo[mm][bj][1];
                        const f32x4 z0 = acc[ai][bj][m][0] * rstd + bv[bj][0], z1 = acc[ai][bj][m][1] * rstd + bv[bj][1];
#pragma unroll
                        for (int j = 0; j < 4; ++j) { x0[j] += p0[j] * sigmoidf_(z0[j]); x1[j] += p1[j] * sigmoidf_(z1[j]); }
                        st16f(OUT + off + bj * HALF, x0); st16f(OUT + off + bj * HALF + 4, x1);
                    } }
                asm volatile("" ::: "memory");
            }
    }
};
template <class Epi, class Sched, bool ALIGN_EPI = false, bool SP2 = false>
__device__ __forceinline__ void gemm_phase(PG8_LAS unsigned char* lds, const Gemm g, const Sched& S, const Epi& E) {
    int tid_ = threadIdx.x; asm volatile("" : "+v"(tid_)); const int tid = tid_, wid = __builtin_amdgcn_readfirstlane(tid >> 6), lane = tid & 63, wr = wid >> 2, wc = wid & 3, fr = lane & 15, fq = lane >> 4;
    const int K = g.K, nt = K / BK;
    unsigned voffA[2], voffB[2];
#pragma unroll
    for (int i = 0; i < 2; ++i) { int R, C; stage_rc(tid * 16 + i * 8192, R, C); const int Rb = Epi::PERM ? ((R & ~31) + perm32(R & 31)) : R;
        voffA[i] = (unsigned)(R * K + C) * 2u; voffB[i] = (unsigned)(Rb * K + C) * 2u; }
    const size_t kstep = (size_t)(BK * 2);
    const size_t hstep = (size_t)HALF * K * 2;
    const size_t tstep = 2 * hstep;
    const unsigned ldsw = (unsigned)wid * 1024u;
    const int aoff = lds_byte(wr * 64 + fr, fq * 8), boff = lds_byte(wc * 32 + fr, fq * 8);
#define PG8_SA(b, h) (((b) * 2 + (h)) * HTB)
#define PG8_SB(b, h) ((4 + (b) * 2 + (h)) * HTB)
#define PG8_STAGE(bufoff, gbase, voff) do { _Pragma("unroll") for (int _i = 0; _i < 2; ++_i) \
        __builtin_amdgcn_global_load_lds((const unsigned*)((const char*)(gbase) + (voff)[_i]), (PG8_LAS unsigned*)(lds + (bufoff) + ldsw + _i * 8192), 16, 0, 0); } while (0)
#define PG8_LDA(dst, b, h) do { _Pragma("unroll") for (int m = 0; m < 4; ++m) _Pragma("unroll") for (int k = 0; k < 2; ++k) dst[m][k] = *(const PG8_LAS bf16x8*)(lds + PG8_SA(b, h) + aoff + m * 2048 + k * 1024); } while (0)
#define PG8_LDB(dst, b, h) do { _Pragma("unroll") for (int n = 0; n < 2; ++n) _Pragma("unroll") for (int k = 0; k < 2; ++k) dst[n][k] = *(const PG8_LAS bf16x8*)(lds + PG8_SB(b, h) + boff + n * 2048 + k * 1024); } while (0)
#define PG8_MMA(ai, bj, At, Bt) do { __builtin_amdgcn_s_setprio(1); _Pragma("unroll") for (int m = 0; m < 4; ++m) _Pragma("unroll") for (int n = 0; n < 2; ++n) _Pragma("unroll") for (int k = 0; k < 2; ++k) \
        acc[ai][bj][m][n] = __builtin_amdgcn_mfma_f32_16x16x32_bf16(Bt[n][k], At[m][k], acc[ai][bj][m][n], 0, 0, 0); __builtin_amdgcn_s_setprio(0); } while (0)
#define PG8_WAIT_V(n) asm volatile("s_waitcnt vmcnt(" #n ")" ::: "memory")
#define PG8_WAIT_L(n) asm volatile("s_waitcnt lgkmcnt(" #n ")" ::: "memory")
#define PG8_BAR __builtin_amdgcn_s_barrier()
#define PG8_SCHED __builtin_amdgcn_sched_barrier(0)
    Unit cur, nxt; int ui = 0;
    if (!S.next(0, cur)) return;
    f32x4 acc[2][2][4][2];
#pragma unroll
    for (int a = 0; a < 2; ++a)
#pragma unroll
        for (int b = 0; b < 2; ++b)
#pragma unroll
            for (int m = 0; m < 4; ++m)
#pragma unroll
                for (int n = 0; n < 2; ++n) acc[a][b][m][n] = (f32x4){0.f, 0.f, 0.f, 0.f};
    bf16x8 At[4][2], B0[2][2], B1[2][2];
    const char* cA = (const char*)g.A + (size_t)cur.pm * tstep; const char* cB = (const char*)g.Bt + (size_t)cur.pn * tstep;
    S.a_ready(cur);
    if constexpr (SP2) {
        PG8_STAGE(PG8_SB(0, 0), cB, voffB); PG8_STAGE(PG8_SB(0, 1), cB + hstep, voffB); PG8_STAGE(PG8_SA(0, 0), cA, voffA); PG8_STAGE(PG8_SA(0, 1), cA + hstep, voffA);
        if (wr == 1) PG8_BAR;
        PG8_WAIT_V(2); PG8_BAR;
        PG8_STAGE(PG8_SB(1, 0), cB + kstep, voffB); PG8_STAGE(PG8_SA(1, 0), cA + kstep, voffA); PG8_STAGE(PG8_SB(1, 1), cB + hstep + kstep, voffB);
        PG8_WAIT_V(6); PG8_BAR;
    } else {
        PG8_STAGE(PG8_SB(0, 0), cB, voffB); PG8_STAGE(PG8_SA(0, 0), cA, voffA); PG8_STAGE(PG8_SB(0, 1), cB + hstep, voffB); PG8_STAGE(PG8_SA(0, 1), cA + hstep, voffA);
        if (wr == 1) PG8_BAR;
        PG8_WAIT_V(4); PG8_BAR;
        PG8_STAGE(PG8_SB(1, 0), cB + kstep, voffB); PG8_STAGE(PG8_SA(1, 0), cA + kstep, voffA); PG8_STAGE(PG8_SB(1, 1), cB + hstep + kstep, voffB);
        PG8_WAIT_V(6); PG8_BAR;
    }
    for (;;) {
        const bool has_next = S.next(ui + 1, nxt);
        const char* nA = has_next ? (const char*)g.A + (size_t)nxt.pm * tstep : cA; const char* nB = has_next ? (const char*)g.Bt + (size_t)nxt.pn * tstep : cB;
        for (int t = 0; t < nt; t += 2) {
            const bool last = (t == nt - 2);
            if constexpr (Epi::HOOK) { if (t == E.hook_t) E.mid(acc, cur, wr, wc, fr, fq); }
            const char* a1 = cA + (size_t)(t + 1) * kstep;
            const char* a2 = last ? nA : cA + (size_t)(t + 2) * kstep; const char* b2 = last ? nB : cB + (size_t)(t + 2) * kstep;
            const char* a3 = a2 + kstep; const char* b3 = b2 + kstep;
            if (last && has_next) S.a_ready(nxt);
            if constexpr (SP2) {
            PG8_LDB(B0, 0, 0); PG8_LDB(B1, 0, 1); PG8_SCHED; PG8_LDA(At, 0, 0); PG8_STAGE(PG8_SA(1, 1), a1 + hstep, voffA);
            PG8_WAIT_V(8); PG8_WAIT_L(0); PG8_BAR; PG8_MMA(0, 0, At, B0); PG8_MMA(0, 1, At, B1); PG8_BAR; PG8_SCHED;
            PG8_LDA(At, 0, 1); PG8_STAGE(PG8_SB(0, 0), b2, voffB); PG8_STAGE(PG8_SB(0, 1), b2 + hstep, voffB); PG8_STAGE(PG8_SA(0, 0), a2, voffA);
            PG8_WAIT_V(8); PG8_WAIT_L(0); PG8_BAR; PG8_MMA(1, 0, At, B0); PG8_MMA(1, 1, At, B1); PG8_BAR; PG8_SCHED;
            PG8_LDB(B0, 1, 0); PG8_LDB(B1, 1, 1); PG8_SCHED; PG8_LDA(At, 1, 0); PG8_STAGE(PG8_SA(0, 1), a2 + hstep, voffA);
            PG8_WAIT_V(8); PG8_WAIT_L(0); PG8_BAR; PG8_MMA(0, 0, At, B0); PG8_MMA(0, 1, At, B1); PG8_BAR; PG8_SCHED;
            PG8_LDA(At, 1, 1); PG8_STAGE(PG8_SB(1, 0), b3, voffB); PG8_STAGE(PG8_SB(1, 1), b3 + hstep, voffB); PG8_STAGE(PG8_SA(1, 0), a3, voffA);
            PG8_WAIT_V(8); PG8_WAIT_L(0); PG8_BAR; PG8_MMA(1, 0, At, B0); PG8_MMA(1, 1, At, B1); PG8_BAR; PG8_SCHED;
            } else {
            PG8_LDB(B0, 0, 0); PG8_SCHED; PG8_LDA(At, 0, 0); PG8_STAGE(PG8_SA(1, 1), a1 + hstep, voffA);
            PG8_WAIT_L(8); PG8_BAR; PG8_WAIT_L(0); PG8_MMA(0, 0, At, B0); PG8_BAR; PG8_SCHED;
            PG8_LDB(B1, 0, 1); PG8_STAGE(PG8_SB(0, 0), b2, voffB);
            PG8_BAR; PG8_WAIT_L(0); PG8_MMA(0, 1, At, B1); PG8_BAR;
            PG8_LDA(At, 0, 1); PG8_STAGE(PG8_SA(0, 0), a2, voffA);
            PG8_BAR; PG8_WAIT_L(0); PG8_MMA(1, 0, At, B0); PG8_BAR; PG8_SCHED;
            PG8_STAGE(PG8_SB(0, 1), b2 + hstep, voffB);
            PG8_WAIT_V(6); PG8_BAR; PG8_MMA(1, 1, At, B1); PG8_BAR;
            PG8_LDB(B0, 1, 0); PG8_SCHED; PG8_LDA(At, 1, 0); PG8_STAGE(PG8_SA(0, 1), a2 + hstep, voffA);
            PG8_WAIT_L(8); PG8_BAR; PG8_WAIT_L(0); PG8_MMA(0, 0, At, B0); PG8_BAR; PG8_SCHED;
            PG8_LDB(B1, 1, 1); PG8_STAGE(PG8_SB(1, 0), b3, voffB);
            PG8_BAR; PG8_WAIT_L(0); PG8_MMA(0, 1, At, B1); PG8_BAR;
            PG8_LDA(At, 1, 1); PG8_STAGE(PG8_SA(1, 0), a3, voffA);
            PG8_BAR; PG8_WAIT_L(0); PG8_MMA(1, 0, At, B0); PG8_BAR; PG8_SCHED;
            PG8_STAGE(PG8_SB(1, 1), b3 + hstep, voffB);
            PG8_WAIT_V(6); PG8_BAR; PG8_MMA(1, 1, At, B1); PG8_BAR;
            }
        }
        if constexpr (ALIGN_EPI) { if (wr == 0) PG8_BAR; }
        if constexpr (!Epi::AFTER_DRAIN) { E(acc, cur, wr, wc, fr, fq); S.done(cur); }
        if (!has_next) break;
#pragma unroll
        for (int a = 0; a < 2; ++a)
#pragma unroll
            for (int b = 0; b < 2; ++b)
#pragma unroll
                for (int m = 0; m < 4; ++m)
#pragma unroll
                    for (int n = 0; n < 2; ++n) acc[a][b][m][n] = (f32x4){0.f, 0.f, 0.f, 0.f};
        cur = nxt; cA = nA; cB = nB; ++ui;
        if constexpr (ALIGN_EPI) { if (wr == 1) PG8_BAR; }
    }
    PG8_WAIT_V(0);
    if constexpr (!ALIGN_EPI) { if (wr == 0) PG8_BAR; }
    PG8_BAR;
#undef PG8_SA
#undef PG8_SB
#undef PG8_STAGE
#undef PG8_LDA
#undef PG8_LDB
#undef PG8_MMA
#undef PG8_WAIT_V
#undef PG8_WAIT_L
#undef PG8_BAR
#undef PG8_SCHED
}
}

namespace attn {
constexpr int D = 128;
constexpr float THR = 8.f;
constexpr bool WSKIP = false;
constexpr float SCALE = 0.08838834764831845f;
constexpr int NW = 8, QBLK = 32, KVBLK = 64, QB = NW * QBLK;
constexpr int SHM_V = KVBLK * D * 2, SHM_K = KVBLK * D * 2;
constexpr int LDS_BYTES = 2 * SHM_V + 2 * SHM_K + NW * 64 * 4;
constexpr int KM_OFF = 69632;
constexpr int LDO = 2048, LDG = 1024, STG_OFF = 73728;
#ifndef MOBA_ON
#define MOBA_ON 1
#endif
#ifndef GA_ON
#define GA_ON 1
#endif
using bf16 = __hip_bfloat16;
typedef short bf16x8 __attribute__((ext_vector_type(8)));
typedef short s16x4 __attribute__((ext_vector_type(4)));
typedef float f32x16 __attribute__((ext_vector_type(16)));
typedef float f32x4 __attribute__((ext_vector_type(4)));
typedef unsigned u32x4 __attribute__((ext_vector_type(4)));
template <class A, class Bt> struct same_t { static constexpr bool v = false; };
template <class A> struct same_t<A, A> { static constexpr bool v = true; };

#define KSWZ(row, colB) ((row) * 256 + ((colB) ^ (((row) & 7) << 4)))
#define SBAR() __builtin_amdgcn_sched_barrier(0)
__device__ __forceinline__ int v_st(int k, int c) { const int kk = (k & ~0xC) | ((k & 4) << 1) | ((k & 8) >> 1); return ((kk >> 3) * 4 + (c >> 5)) * 512 + ((kk & 7) * 32 + (c & 31)) * 2; }
__device__ __forceinline__ int v_rd_base(int lane) { return ((lane & 3) << 3) | (((lane >> 2) & 3) << 6) | (((lane >> 4) & 1) << 5) | (((lane >> 5) & 1) << 8); }
constexpr int v_rd_off(int d0, int ks, int half) { return d0 * 512 + ks * 4096 + half * 2048; }
__device__ __forceinline__ int crow(int r, int hi) { return (r & 3) + 8 * (r >> 2) + 4 * hi; }
__device__ __forceinline__ unsigned cvtpk(float lo, float hi) {
    unsigned r; asm volatile("v_cvt_pk_bf16_f32 %0, %1, %2" : "=v"(r) : "v"(lo), "v"(hi)); return r;
}
__device__ __forceinline__ bf16x8 pack8(f32x4 a, f32x4 b) {
    u32x4 w = {cvtpk(a[0], a[1]), cvtpk(a[2], a[3]), cvtpk(b[0], b[1]), cvtpk(b[2], b[3])};
    return *reinterpret_cast<bf16x8*>(&w);
}
template <class T> __device__ __forceinline__ bf16x8 load8(const T* p) {
    if constexpr (same_t<T, float>::v) { return pack8(*(const f32x4*)p, *(const f32x4*)(p + 4)); }
    else { return *reinterpret_cast<const bf16x8*>(p); }
}
__device__ __forceinline__ void mask_tile(f32x16& p0, f32x16& p1, int dq, unsigned W) {
    const float NEG = -__builtin_inff();
#pragma unroll
    for (int r = 0; r < 16; ++r) {
        const int c = (r & 3) + 8 * (r >> 2);
        if ((unsigned)(dq - c) >= W) p0[r] = NEG;
        if ((unsigned)(dq - c - 32) >= W) p1[r] = NEG;
    }
}
__device__ __forceinline__ void partialSM(f32x16& p0, f32x16& p1, float& m_reg, float& mn, float& alpha) {
    float pmax = p0[0]; for (int r = 1; r < 16; ++r) pmax = fmaxf(pmax, p0[r]); for (int r = 0; r < 16; ++r) pmax = fmaxf(pmax, p1[r]);
    { auto rr = __builtin_amdgcn_permlane32_swap(__float_as_uint(pmax), __float_as_uint(pmax), false, false);
      pmax = fmaxf(__uint_as_float(rr[0]), __uint_as_float(rr[1])); }
    constexpr float C2 = 1.4426950408889634f * SCALE;
    if (__builtin_expect(__all((pmax - m_reg) * SCALE <= THR), 1)) { mn = m_reg; alpha = 1.f; }
    else { mn = fmaxf(m_reg, pmax); alpha = __builtin_amdgcn_exp2f((m_reg - mn) * C2); m_reg = mn; }
    const float mnL = -mn * C2;
    for (int r = 0; r < 16; ++r) p0[r] = fmaf(p0[r], C2, mnL); for (int r = 0; r < 16; ++r) p1[r] = fmaf(p1[r], C2, mnL);
    for (int r = 0; r < 16; ++r) p0[r] = __builtin_amdgcn_exp2f(p0[r]);
}
__device__ __forceinline__ void finishSM(f32x16& p0, f32x16& p1, float alpha, float& l_reg, bf16x8& pa0, bf16x8& pa1, bf16x8& pa2, bf16x8& pa3) {
    for (int r = 0; r < 16; ++r) p1[r] = __builtin_amdgcn_exp2f(p1[r]);
    float ps = 0; for (int r = 0; r < 16; ++r) ps += p0[r]; for (int r = 0; r < 16; ++r) ps += p1[r];
    { auto rr = __builtin_amdgcn_permlane32_swap(__float_as_uint(ps), __float_as_uint(ps), false, false);
      ps = __uint_as_float(rr[0]) + __uint_as_float(rr[1]); }
    l_reg = l_reg * alpha + ps;
#define PK4(P, B_, OUT) do { unsigned a0 = cvtpk(P[B_+0], P[B_+1]), a1 = cvtpk(P[B_+2], P[B_+3]);                          \
        unsigned b0 = cvtpk(P[B_+4], P[B_+5]), b1 = cvtpk(P[B_+6], P[B_+7]);                                             \
        auto r0 = __builtin_amdgcn_permlane32_swap(a0, b0, false, false); auto r1 = __builtin_amdgcn_permlane32_swap(a1, b1, false, false); \
        u32x4 w = {r0[0], r1[0], r0[1], r1[1]}; OUT = *reinterpret_cast<bf16x8*>(&w); } while (0)
    PK4(p0, 0, pa0); PK4(p0, 8, pa1); PK4(p1, 0, pa2); PK4(p1, 8, pa3);
#undef PK4
}
template <int KB, bool SK>
__device__ __forceinline__ void qkt(f32x16& p0, f32x16& p1, const char* K_lds, int r32, int hi, const bf16x8* qr, bool act) {
    if (SK && !act) { const float NEG = -__builtin_inff();
#pragma unroll
        for (int r = 0; r < 16; ++r) { p0[r] = NEG; p1[r] = NEG; } return; }
    p0 = f32x16{}; p1 = f32x16{};
    const char* kb[4];
#pragma unroll
    for (int dd = 0; dd < 4; ++dd) kb[dd] = K_lds + KB * SHM_K + KSWZ(r32, (dd * 16 + hi * 8) * 2);
#pragma unroll
    for (int d0 = 0; d0 < 8; ++d0) { const char* a = kb[d0 & 3] + (d0 >> 2) * 128;
        bf16x8 b0 = *reinterpret_cast<const bf16x8*>(a);
        bf16x8 b1 = *reinterpret_cast<const bf16x8*>(a + 32 * 256);
        p0 = __builtin_amdgcn_mfma_f32_32x32x16_bf16(b0, qr[d0], p0, 0, 0, 0);
        p1 = __builtin_amdgcn_mfma_f32_32x32x16_bf16(b1, qr[d0], p1, 0, 0, 0); }
}
template <int VB, bool SK>
__device__ __forceinline__ void pv_tile(f32x16* o, int vb0, bf16x8 pa0, bf16x8 pa1, bf16x8 pa2, bf16x8 pa3, bool act) {
    if (SK && !act) return;
#define TRRD(dst, off) asm volatile("ds_read_b64_tr_b16 %0, %1 offset:%2" : "=&v"(dst) : "v"(vb0), "i"(off) : "memory")
#define PV_D0(d0) do { s16x4 l0, l1, l2, l3, h0, h1, h2, h3; constexpr int b_ = VB * SHM_V + v_rd_off(d0, 0, 0);     \
        TRRD(l0, b_); TRRD(h0, b_ + 2048); TRRD(l1, b_ + 4096); TRRD(h1, b_ + 6144); TRRD(l2, b_ + 8192); TRRD(h2, b_ + 10240); TRRD(l3, b_ + 12288); TRRD(h3, b_ + 14336); \
        asm volatile("s_waitcnt lgkmcnt(0)" ::: "memory"); SBAR();                 \
        o[d0] = __builtin_amdgcn_mfma_f32_32x32x16_bf16(pa0, (bf16x8){l0[0], l0[1], l0[2], l0[3], h0[0], h0[1], h0[2], h0[3]}, o[d0], 0, 0, 0);   \
        o[d0] = __builtin_amdgcn_mfma_f32_32x32x16_bf16(pa1, (bf16x8){l1[0], l1[1], l1[2], l1[3], h1[0], h1[1], h1[2], h1[3]}, o[d0], 0, 0, 0);   \
        o[d0] = __builtin_amdgcn_mfma_f32_32x32x16_bf16(pa2, (bf16x8){l2[0], l2[1], l2[2], l2[3], h2[0], h2[1], h2[2], h2[3]}, o[d0], 0, 0, 0);   \
        o[d0] = __builtin_amdgcn_mfma_f32_32x32x16_bf16(pa3, (bf16x8){l3[0], l3[1], l3[2], l3[3], h3[0], h3[1], h3[2], h3[3]}, o[d0], 0, 0, 0); } while (0)
    PV_D0(0); PV_D0(1); PV_D0(2); PV_D0(3);
#undef PV_D0
#undef TRRD
}

template <class TIn, class TOut> struct BlockRef { const TIn* Q; const TIn* K; const TIn* V; TOut* O; int P0; const unsigned short* GA; const float* KM; int qb; };
template <class TIn> struct Seam {
    bf16x8 qr[8];
    bf16x8 st_v0, st_v1, st_k0, st_k1; f32x4 sf0, sf1, sf2, sf3;
    f32x4 tq[16];
};
__device__ __forceinline__ int swa_jlo(int P0, int W) { const int lowk = P0 - W + 1; return lowk > 0 ? lowk / KVBLK : 0; }
#define ROW(p, k0, rr) ((p) + (size_t)((k0) + (rr)) * D + sc)
#define VMW() asm volatile("s_waitcnt vmcnt(0)" ::: "memory")
#define VMWN(n) asm volatile("s_waitcnt vmcnt(%0)" :: "i"(n) : "memory")
#define SLOAD_H(Kp, Vp, k0) do { S.st_v0 = load8<TIn>(ROW(Vp, k0, sr)); S.st_v1 = load8<TIn>(ROW(Vp, k0, 32 + sr));              \
                         S.st_k0 = load8<TIn>(ROW(Kp, k0, sr)); S.st_k1 = load8<TIn>(ROW(Kp, k0, 32 + sr)); } while (0)
#define SWRITE_HK(bf) do { *(bf16x8*)(K_lds + (bf) * SHM_K + kws) = S.st_k0; *(bf16x8*)(K_lds + (bf) * SHM_K + kws + 32 * 256) = S.st_k1; } while (0)
#define SWRITE_HV(bf) do { *(bf16x8*)(V_lds + (bf) * SHM_V + vst0) = S.st_v0; *(bf16x8*)(V_lds + (bf) * SHM_V + vst1) = S.st_v1; } while (0)
#define SWRITE_H(bf) do { SWRITE_HV(bf); SWRITE_HK(bf); } while (0)
#define SLOAD_F(p, k0) do { S.sf0 = *(const f32x4*)ROW(p, k0, sr); S.sf1 = *(const f32x4*)(ROW(p, k0, sr) + 4);                \
                            S.sf2 = *(const f32x4*)ROW(p, k0, 32 + sr); S.sf3 = *(const f32x4*)(ROW(p, k0, 32 + sr) + 4); } while (0)
#define SWRITE_KF(bf) do { *(bf16x8*)(K_lds + (bf) * SHM_K + kws) = pack8(S.sf0, S.sf1); *(bf16x8*)(K_lds + (bf) * SHM_K + kws + 32 * 256) = pack8(S.sf2, S.sf3); } while (0)
#define SWRITE_VF(bf) do { *(bf16x8*)(V_lds + (bf) * SHM_V + vst0) = pack8(S.sf0, S.sf1); *(bf16x8*)(V_lds + (bf) * SHM_V + vst1) = pack8(S.sf2, S.sf3); } while (0)
template <class TIn, class TOut>
__device__ __forceinline__ void causal_swa_prime(const BlockRef<TIn, TOut>& cur, int W, char* lds, Seam<TIn>& S) {
    constexpr bool F32 = same_t<TIn, float>::v;
    int tid_ = threadIdx.x; asm volatile("" : "+v"(tid_)); const int tid = tid_, wid = __builtin_amdgcn_readfirstlane(tid >> 6), lane = tid & 63, r32 = lane & 31, hi = lane >> 5;
    const int sr = tid >> 4, sc = (tid & 15) * 8, kws = KSWZ(sr, sc * 2); char* K_lds = lds + 2 * SHM_V;
    const int kb0 = swa_jlo(cur.P0, W) * KVBLK;
    for (int d0 = 0; d0 < 8; ++d0) S.qr[d0] = load8<TIn>(cur.Q + (size_t)(wid * QBLK + r32) * D + d0 * 16 + hi * 8);
    if constexpr (F32) { SLOAD_F((const float*)cur.K, kb0); VMW(); SWRITE_KF(0); SBAR(); SLOAD_F((const float*)cur.V, kb0); }
    else { SLOAD_H(cur.K, cur.V, kb0); VMW(); SWRITE_HK(0); }
    __syncthreads();
}
template <class TIn, class TOut>
__device__ __forceinline__ void causal_swa_block(const BlockRef<TIn, TOut>& cur, const BlockRef<TIn, TOut>& nxt, int skv, int W, char* lds, Seam<TIn>& S) {
    constexpr bool F32 = same_t<TIn, float>::v;
    int tid_ = threadIdx.x; asm volatile("" : "+v"(tid_)); const int tid = tid_, wid = __builtin_amdgcn_readfirstlane(tid >> 6), lane = tid & 63, r32 = lane & 31, hi = lane >> 5;
    const int j_lo = swa_jlo(cur.P0, W);
    int j_hi = (cur.P0 + QB - 1) / KVBLK + 1; if (j_hi > skv / KVBLK) j_hi = skv / KVBLK;
    const int NT = j_hi - j_lo;
    const int kbn = swa_jlo(nxt.P0, W) * KVBLK;
    const int qlo = cur.P0 + wid * QBLK, qm = qlo + r32 - 4 * hi;
    char* V_lds = lds; char* K_lds = lds + 2 * SHM_V;
    float* ws = (float*)(lds + 2 * SHM_V + 2 * SHM_K) + wid * 64; float* li_l = ws, * al_l = ws + 32;
    float m_reg = -1e30f, l_reg = 0; f32x16 o[4] = {};
    const int sr = tid >> 4, sc = (tid & 15) * 8, vst0 = v_st(sr, sc), vst1 = v_st(32 + sr, sc), kws = KSWZ(sr, sc * 2);
    const int vb0 = (int)(uintptr_t)V_lds + v_rd_base(lane);
    const TIn* Kh = cur.K; const TIn* Vh = cur.V;
    unsigned pf0_ = 0u, pf1_ = 0u;
#define PREF(t, PF) do { asm volatile("" :: "v"(PF)); int tp_ = (t) + 2 + (wid >> 2); tp_ = tp_ < NT ? tp_ : NT - 1; \
        const char* pp_ = (const char*)((wid & 2) ? (const void*)Vh : (const void*)Kh) + (size_t)KBASE(tp_) * (D * 2) + (wid & 1) * 8192 + lane * 128; \
        PF = *(const __attribute__((address_space(1))) unsigned*)(unsigned long long)pp_; } while (0)
    unsigned selmask = 0xffu; const bool moba = cur.qb >= 4;
    {
        float* kml = (float*)(lds + KM_OFF);
        { float kv_[2];
#pragma unroll
          for (int i_ = 0; i_ < 2; ++i_) { const int idx = tid + i_ * 64 * NW, n_ = idx >> 7, d_ = idx & 127; kv_[i_] = (cur.KM[(size_t)n_ * 2048 + d_] + cur.KM[(size_t)n_ * 2048 + 1024 + d_]) * (1.0f / 256.0f); }
#pragma unroll
          for (int i_ = 0; i_ < 2; ++i_) ((__attribute__((address_space(3))) float*)kml)[tid + i_ * 64 * NW] = kv_[i_]; }
        __syncthreads();
        if (moba) {
            float g[7];
#pragma unroll
            for (int n_ = 0; n_ < 7; ++n_) { float s = 0.f;
                if (n_ < cur.qb) {
#pragma unroll
                    for (int d0 = 0; d0 < 8; ++d0) { const f32x4 k0 = *(const f32x4*)(kml + n_ * 128 + d0 * 16 + hi * 8), k1 = *(const f32x4*)(kml + n_ * 128 + d0 * 16 + hi * 8 + 4);
                        const bf16x8 qv = S.qr[d0];
#define B2F_(x) __uint_as_float(((unsigned)(unsigned short)(x)) << 16)
                        s += (B2F_(qv[0]) * k0[0] + B2F_(qv[1]) * k0[1]) + (B2F_(qv[2]) * k0[2] + B2F_(qv[3]) * k0[3]) + (B2F_(qv[4]) * k1[0] + B2F_(qv[5]) * k1[1]) + (B2F_(qv[6]) * k1[2] + B2F_(qv[7]) * k1[3]);
#undef B2F_
                    } }
                g[n_] = s + __shfl_xor(s, 32); }
            selmask = 0u;
#pragma unroll
            for (int rd = 0; rd < 3; ++rd) { float best = -__builtin_inff(); unsigned bi = 0u;
#pragma unroll
                for (int n_ = 0; n_ < 7; ++n_) { const bool ok = (n_ < cur.qb) && (((selmask >> n_) & 1u) == 0u) && (g[n_] > best); best = ok ? g[n_] : best; bi = ok ? (unsigned)n_ : bi; }
                selmask |= 1u << bi; }
        }
    }
#define RESC(a) do { if (__any((a) < 1.f)) { if (hi == 0) al_l[r32] = (a); asm volatile("s_waitcnt lgkmcnt(0)" ::: "memory");              \
                     for (int d_ = 0; d_ < 4; ++d_) for (int r = 0; r < 16; ++r) o[d_][r] *= al_l[crow(r, hi)]; } } while (0)
#define KBASE(t) ((j_lo + (t)) * KVBLK)
#define ACT(t) (KBASE(t) <= qlo + QBLK - 1 && KBASE(t) + KVBLK - 1 >= qlo - W + 1)
#define MASKT(P0_, P1_, t) do { const int kb_ = KBASE(t); if ((!SK || ACT(t)) && (kb_ + KVBLK - 1 > qlo || kb_ <= qlo + QBLK - 1 - W)) mask_tile(P0_, P1_, qm - kb_, (unsigned)W); \
        if (MOBA_ON && moba && kb_ < cur.P0) { const bool dead_ = ((selmask >> (kb_ >> 8)) & 1u) == 0u; const float NEG_ = -__builtin_inff(); \
            _Pragma("unroll") for (int r_ = 0; r_ < 16; ++r_) { P0_[r_] = dead_ ? NEG_ : P0_[r_]; P1_[r_] = dead_ ? NEG_ : P1_[r_]; } } } while (0)
    constexpr int NQL = F32 ? 16 : 8;
    constexpr bool SK = WSKIP && !F32;
#define SEAM_K0() do { VMWN(NQL); if constexpr (F32) { SWRITE_KF(0); SBAR(); SLOAD_F((const float*)nxt.V, kbn); } else { SWRITE_HK(0); } SBAR(); } while (0)
    f32x16 pA0, pA1, pB0, pB1; float mnA, mnB, alA, alB; bf16x8 pa0, pa1, pa2, pa3;
    if constexpr (F32) { VMW(); SWRITE_VF(0); SBAR(); } else { SWRITE_HV(0); SBAR(); }
    if (NT > 1) { if constexpr (F32) SLOAD_F((const float*)Kh, KBASE(1)); else SLOAD_H(Kh, Vh, KBASE(1)); }
    SBAR(); qkt<0, SK>(pA0, pA1, K_lds, r32, hi, S.qr, ACT(0));
    if constexpr (F32) { if (NT > 1) { VMW(); SWRITE_KF(1); SBAR(); SLOAD_F((const float*)Vh, KBASE(1)); } }
    MASKT(pA0, pA1, 0); partialSM(pA0, pA1, m_reg, mnA, alA);
    if (NT > 1) { VMW(); if constexpr (F32) { SWRITE_VF(1); SBAR(); if (NT > 2) SLOAD_F((const float*)Kh, KBASE(2)); } else SWRITE_H(1); }
    __syncthreads();
#define HALF_STEP(PX0, PX1, mnX, alX, PY0, PY1, alY, t, KB, VB, SB) do {                                                      \
        SBAR(); qkt<KB, SK>(PX0, PX1, K_lds, r32, hi, S.qr, ACT(t));                                             \
        finishSM(PY0, PY1, alY, l_reg, pa0, pa1, pa2, pa3); SBAR();                                                           \
        if ((t) + 1 < NT) { if constexpr (F32) { VMW(); SWRITE_KF(SB); SBAR(); SLOAD_F((const float*)Vh, KBASE((t) + 1)); }  \
                            else { SLOAD_H(Kh, Vh, KBASE((t) + 1)); SBAR(); if (SB) PREF(t, pf1_); else PREF(t, pf0_); } SBAR(); }                                               \
        pv_tile<VB, SK>(o, vb0, pa0, pa1, pa2, pa3, ACT((t) - 1)); MASKT(PX0, PX1, (t)); partialSM(PX0, PX1, m_reg, mnX, alX);                                        \
        __syncthreads();                                                                                                      \
        if ((t) + 1 < NT) { if constexpr (F32) VMW(); else VMWN(1); if constexpr (F32) { SWRITE_VF(SB); SBAR(); if ((t) + 2 < NT) SLOAD_F((const float*)Kh, KBASE((t) + 2)); } \
                            else { SWRITE_H(SB); } }                                                                          \
        RESC(alX); __syncthreads(); } while (0)
    for (int t = 1; t + 1 < NT; t += 2) {
        HALF_STEP(pB0, pB1, mnB, alB, pA0, pA1, alA, t, 1, 0, 0);
        HALF_STEP(pA0, pA1, mnA, alA, pB0, pB1, alB, t + 1, 0, 1, 1);
    }
    const bool even = (NT & 1) == 0;
    if (even) { SBAR(); qkt<1, SK>(pB0, pB1, K_lds, r32, hi, S.qr, ACT(NT - 1)); SBAR(); }
#define QROW(e) (nxt.Q + (size_t)(wid * QBLK + r32) * D + ((e) >> 1) * 16 + hi * 8 + ((e) & 1) * 4)
    if constexpr (F32) { SLOAD_F((const float*)nxt.K, kbn); SBAR();
#pragma unroll
        for (int e = 0; e < 8; ++e) S.tq[e] = *(const f32x4*)QROW(e); }
    else { SLOAD_H(nxt.K, nxt.V, kbn); SBAR();
#pragma unroll
        for (int d0 = 0; d0 < 8; ++d0) S.qr[d0] = load8<TIn>(nxt.Q + (size_t)(wid * QBLK + r32) * D + d0 * 16 + hi * 8); }
    SBAR();
    finishSM(pA0, pA1, alA, l_reg, pa0, pa1, pa2, pa3); SBAR();
    if constexpr (F32) {
#pragma unroll
        for (int e = 8; e < 16; ++e) S.tq[e] = *(const f32x4*)QROW(e); SBAR(); }
#undef QROW
    pv_tile<0, SK>(o, vb0, pa0, pa1, pa2, pa3, ACT(even ? NT - 2 : NT - 1));
    if (even) { MASKT(pB0, pB1, NT - 1); partialSM(pB0, pB1, m_reg, mnB, alB); __syncthreads(); RESC(alB);
        finishSM(pB0, pB1, alB, l_reg, pa0, pa1, pa2, pa3); SBAR(); pv_tile<1, SK>(o, vb0, pa0, pa1, pa2, pa3, ACT(NT - 1)); }
    SBAR(); SEAM_K0();
    if (hi == 0) li_l[r32] = l_reg; asm volatile("s_waitcnt lgkmcnt(0)" ::: "memory");
    float rli[16];
#pragma unroll
    for (int r = 0; r < 16; ++r) rli[r] = __builtin_amdgcn_rcpf(li_l[crow(r, hi)]);
    { unsigned short* stg = (unsigned short*)(lds + STG_OFF) + wid * 4096;
      unsigned short* Ow = (unsigned short*)cur.O + (size_t)(wid * QBLK) * LDO; const unsigned short* Gw = cur.GA + (size_t)(wid * QBLK) * LDG;
      u32x4 gvv[8];
#pragma unroll
      for (int i = 0; i < 8; ++i) gvv[i] = *(const u32x4*)(Gw + (size_t)(i * 4 + (lane >> 4)) * LDG + (lane & 15) * 8);
#pragma unroll
      for (int r = 0; r < 16; ++r) { const int orow = crow(r, hi);
#pragma unroll
        for (int d0 = 0; d0 < 4; ++d0) { const float v = o[d0][r] * rli[r]; stg[orow * 128 + d0 * 32 + r32] = (unsigned short)(cvtpk(v, v) & 0xffffu); } }
      asm volatile("s_waitcnt lgkmcnt(0)" ::: "memory");
#pragma unroll
      for (int i = 0; i < 8; ++i) { const int row = i * 4 + (lane >> 4), ch = lane & 15;
          const u32x4 ov = *(const u32x4*)(stg + row * 128 + ch * 8); const u32x4 gv = gvv[i];
          u32x4 w;
#define MULPK_(a, b) cvtpk(__uint_as_float((a) << 16) * __uint_as_float((b) << 16), __uint_as_float((a) & 0xffff0000u) * __uint_as_float((b) & 0xffff0000u))
          w.x = MULPK_(ov.x, gv.x); w.y = MULPK_(ov.y, gv.y); w.z = MULPK_(ov.z, gv.z); w.w = MULPK_(ov.w, gv.w);
#undef MULPK_
          *(u32x4*)(Ow + (size_t)row * LDO + ch * 8) = w; } }
    if constexpr (F32) {
#pragma unroll
        for (int d0 = 0; d0 < 8; ++d0) S.qr[d0] = pack8(S.tq[2 * d0], S.tq[2 * d0 + 1]); }
    __syncthreads();
    asm volatile("" :: "v"(pf0_), "v"(pf1_));
#undef PREF
#undef RESC
#undef KBASE
#undef ACT
#undef MASKT
#undef SEAM_K0
#undef HALF_STEP
}
#undef ROW
#undef VMW
#undef VMWN
#undef SLOAD_H
#undef SWRITE_HK
#undef SWRITE_HV
#undef SWRITE_H
#undef SLOAD_F
#undef SWRITE_KF
#undef SWRITE_VF


typedef BlockRef<bf16, bf16> Ref;
__device__ __forceinline__ Ref make_ref(int L, const bf16* Q, const bf16* K, const bf16* V, bf16* Y, const bf16* GA, const float* KMP) {
    const int bh = L >> 3, qb = L & 7, b = bh >> 3, h = bh & 7; Ref r;
    r.Q = Q + ((size_t)bh * 2048 + (size_t)qb * QB) * D; r.K = K + (size_t)bh * 2048 * D; r.V = V + (size_t)bh * 2048 * D;
    r.O = Y + ((size_t)b * 2048 + (size_t)qb * QB) * LDO + h * 128; r.GA = (const unsigned short*)GA + ((size_t)b * 2048 + (size_t)qb * QB) * LDG + h * 128;
    r.P0 = qb * QB; r.KM = KMP + (size_t)b * 16 * 1024 + h * 128; r.qb = qb; return r;
}
__device__ __forceinline__ void phase(char* lds, const bf16* Q, const bf16* K, const bf16* V, bf16* Y, const bf16* GA, const float* KMP, int vcu, int G) {
    int L = vcu; if (L >= 256) return;
    Ref cur = make_ref(L, Q, K, V, Y, GA, KMP);
    Seam<bf16> S;
    causal_swa_prime<bf16, bf16>(cur, 2048, lds, S);
    for (;;) {
        const int Ln = L + G; const bool last = Ln >= 256;
        const Ref nxt = last ? cur : make_ref(Ln, Q, K, V, Y, GA, KMP);
        causal_swa_block<bf16, bf16>(cur, nxt, 2048, 2048, lds, S);
        if (last) break;
        cur = nxt; L = Ln;
    }
}
#undef KSWZ
#undef SBAR
}
#ifdef PROBE_TS
#ifndef PROBE_BLK
#define PROBE_BLK 0
#endif
#define LSTAMP(T, i) do { if (blockIdx.x == PROBE_BLK && threadIdx.x == 0) ((volatile unsigned long long*)((unsigned char*)(T).PUB - ((2u << 20) + (512u << 10)) + (600u << 10)))[i] = __builtin_amdgcn_s_memrealtime(); } while (0)
#else
#define LSTAMP(T, i) do { } while (0)
#endif
namespace lru {
#define LRU_LAS __attribute__((address_space(3)))
typedef short bf16x8 __attribute__((ext_vector_type(8)));
typedef float f32x4 __attribute__((ext_vector_type(4)));
typedef unsigned u32x4 __attribute__((ext_vector_type(4)));
typedef unsigned u32x2 __attribute__((ext_vector_type(2)));
constexpr int CH = 128  , XCP = 272  , LP = 36  ;
constexpr int OFF_XC = 0, OFF_WB = CH * XCP, OFF_A = OFF_WB + 256 * XCP, OFF_U = OFF_A + CH * LP * 4, OFF_SA = OFF_U + CH * LP * 4, OFF_SH = OFF_SA + 16 * 32 * 4, OFF_TA = OFF_SH + 16 * 32 * 4,
              OFF_TH = OFF_TA + 128 * 4, OFF_CR = OFF_TH + 128 * 4, OFF_CT = OFF_CR + 128 * 4, LRU_LDS = OFF_CT + 1024 * 4;
constexpr int CT_BR = 0, CT_BI = 128, CT_C8 = 256, CT_CW = 384, CT_CB = 896;
__device__ __forceinline__ float b2f(unsigned short x) { return __uint_as_float(((unsigned)x) << 16); }
__device__ __forceinline__ unsigned cvtpk(float lo, float hi) { unsigned r; asm volatile("v_cvt_pk_bf16_f32 %0, %1, %2" : "=v"(r) : "v"(lo), "v"(hi)); return r; }
struct Tensors { const unsigned short* XR; const unsigned short* GL; unsigned short* Y; unsigned short* Q1; const unsigned short* WrT; const unsigned short* WiT;
                 const float *cw, *cb, *br, *bi, *c8; float* PUB; unsigned* FLG; };
__device__ __forceinline__ int unit_tc(int q, int r) { const int base = (r == 0) ? 0 : (r == 1) ? 7 : (r == 2) ? 12 : 15, width = (r == 0) ? 7 : (r == 1) ? 5 : (r == 2) ? 3 : 1; return q < width ? base + q : -1; }

__device__ __forceinline__ void load_weights(LRU_LAS unsigned char* lds, const Tensors& T, int n) {
    const int tid = threadIdx.x;
#pragma unroll
    for (int i = 0; i < 8; ++i) { const int p = tid + 512 * i, o = p >> 4, c = p & 15;
        const unsigned short* src = (o < 128 ? T.WrT : T.WiT) + ((size_t)n * 128 + (o & 127)) * 128 + c * 8;
        *(LRU_LAS u32x4*)(lds + OFF_WB + o * XCP + c * 16) = *(const u32x4*)src; }
    if (tid < 128) { LRU_LAS float* CT = (LRU_LAS float*)(lds + OFF_CT); const int ch = n * 128 + tid;
        CT[CT_BR + tid] = T.br[ch]; CT[CT_BI + tid] = T.bi[ch]; CT[CT_C8 + tid] = T.c8[ch]; CT[CT_CB + tid] = T.cb[ch];
#pragma unroll
        for (int k = 0; k < 4; ++k) CT[CT_CW + k * 128 + tid] = T.cw[k * 1024 + ch]; }
    __syncthreads();
}

struct Raw { u32x4 w[4][4]; };
__device__ __forceinline__ void load_raw(const Tensors& T, int g, int tc, Raw& R) {
    const int tid = threadIdx.x, cg = tid & 15, trow = tid >> 4, b = g >> 3, n = g & 7; const int chb = n * 128 + cg * 8; const size_t rowb = (size_t)b * 2048;
#pragma unroll
    for (int i = 0; i < 4; ++i)
#pragma unroll
        for (int k = 0; k < 4; ++k) { const int tt = tc * CH + trow + 32 * i - 3 + k;
            R.w[i][k] = (u32x4){0u, 0u, 0u, 0u};
            if (tt >= 0) R.w[i][k] = *(const u32x4*)(T.XR + (rowb + tt) * 1024 + chb); }
}
__device__ __forceinline__ void conv_stage(LRU_LAS unsigned char* lds, const Tensors& T, int g, const Raw& R) {
    const int tid = threadIdx.x, cg = tid & 15, trow = tid >> 4, n = g & 7; const int chb = n * 128 + cg * 8;
    float cw[4][8], cb[8]; const LRU_LAS float* CT = (const LRU_LAS float*)(lds + OFF_CT);
#pragma unroll
    for (int k = 0; k < 4; ++k) { const f32x4 a = *(const LRU_LAS f32x4*)(CT + CT_CW + k * 128 + cg * 8), c = *(const LRU_LAS f32x4*)(CT + CT_CW + k * 128 + cg * 8 + 4);
#pragma unroll
        for (int j = 0; j < 4; ++j) { cw[k][j] = a[j]; cw[k][4 + j] = c[j]; } }
    { const f32x4 a = *(const LRU_LAS f32x4*)(CT + CT_CB + cg * 8), c = *(const LRU_LAS f32x4*)(CT + CT_CB + cg * 8 + 4);
#pragma unroll
      for (int j = 0; j < 4; ++j) { cb[j] = a[j]; cb[4 + j] = c[j]; } }
#pragma unroll
    for (int i = 0; i < 4; ++i) { const int tok = trow + 32 * i;
        float acc8[8];
#pragma unroll
        for (int j = 0; j < 8; ++j) acc8[j] = cb[j];
#pragma unroll
        for (int k = 0; k < 4; ++k) { const u32x4 w = R.w[i][k];
            acc8[0] += cw[k][0] * __uint_as_float(w.x << 16); acc8[1] += cw[k][1] * __uint_as_float(w.x & 0xffff0000u);
            acc8[2] += cw[k][2] * __uint_as_float(w.y << 16); acc8[3] += cw[k][3] * __uint_as_float(w.y & 0xffff0000u);
            acc8[4] += cw[k][4] * __uint_as_float(w.z << 16); acc8[5] += cw[k][5] * __uint_as_float(w.z & 0xffff0000u);
            acc8[6] += cw[k][6] * __uint_as_float(w.w << 16); acc8[7] += cw[k][7] * __uint_as_float(w.w & 0xffff0000u); }
        u32x4 o; o.x = cvtpk(acc8[0], acc8[1]); o.y = cvtpk(acc8[2], acc8[3]); o.z = cvtpk(acc8[4], acc8[5]); o.w = cvtpk(acc8[6], acc8[7]);
        *(LRU_LAS u32x4*)(lds + OFF_XC + tok * XCP + cg * 16) = o; }
    __syncthreads();
}
__device__ __forceinline__ void publish(LRU_LAS unsigned char* lds, const Tensors& T, int g, int tc) {
    const int tid = threadIdx.x;
    if (tid < 64) { const LRU_LAS float* TA = (const LRU_LAS float*)(lds + OFF_TA); const LRU_LAS float* TH = (const LRU_LAS float*)(lds + OFF_TH);
        float* pub = T.PUB + (size_t)(g * 16 + tc) * 256;
        __hip_atomic_store(pub + tid, TA[tid], __ATOMIC_RELAXED, __HIP_MEMORY_SCOPE_AGENT); __hip_atomic_store(pub + 64 + tid, TA[64 + tid], __ATOMIC_RELAXED, __HIP_MEMORY_SCOPE_AGENT);
        __hip_atomic_store(pub + 128 + tid, TH[tid], __ATOMIC_RELAXED, __HIP_MEMORY_SCOPE_AGENT); __hip_atomic_store(pub + 192 + tid, TH[64 + tid], __ATOMIC_RELAXED, __HIP_MEMORY_SCOPE_AGENT);
        asm volatile("s_waitcnt vmcnt(0)" ::: "memory");
        if (tid == 0) __hip_atomic_store(T.FLG + (size_t)(g * 16 + tc) * 16, 1u, __ATOMIC_RELAXED, __HIP_MEMORY_SCOPE_AGENT); }
}
__device__ __forceinline__ void gate_stage(LRU_LAS unsigned char* lds, const Tensors& T, int g, int tc) {
    int tid_ = threadIdx.x; asm volatile("" : "+v"(tid_)); const int tid = tid_, lane = tid & 63, wid = __builtin_amdgcn_readfirstlane(tid >> 6), fr = lane & 15, fq = lane >> 4;
    const int b = g >> 3, n = g & 7;
    LRU_LAS float* LA = (LRU_LAS float*)(lds + OFF_A); LRU_LAS float* LU = (LRU_LAS float*)(lds + OFF_U);
    LRU_LAS float* SA = (LRU_LAS float*)(lds + OFF_SA); LRU_LAS float* SH = (LRU_LAS float*)(lds + OFF_SH);
    LRU_LAS float* TA = (LRU_LAS float*)(lds + OFF_TA); LRU_LAS float* TH = (LRU_LAS float*)(lds + OFF_TH);
    const size_t rowb = (size_t)b * 2048; const int t0 = tc * CH;
    const int tok = 16 * wid + fr;
    bf16x8 af[4];
#pragma unroll
    for (int ks = 0; ks < 4; ++ks) af[ks] = *(const LRU_LAS bf16x8*)(lds + OFF_XC + tok * XCP + (ks * 32 + fq * 8) * 2);
    const int se = tid & 31, sg = tid >> 5;
#pragma unroll 1
    for (int es = 0; es < 4; ++es) {
        LSTAMP(T, 30);
        const size_t chn = (size_t)n * 128 + es * 32 + se;
        unsigned short glr[8];
#pragma unroll
        for (int j = 0; j < 8; ++j) glr[j] = T.GL[(rowb + t0 + sg * 8 + j) * 1024 + chn];
        {
            f32x4 ar[2], ai_[2];
#pragma unroll
            for (int nb = 0; nb < 2; ++nb) { ar[nb] = (f32x4){0.f, 0.f, 0.f, 0.f}; ai_[nb] = (f32x4){0.f, 0.f, 0.f, 0.f}; }
#pragma unroll
            for (int ks = 0; ks < 4; ++ks)
#pragma unroll
                for (int nb = 0; nb < 2; ++nb) {
                    const bf16x8 wr_ = *(const LRU_LAS bf16x8*)(lds + OFF_WB + (es * 32 + nb * 16 + fr) * XCP + (ks * 32 + fq * 8) * 2);
                    const bf16x8 wi_ = *(const LRU_LAS bf16x8*)(lds + OFF_WB + (128 + es * 32 + nb * 16 + fr) * XCP + (ks * 32 + fq * 8) * 2);
                    ar[nb] = __builtin_amdgcn_mfma_f32_16x16x32_bf16(wr_, af[ks], ar[nb], 0, 0, 0);
                    ai_[nb] = __builtin_amdgcn_mfma_f32_16x16x32_bf16(wi_, af[ks], ai_[nb], 0, 0, 0); }
#pragma unroll
            for (int nb = 0; nb < 2; ++nb) {
                const LRU_LAS float* CT = (const LRU_LAS float*)(lds + OFF_CT) + es * 32 + nb * 16 + fq * 4;
                const f32x4 vbr = *(const LRU_LAS f32x4*)(CT + CT_BR), vbi = *(const LRU_LAS f32x4*)(CT + CT_BI), vc8 = *(const LRU_LAS f32x4*)(CT + CT_C8);
                const u32x2 xw = *(const LRU_LAS u32x2*)(lds + OFF_XC + tok * XCP + (es * 32 + nb * 16 + fq * 4) * 2);
                const float xv[4] = {__uint_as_float(xw.x << 16), __uint_as_float(xw.x & 0xffff0000u), __uint_as_float(xw.y << 16), __uint_as_float(xw.y & 0xffff0000u)};
                f32x4 av, uv;
#pragma unroll
                for (int j = 0; j < 4; ++j) {
                    const float dr = 1.0f + __expf(-(ar[nb][j] + vbr[j])), di = 1.0f + __expf(-(ai_[nb][j] + vbi[j]));
                    const float rc = __builtin_amdgcn_rcpf(dr * di);
                    const float r = rc * di, ig = rc * dr;
                    const float la = -r * vc8[j];
                    const float a = __expf(la);
                    const float y = -2.0f * la;
                    const float om = (y < 0.02f) ? y * (1.0f - y * 0.5f * (1.0f - y * (1.0f / 3.0f))) : (1.0f - a * a);
                    av[j] = a;
                    uv[j] = __builtin_amdgcn_sqrtf(om) * (ig * xv[j]);
                }
                *(LRU_LAS f32x4*)(LA + tok * LP + nb * 16 + fq * 4) = av; *(LRU_LAS f32x4*)(LU + tok * LP + nb * 16 + fq * 4) = uv;
            }
        }
        LSTAMP(T, 34);
        __syncthreads();
        LSTAMP(T, 31);
        float a8[8], u8[8];
        { float A = 1.f, Hh = 0.f;
#pragma unroll
          for (int j = 0; j < 8; ++j) { a8[j] = LA[(sg * 8 + j) * LP + se]; u8[j] = LU[(sg * 8 + j) * LP + se]; Hh = a8[j] * Hh + u8[j]; A *= a8[j]; }
          SA[sg * 32 + se] = A; SH[sg * 32 + se] = Hh; }
        __syncthreads();
        LSTAMP(T, 32);
        { float h = 0.f, Ap = 1.f;
#pragma unroll
          for (int s2 = 0; s2 < 15; ++s2) { const float sa = SA[s2 * 32 + se], sh = SH[s2 * 32 + se]; if (s2 < sg) { h = sa * h + sh; Ap *= sa; } }
#pragma unroll
          for (int j = 0; j < 8; ++j) { h = a8[j] * h + u8[j]; Ap *= a8[j]; const size_t row = rowb + t0 + sg * 8 + j;
              const float gl = b2f(glr[j]);
              const float y = h * gl, q = Ap * gl;
              const float yn = __int_as_float(__builtin_amdgcn_mov_dpp(__float_as_int(y), 0xB1, 0xF, 0xF, true)), qn = __int_as_float(__builtin_amdgcn_mov_dpp(__float_as_int(q), 0xB1, 0xF, 0xF, true));
              if ((se & 1) == 0) { *(unsigned*)(T.Y + row * 2048 + 1024 + chn) = cvtpk(y, yn); *(unsigned*)(T.Q1 + row * 1024 + chn) = cvtpk(q, qn); } }
          if (sg == 15) { TA[es * 32 + se] = Ap; TH[es * 32 + se] = h; } }
        LSTAMP(T, 33);
    }
    __syncthreads();
}

__device__ __forceinline__ void fix(LRU_LAS unsigned char* lds, const Tensors& T, int g, int tc) {
    if (tc == 0) return;
    const int tid = threadIdx.x; LRU_LAS float* CR = (LRU_LAS float*)(lds + OFF_CR);
    const int b = g >> 3, n = g & 7; const size_t rowb = (size_t)b * 2048 + tc * CH;
    const int cg = tid & 15, trow = tid >> 4;
    u32x4 yv[4], qv[4];
#pragma unroll
    for (int i = 0; i < 4; ++i) { const size_t row = rowb + trow + 32 * i;
        yv[i] = *(const u32x4*)(T.Y + row * 2048 + 1024 + n * 128 + cg * 8); qv[i] = *(const u32x4*)(T.Q1 + row * 1024 + n * 128 + cg * 8); }
    if (tid < tc) { unsigned sp = 0; while (__hip_atomic_load(T.FLG + (size_t)(g * 16 + tid) * 16, __ATOMIC_RELAXED, __HIP_MEMORY_SCOPE_AGENT) == 0u) { __builtin_amdgcn_s_sleep(2); if (++sp > (1u << 22)) break; } }
    __syncthreads();
    if (tid < 128) { float c = 0.f; float pa[15], ph[15];
#pragma unroll
        for (int t2 = 0; t2 < 15; ++t2) { pa[t2] = 1.f; ph[t2] = 0.f;
            if (t2 < tc) { const float* pub = T.PUB + (size_t)(g * 16 + t2) * 256;
                pa[t2] = __hip_atomic_load(pub + tid, __ATOMIC_RELAXED, __HIP_MEMORY_SCOPE_AGENT); ph[t2] = __hip_atomic_load(pub + 128 + tid, __ATOMIC_RELAXED, __HIP_MEMORY_SCOPE_AGENT); } }
#pragma unroll
        for (int t2 = 0; t2 < 15; ++t2) c = pa[t2] * c + ph[t2];
        CR[tid] = c; }
    __syncthreads();
    f32x4 c0 = *(const LRU_LAS f32x4*)(CR + cg * 8), c1 = *(const LRU_LAS f32x4*)(CR + cg * 8 + 4);
#pragma unroll
    for (int i = 0; i < 4; ++i) { const size_t row = rowb + trow + 32 * i;
        unsigned short* yp = T.Y + row * 2048 + 1024 + n * 128 + cg * 8; u32x4 o;
#define FIX2_(y, q, ca, cb_) cvtpk(__uint_as_float((y) << 16) + __uint_as_float((q) << 16) * (ca), __uint_as_float((y) & 0xffff0000u) + __uint_as_float((q) & 0xffff0000u) * (cb_))
        o.x = FIX2_(yv[i].x, qv[i].x, c0[0], c0[1]); o.y = FIX2_(yv[i].y, qv[i].y, c0[2], c0[3]); o.z = FIX2_(yv[i].z, qv[i].z, c1[0], c1[1]); o.w = FIX2_(yv[i].w, qv[i].w, c1[2], c1[3]);
#undef FIX2_
        *(u32x4*)yp = o; }
    __syncthreads();
}
}

namespace cg = cooperative_groups;
#ifndef ALIGN_SINGLE
#define ALIGN_SINGLE true
#endif
#ifndef REP_P0
#define REP_P0 1
#endif
#ifndef REP_P1
#define REP_P1 1
#endif
#ifndef REP_LRU
#define REP_LRU 1
#endif
#ifndef REP_ATT
#define REP_ATT 1
#endif
#ifndef REP_P3
#define REP_P3 1
#endif
#ifndef REP_P4
#define REP_P4 1
#endif
#ifndef EXTRA_SYNC
#define EXTRA_SYNC 0
#endif
constexpr int NWAVES = 8;
constexpr int BATCH = 4, SEQ = 2048, DM = 2048, M = BATCH * SEQ, DIN = 10240, AW = 1024, LW = 1024, PLE = 256, NH = 8, HD = 128;
constexpr size_t MiB = 1u << 20;
constexpr size_t WS_BAR = 512 * 1024, BAR_BYTES = 16384, WS_FLG = WS_BAR + BAR_BYTES, FLG_BYTES = 32768, WS_C8 = 576 * 1024, WS_PUB = 2 * MiB + 512 * 1024, WS_Q1 = 296 * MiB;
constexpr size_t WS_KMP = 0, WS_SSQ = 1 * MiB, WS_WRT = 2 * MiB, WS_WIT = 2 * MiB + 256 * 1024, WS_WPLE = 3 * MiB, WS_W2 = 4 * MiB, WS_WOUT = 12 * MiB, WS_WG = 20 * MiB, WS_WIN = 28 * MiB,
                 WS_H = 68 * MiB, WS_MG = 68 * MiB, WS_PB = 100 * MiB, WS_Q = 104 * MiB, WS_K = 120 * MiB, WS_V = 136 * MiB, WS_GA = 152 * MiB, WS_XR = 168 * MiB, WS_GL = 184 * MiB,
                 WS_SA = 200 * MiB, WS_SL = 232 * MiB, WS_Y = 264 * MiB, WS_X1G = 104 * MiB, WS_PL = 136 * MiB, WS_END = 312 * MiB;
static_assert(WS_K == WS_Q + 16 * MiB && WS_V == WS_Q + 32 * MiB && WS_GA == WS_Q + 48 * MiB && WS_XR == WS_Q + 64 * MiB && WS_GL == WS_Q + 80 * MiB && WS_SA == WS_Q + 96 * MiB && WS_SL == WS_SA + 32 * MiB, "EpiG1 destination arithmetic");
constexpr int RING_BYTES = 131072, SCR_OFF = RING_BYTES, KM_LDS_OFF = 69632;
constexpr int LDS_BYTES = 155648, MISC_OFF = LDS_BYTES - 64;
static_assert(attn::STG_OFF + 65536 <= LDS_BYTES && attn::KM_OFF == KM_LDS_OFF && attn::KM_OFF + 4096 <= attn::STG_OFF, "attention LDS map");
static_assert(attn::LDS_BYTES <= KM_LDS_OFF && KM_LDS_OFF + 4096 <= RING_BYTES && lru::LRU_LDS <= MISC_OFF && SCR_OFF + 8192 <= LDS_BYTES, "LDS map");

#define GAS __attribute__((address_space(1)))
#define LAS __attribute__((address_space(3)))
typedef unsigned short bf16;
typedef unsigned v4u __attribute__((ext_vector_type(4)));
typedef float f32x4 __attribute__((ext_vector_type(4)));
#define LDS_WAIT() asm volatile("s_waitcnt lgkmcnt(0)" ::: "memory")
__device__ __forceinline__ unsigned f2bf(float f) { unsigned u = __builtin_bit_cast(unsigned, f); return (u + 0x7fffu + ((u >> 16) & 1u)) >> 16; }
__device__ __forceinline__ unsigned pk2(float lo, float hi) { return f2bf(lo) | (f2bf(hi) << 16); }
__device__ __forceinline__ float wave_sum(float v) {
#pragma unroll
    for (int o = 1; o < 64; o <<= 1) v += __shfl_xor(v, o);
    return v;
}
__device__ __forceinline__ void p0_transpose_item(const float* W, int N, bf16* WT, int ldk, int row_off, int k_off, LAS float* scr, int kb, int nb, int lane) {
    const int k0 = 64 * kb, n0 = 32 * nb;
#pragma unroll 8
    for (int i = 0; i < 32; ++i) { const int kk = 2 * i + (lane >> 5); scr[kk * 33 + (lane & 31)] = W[(size_t)(k0 + kk) * N + n0 + (lane & 31)]; }
    LDS_WAIT(); asm volatile("" ::: "memory");
    const int c = lane & 7;
#pragma unroll
    for (int j = 0; j < 4; ++j) { const int n = (lane >> 3) + 8 * j; const LAS float* s = scr + (8 * c) * 33 + n;
        v4u o; o.x = pk2(s[0 * 33], s[1 * 33]); o.y = pk2(s[2 * 33], s[3 * 33]); o.z = pk2(s[4 * 33], s[5 * 33]); o.w = pk2(s[6 * 33], s[7 * 33]);
        *(GAS v4u*)(WT + (size_t)(row_off + n0 + n) * ldk + k_off + k0 + 8 * c) = o; }
    LDS_WAIT(); asm volatile("" ::: "memory");
}

#define RLX_AGENT __ATOMIC_RELAXED, __HIP_MEMORY_SCOPE_AGENT
#define XB_TMO      128
#define XB_XCNT(j)  (256  + 64 * (j))
#define XB_XSUB(j)  (1280 + 64 * (j))
#define XB_XGEN(j)  (2304 + 64 * (j))
#define XB_TOP      3328
#define XB_TOPGEN   3392
#define XCD_BAR_WORDS 3456
#define XB_SPIN_CAP (1u << 18)

__device__ __forceinline__ unsigned xb_ld(unsigned* p)              { return __hip_atomic_load(p, __ATOMIC_RELAXED, __HIP_MEMORY_SCOPE_AGENT); }
__device__ __forceinline__ unsigned xb_add(unsigned* p, unsigned v) { return __hip_atomic_fetch_add(p, v, __ATOMIC_RELAXED, __HIP_MEMORY_SCOPE_AGENT); }
__device__ __forceinline__ unsigned xb_xcc_id() { return (unsigned)__builtin_amdgcn_s_getreg((3 << 11) | 20) & 0xFu; }
#define XB_SPIN(cond, bar) do { unsigned _sp = 0; while (cond) { __builtin_amdgcn_s_sleep(1); \
    if ((++_sp & 255u) == 0u) { if (xb_ld(&(bar)[XB_TMO])) break; if (_sp > XB_SPIN_CAP) { atomicAdd(&(bar)[XB_TMO], 1u); break; } } } } while (0)

struct XcdBarrier {
    unsigned* bar; unsigned x;
    volatile LAS unsigned* st;
};

__device__ __forceinline__ XcdBarrier xcd_barrier_post(unsigned* bar, volatile LAS unsigned* st) {
    XcdBarrier b; b.bar = bar; b.x = xb_xcc_id(); b.st = st;
    if (threadIdx.x == 0) (void)xb_add(&bar[XB_XCNT(b.x)], 1u);
    return b;
}
__device__ __forceinline__ void xcd_barrier_complete(unsigned* bar, unsigned x, unsigned& nloc, unsigned& nx) {
    const unsigned G = gridDim.x * gridDim.y * gridDim.z;
    unsigned sum, cnt, mine, sp = 0u;
    for (;;) {
        sum = 0u; cnt = 0u; mine = 0u;
#pragma unroll
        for (unsigned j = 0; j < 16; ++j) { const unsigned c = xb_ld(&bar[XB_XCNT(j)]); sum += c; cnt += (c > 0u) ? 1u : 0u; mine = (j == x) ? c : mine; }
        if (sum == G) break;
        __builtin_amdgcn_s_sleep(1);
        if ((++sp & 255u) == 0u) { if (xb_ld(&bar[XB_TMO])) break; if (sp > XB_SPIN_CAP) { atomicAdd(&bar[XB_TMO], 1u); break; } }
    }
    nloc = mine > 0u ? mine : 1u; nx = cnt > 0u ? cnt : 1u;
}

__device__ __forceinline__ void xcd_barrier(const XcdBarrier& b) {
    asm volatile("s_waitcnt vmcnt(0)" ::: "memory");
    __syncthreads();
    if (threadIdx.x == 0) {
        unsigned* bar = b.bar;
        __builtin_amdgcn_s_waitcnt(0);
        unsigned nloc = b.st[0], nx = b.st[1];
        if (nloc == 0u) { xcd_barrier_complete(bar, b.x, nloc, nx); b.st[0] = nloc; b.st[1] = nx; }
        const unsigned old = xb_add(&bar[XB_XSUB(b.x)], 1u);
        const unsigned gen = old / nloc;
        if (old + 1u == (gen + 1u) * nloc) {
            __builtin_amdgcn_fence(__ATOMIC_RELEASE, "agent");
            asm volatile("s_waitcnt vmcnt(0)" ::: "memory");
            const unsigned og = xb_add(&bar[XB_TOP], 1u);
            const unsigned tg = og / nx;
            if (og + 1u == (tg + 1u) * nx) xb_add(&bar[XB_TOPGEN], 1u);
            else XB_SPIN(xb_ld(&bar[XB_TOPGEN]) == tg, bar);
            __builtin_amdgcn_fence(__ATOMIC_ACQUIRE, "agent");
            xb_add(&bar[XB_XGEN(b.x)], 1u);
            asm volatile("s_waitcnt vmcnt(0)" ::: "memory");
        } else {
            XB_SPIN(xb_ld(&bar[XB_XGEN(b.x)]) == gen, bar);
            __builtin_amdgcn_fence(__ATOMIC_ACQUIRE, "agent");
            asm volatile("s_waitcnt vmcnt(0)" ::: "memory");
        }
    }
    __syncthreads();
}

struct Args { const float* in[20]; float* out; unsigned char* ws; };

__device__ __forceinline__ void p0_prologue(const Args& args, LAS unsigned char* ldsl, int vcu, int G, int wave, int lane, bf16* Win_t, bf16* W2_t, bf16* Wout_t, bf16* Wg_t, bf16* Wple_t, bf16* Wr_t, bf16* Wi_t, bf16* Hb, bf16* PB, float* C8) {
    {
        LAS float* scr = (LAS float*)(ldsl + wave * 16384);
        const int gw = vcu * NWAVES + wave, NGW = G * NWAVES;
        constexpr int I0 = 32 * 320, I1 = 16 * 64, I2 = 16 * 64, I3 = 32 * 64, I4 = 32 * 64, I5 = 4 * 64, I6 = 64, I7 = 64;
        constexpr int NITEMS = I0 + I1 + I2 + I3 + I4 + I5 + I6 + I7;
        for (int it = gw; it < NITEMS; it += NGW) {
            int r = it;
            if (r < I0) { p0_transpose_item(args.in[3], DIN, Win_t, 2048, 0, 0, scr, r / 320, r % 320, lane); continue; } r -= I0;
            if (r < I1) { p0_transpose_item(args.in[13], DM, W2_t, 2048, 0, 0, scr, r / 64, r % 64, lane); continue; } r -= I1;
            if (r < I2) { p0_transpose_item(args.in[14], DM, W2_t, 2048, 0, 1024, scr, r / 64, r % 64, lane); continue; } r -= I2;
            if (r < I3) { p0_transpose_item(args.in[15], DM, Wout_t, 2048, 0, 0, scr, r / 64, r % 64, lane); continue; } r -= I3;
            if (r < I4) { p0_transpose_item(args.in[17], DM, Wg_t, 2048, 0, 0, scr, r / 64, r % 64, lane); continue; } r -= I4;
            if (r < I5) { p0_transpose_item(args.in[19], DM, Wple_t, 256, 0, 0, scr, r / 64, r % 64, lane); continue; } r -= I5;
            if (r < I6) { const int n = r >> 3, s = r & 7; p0_transpose_item(args.in[8] + (size_t)n * 16384, 128, Wr_t, 128, n * 128, 0, scr, s >> 2, s & 3, lane); continue; } r -= I6;
            { const int n = r >> 3, s = r & 7; p0_transpose_item(args.in[10] + (size_t)n * 16384, 128, Wi_t, 128, n * 128, 0, scr, s >> 2, s & 3, lane); }
        }
        const float* x = args.in[0]; const float* ng = args.in[2];
        {
            const GAS f32x4* gr = (const GAS f32x4*)ng + lane; f32x4 gg[8];
#pragma unroll
            for (int j = 0; j < 8; ++j) gg[j] = gr[64 * j];
            int m = gw; f32x4 v[8], vn[8];
            if (m < M) { const GAS f32x4* xr = (const GAS f32x4*)(x + (size_t)m * DM) + lane;
#pragma unroll
                for (int j = 0; j < 8; ++j) v[j] = xr[64 * j]; }
            while (m < M) {
                const int mn = m + NGW;
                if (mn < M) { const GAS f32x4* xr = (const GAS f32x4*)(x + (size_t)mn * DM) + lane;
#pragma unroll
                    for (int j = 0; j < 8; ++j) vn[j] = xr[64 * j]; }
                float s = 0.f;
#pragma unroll
                for (int j = 0; j < 8; ++j) s += (v[j].x * v[j].x + v[j].y * v[j].y) + (v[j].z * v[j].z + v[j].w * v[j].w);
                const float rstd = 1.0f / sqrtf(wave_sum(s) * (1.0f / DM) + 1e-6f);
                GAS unsigned long long* o8 = (GAS unsigned long long*)(Hb + (size_t)m * DM) + lane;
#pragma unroll
                for (int j = 0; j < 8; ++j) { const f32x4 g = gg[j];
                    o8[64 * j] = (unsigned long long)pk2(v[j].x * rstd * g.x, v[j].y * rstd * g.y) | ((unsigned long long)pk2(v[j].z * rstd * g.z, v[j].w * rstd * g.w) << 32); }
#pragma unroll
                for (int j = 0; j < 8; ++j) v[j] = vn[j];
                m = mn; }
        }
        if (gw < 16) { const int i = gw * 64 + lane; const float x = -args.in[12][i]; C8[i] = 8.0f * (fmaxf(x, 0.f) + log1pf(expf(-fabsf(x)))); }
        const float* p = args.in[1];
        for (int m0 = gw; m0 < M; m0 += 4 * NGW) {
            f32x4 pv[4];
#pragma unroll
            for (int i = 0; i < 4; ++i) { const int m = m0 + i * NGW; pv[i] = (f32x4){0.f, 0.f, 0.f, 0.f}; if (m < M) pv[i] = ((const GAS f32x4*)(p + (size_t)m * PLE))[lane]; }
#pragma unroll
            for (int i = 0; i < 4; ++i) { const int m = m0 + i * NGW;
                if (m < M) ((GAS unsigned long long*)(PB + (size_t)m * PLE))[lane] = (unsigned long long)pk2(pv[i].x, pv[i].y) | ((unsigned long long)pk2(pv[i].z, pv[i].w) << 32); }
        }
    }
}

#ifdef PROBE_TS
#ifndef PROBE_SCALE
#define PROBE_SCALE 0.002f
#endif
#ifndef PROBE_BLK
#define PROBE_BLK 0
#endif
#define STAMP(i) do { if (blockIdx.x == PROBE_BLK && threadIdx.x == 0) ((volatile unsigned long long*)(args.ws + (600u << 10)))[i] = __builtin_amdgcn_s_memrealtime(); } while (0)
#else
#define STAMP(i) do { } while (0)
#endif

template <bool DO_LRU, bool DO_ATT, bool WPRE = false> __device__ __forceinline__ void p2_phase(const Args& args, unsigned char* lds, LAS unsigned char* ldsl, int vcu, int G, bf16* Qb, bf16* Kb, bf16* Vb, bf16* GA, bf16* XR, bf16* GL, bf16* Yb, bf16* Wr_t, bf16* Wi_t, float* KMP, bf16* Q1b, float* PUB, unsigned* FLG, const float* C8) {
    const lru::Tensors T{XR, GL, Yb, Q1b, Wr_t, Wi_t, args.in[6], args.in[7], args.in[9], args.in[11], C8, PUB, FLG};
#ifndef SKIP_LRU
    if constexpr (DO_LRU)
    for (int L = vcu; L < 256; L += G) { const int g = L >> 3, q = L & 7;
        int tcs[4]; int nu = 0;
#pragma unroll
        for (int r = 0; r < 4; ++r) { const int tc = lru::unit_tc(q, r); tcs[r] = tc; if (tc >= 0) nu = r + 1; }
        if (nu > 0) {
        lru::Raw R; lru::load_raw(T, g, tcs[0], R);
        if (!(WPRE && L == vcu)) lru::load_weights(ldsl, T, g & 7);
#pragma unroll
        for (int k = 0; k < 4; ++k) if (k < nu) {
            LSTAMP(T, 20);
            lru::conv_stage(ldsl, T, g, R);
            LSTAMP(T, 21);
            if (k > 0) lru::publish(ldsl, T, g, tcs[k - 1]);
            if (k + 1 < nu) lru::load_raw(T, g, tcs[k + 1], R);
            LSTAMP(T, 23);
            lru::gate_stage(ldsl, T, g, tcs[k]); LSTAMP(T, 22); }
        lru::publish(ldsl, T, g, nu == 4 ? tcs[3] : (nu == 3 ? tcs[2] : (nu == 2 ? tcs[1] : tcs[0])));
        }
    }
#endif
    STAMP(10);
#ifndef SKIP_ATTN
    if constexpr (DO_ATT)
    attn::phase((char*)lds, (const attn::bf16*)Qb, (const attn::bf16*)Kb, (const attn::bf16*)Vb, (attn::bf16*)Yb, (const attn::bf16*)GA, KMP, vcu, G);
#endif
    STAMP(11);
#ifndef SKIP_LRU
    if constexpr (DO_LRU)
    for (int L = vcu; L < 256; L += G) { const int g = L >> 3, q = L & 7;
#pragma unroll 1
        for (int r = 0; r < 4; ++r) { const int tc = lru::unit_tc(q, r); if (tc > 0) lru::fix(ldsl, T, g, tc); }
    }
#endif
    STAMP(12);
}

__global__ void __launch_bounds__(NWAVES * 64, 2) moba_rglru_fwd(Args args) {
    extern __shared__ __attribute__((aligned(16))) unsigned char lds[];
    cg::grid_group grid = cg::this_grid();
    LAS unsigned char* ldsl = (LAS unsigned char*)lds;
    const int tid = threadIdx.x, lane = tid & 63, wave = __builtin_amdgcn_readfirstlane(tid >> 6);
    const int G = gridDim.x; const int bx = blockIdx.x; const int vcu = (G % 8 == 0) ? (bx % 8) * (G / 8) + bx / 8 : bx;
    unsigned char* ws = args.ws;
    volatile LAS unsigned* MISC = (volatile LAS unsigned*)(ldsl + MISC_OFF);
    if (tid < 16) MISC[tid] = 0u;
    __syncthreads();
    XcdBarrier bar = xcd_barrier_post((unsigned*)(ws + WS_BAR), MISC);
#ifdef KEEP_CG_DESCRIPTOR
    if (G > (1 << 20)) grid.sync();
#endif
#define GRID_BAR(i) do { xcd_barrier(bar); STAMP(i); } while (0)
    STAMP(0);
    bf16* Win_t = (bf16*)(ws + WS_WIN); bf16* W2_t = (bf16*)(ws + WS_W2); bf16* Wout_t = (bf16*)(ws + WS_WOUT); bf16* Wg_t = (bf16*)(ws + WS_WG); bf16* Wple_t = (bf16*)(ws + WS_WPLE);
    bf16* Wr_t = (bf16*)(ws + WS_WRT); bf16* Wi_t = (bf16*)(ws + WS_WIT);
    bf16* Hb = (bf16*)(ws + WS_H); bf16* MG = (bf16*)(ws + WS_MG); bf16* PB = (bf16*)(ws + WS_PB);
    bf16* Qb = (bf16*)(ws + WS_Q); bf16* Kb = (bf16*)(ws + WS_K); bf16* Vb = (bf16*)(ws + WS_V); bf16* GA = (bf16*)(ws + WS_GA); bf16* XR = (bf16*)(ws + WS_XR); bf16* GL = (bf16*)(ws + WS_GL);
    bf16* SAb = (bf16*)(ws + WS_SA); bf16* SLb = (bf16*)(ws + WS_SL); bf16* Yb = (bf16*)(ws + WS_Y); bf16* X1G = (bf16*)(ws + WS_X1G); bf16* PL = (bf16*)(ws + WS_PL);
    float* KMP = (float*)(ws + WS_KMP); float* SSQ = (float*)(ws + WS_SSQ);
    bf16* Q1b = (bf16*)(ws + WS_Q1); float* PUB = (float*)(ws + WS_PUB); unsigned* FLG = (unsigned*)(ws + WS_FLG); float* C8 = (float*)(ws + WS_C8);

#ifndef SKIP_P0
    p0_prologue(args, ldsl, vcu, G, wave, lane, Win_t, W2_t, Wout_t, Wg_t, Wple_t, Wr_t, Wi_t, Hb, PB, C8);
#if REP_P0 >= 2
    p0_prologue(args, ldsl, vcu, G, wave, lane, Win_t, W2_t, Wout_t, Wg_t, Wple_t, Wr_t, Wi_t, Hb, PB, C8);
#endif
#if REP_P0 >= 3
    p0_prologue(args, ldsl, vcu, G, wave, lane, Win_t, W2_t, Wout_t, Wg_t, Wple_t, Wr_t, Wi_t, Hb, PB, C8);
#endif
#endif
    GRID_BAR(1);

    for (int es_ = 0; es_ < EXTRA_SYNC; ++es_) GRID_BAR(99);
#ifndef SKIP_P1
    for (int rep_ = 0; rep_ < REP_P1; ++rep_) {
    {
        pg8::Gemm g{Hb, Win_t, M, DIN, DM}; pg8::StaticOrder S; S.init(M, DIN, G, bx);
        pg8::EpiG1 E{ws + WS_Q, KMP, args.in[4], args.in[5], (LAS float*)(ldsl + SCR_OFF), 0};
        pg8::gemm_phase<pg8::EpiG1, pg8::StaticOrder, true, true>(ldsl, g, S, E);
    }
    }
#endif
#if !defined(SKIP_P2) && !defined(SKIP_LRU)
    if (vcu < 256 && lru::unit_tc(vcu & 7, 0) >= 0) {
        const lru::Tensors T{XR, GL, Yb, Q1b, Wr_t, Wi_t, args.in[6], args.in[7], args.in[9], args.in[11], C8, PUB, FLG};
        lru::load_weights(ldsl, T, (vcu >> 3) & 7); }
#endif
    GRID_BAR(2);

#ifndef SKIP_P2
    p2_phase<true, true, true>(args, lds, ldsl, vcu, G, Qb, Kb, Vb, GA, XR, GL, Yb, Wr_t, Wi_t, KMP, Q1b, PUB, FLG, C8);
#if REP_LRU >= 2
    p2_phase<true, false>(args, lds, ldsl, vcu, G, Qb, Kb, Vb, GA, XR, GL, Yb, Wr_t, Wi_t, KMP, Q1b, PUB, FLG, C8);
#endif
#if REP_ATT >= 2
    p2_phase<false, true>(args, lds, ldsl, vcu, G, Qb, Kb, Vb, GA, XR, GL, Yb, Wr_t, Wi_t, KMP, Q1b, PUB, FLG, C8);
#endif
#if REP_LRU >= 3
    p2_phase<true, false>(args, lds, ldsl, vcu, G, Qb, Kb, Vb, GA, XR, GL, Yb, Wr_t, Wi_t, KMP, Q1b, PUB, FLG, C8);
#endif
#if REP_ATT >= 3
    p2_phase<false, true>(args, lds, ldsl, vcu, G, Qb, Kb, Vb, GA, XR, GL, Yb, Wr_t, Wi_t, KMP, Q1b, PUB, FLG, C8);
#endif
#endif
    GRID_BAR(3);

#ifndef SKIP_P3
    for (int rep_ = 0; rep_ < REP_P3; ++rep_) {
    {
        size_t zw3 = 0; asm volatile("" : "+s"(zw3)); unsigned char* w3 = args.ws + zw3;
        pg8::Gemm g{(bf16*)(w3 + WS_Y), (bf16*)(w3 + WS_W2), M, DM, DM}; pg8::StaticOrder S; S.init(M, DM, G, bx);
        pg8::EpiG2 E{(bf16*)(w3 + WS_SA), (bf16*)(w3 + WS_SL), (bf16*)(w3 + WS_MG), 16};
        pg8::gemm_phase<pg8::EpiG2, pg8::StaticOrder, ALIGN_SINGLE, true>(ldsl, g, S, E);
    }
    }
#endif
    GRID_BAR(4);

#ifndef SKIP_P4
    for (int rep_ = 0; rep_ < REP_P4; ++rep_) {
    {
        size_t zw4 = 0; asm volatile("" : "+s"(zw4)); unsigned char* w4 = args.ws + zw4;
        pg8::Gemm g{(bf16*)(w4 + WS_MG), (bf16*)(w4 + WS_WOUT), M, DM, DM}; pg8::StaticOrder S; S.init(M, DM, G, bx);
        pg8::EpiG3 E{args.in[0], args.out, (bf16*)(w4 + WS_X1G), (float*)(w4 + WS_SSQ), args.in[16], 0};
        pg8::gemm_phase<pg8::EpiG3, pg8::StaticOrder, ALIGN_SINGLE, true>(ldsl, g, S, E);
    }
    }
#endif
#ifndef SKIP_P5
    {
        size_t zw5a = 0; asm volatile("" : "+s"(zw5a)); unsigned char* w5 = args.ws + zw5a;
        { pg8::Gemm g{(bf16*)(w5 + WS_PB), (bf16*)(w5 + WS_WPLE), M, DM, PLE}; pg8::StaticOrder S; S.init(M, DM, G, bx);
          pg8::EpiG4a E{(bf16*)(w5 + WS_PL), 0};
          pg8::gemm_phase<pg8::EpiG4a, pg8::StaticOrder, ALIGN_SINGLE, true>(ldsl, g, S, E); }
        asm volatile("s_waitcnt vmcnt(0)" ::: "memory"); __syncthreads();
    }
#endif
    GRID_BAR(5);

#ifndef SKIP_P5
    {
        size_t zw5 = 0; asm volatile("" : "+s"(zw5)); unsigned char* w5 = args.ws + zw5;
        { pg8::Gemm g{(bf16*)(w5 + WS_X1G), (bf16*)(w5 + WS_WG), M, DM, DM}; pg8::StaticOrder S; S.init(M, DM, G, bx);
          pg8::EpiG4b E{args.out, (bf16*)(w5 + WS_PL), (float*)(w5 + WS_SSQ), args.in[18], (LAS float*)(ldsl + SCR_OFF), 0};
          pg8::gemm_phase<pg8::EpiG4b, pg8::StaticOrder, ALIGN_SINGLE, true>(ldsl, g, S, E); }
    }
#endif
#ifdef PROBE_TS
    asm volatile("s_waitcnt vmcnt(0)" ::: "memory"); __syncthreads();
    STAMP(6);
    if (blockIdx.x == PROBE_BLK && threadIdx.x == 0) { volatile unsigned long long* ts_ = (volatile unsigned long long*)(args.ws + (600u << 10)); const float us = (float)(ts_[PROBE_TE] - ts_[PROBE_TS]) * 0.01f; args.out[0] += us * PROBE_SCALE; }
#endif
}

extern "C" void kernel_launch(void* const* d_in, const int* in_sizes, int n_in, void* d_out, int out_size, void* d_ws, size_t ws_size, hipStream_t stream) {
    static int grid_blocks = 0;
    if (grid_blocks == 0) {
        if (n_in != 20 || in_sizes[0] != M * DM || out_size != M * DM || ws_size < WS_END) { fprintf(stderr, "kernel_launch: unexpected shapes (n_in %d, in0 %d, out %d, ws %zu)\n", n_in, n_in > 0 ? in_sizes[0] : -1, out_size, ws_size); grid_blocks = -1; return; }
        int dev = 0, cus = 0, per_cu = 0;
        (void)hipGetDevice(&dev);
        (void)hipDeviceGetAttribute(&cus, hipDeviceAttributeMultiprocessorCount, dev);
        if (hipFuncSetAttribute((const void*)moba_rglru_fwd, hipFuncAttributeMaxDynamicSharedMemorySize, LDS_BYTES) != hipSuccess) { fprintf(stderr, "kernel_launch: hipFuncSetAttribute failed\n"); }
        if (hipOccupancyMaxActiveBlocksPerMultiprocessor(&per_cu, (const void*)moba_rglru_fwd, NWAVES * 64, LDS_BYTES) != hipSuccess || per_cu < 1) { fprintf(stderr, "kernel_launch: occupancy query failed (%d)\n", per_cu); per_cu = 1; }
        (void)hipGetLastError();
        if (per_cu > 1) per_cu = 1;
        grid_blocks = cus * per_cu;
        if (grid_blocks > 256) grid_blocks = 256;
    }
    if (grid_blocks < 0) return;
    if (hipMemsetAsync((char*)d_ws + WS_BAR, 0, BAR_BYTES + FLG_BYTES, stream) != hipSuccess) { fprintf(stderr, "kernel_launch: hipMemsetAsync failed\n"); return; }
    Args a{};
    for (int i = 0; i < 20; ++i) a.in[i] = (const float*)d_in[i];
    a.out = (float*)d_out; a.ws = (unsigned char*)d_ws;
    void* kargs[] = {&a};
    hipError_t e = hipLaunchCooperativeKernel((const void*)moba_rglru_fwd, dim3(grid_blocks), dim3(NWAVES * 64), kargs, LDS_BYTES, stream);
    if (e != hipSuccess) fprintf(stderr, "cooperative launch failed: %s (grid %d)\n", hipGetErrorString(e), grid_blocks);
}
```

```cpp
#include <hip/hip_runtime.h>
#include <hip/hip_bf16.h>
#include <hip/hip_cooperative_groups.h>
#include <cstdio>
#include <cstdint>
#include <cmath>
namespace pg8 {
#define PG8_LAS __attribute__((address_space(3)))
typedef unsigned short bf16_t;
typedef short bf16x8 __attribute__((ext_vector_type(8)));
typedef float f32x4 __attribute__((ext_vector_type(4)));
typedef unsigned u32x4 __attribute__((ext_vector_type(4)));
constexpr int BM = 256, BK = 64, HALF = 128, HTB = HALF * BK * 2  , STAGE_BYTES = 8 * HTB, NXCD = 8, WGM = 8;

__host__ __device__ __forceinline__ int lds_byte(int r, int c) { const int st = (r >> 4) * 2 + (c >> 5), rr = r & 15, cc = c & 31, ob = rr * 64 + cc * 2; return st * 1024 + (ob ^ (((ob >> 9) & 1) << 5)); }
__host__ __device__ __forceinline__ void stage_rc(int b, int& R, int& C) { const int st = b / 1024, sb = b % 1024, swz = sb ^ (((sb >> 9) & 1) << 5); R = (st >> 1) * 16 + swz / 64; C = (st & 1) * 32 + (swz % 64) / 2; }
__host__ __device__ __forceinline__ int perm32(int rho) { const int n = rho >> 4, i = rho & 15; return 8 * (i >> 2) + 4 * n + (i & 3); }

struct Unit { int pm, pn; };
struct Gemm { const bf16_t* A; const bf16_t* Bt; int M, N, K; };

struct StaticOrder {
    int nM, nN, nwg, G, c;
    __host__ __device__ void init(int M, int N, int G_, int c_) { nM = M / BM; nN = N / BM; nwg = nM * nN; G = G_; c = c_; }
    __host__ __device__ bool next(int i, Unit& u) const {
        const long L = (long)i * G + c; if (L >= nwg) return false;
        int wgid = (int)L; { const int q = nwg / NXCD, r = nwg % NXCD, xcd = wgid % NXCD, off = wgid / NXCD; wgid = (xcd < r ? xcd * (q + 1) : r * (q + 1) + (xcd - r) * q) + off; }
        const int nig = WGM * nN, gid = wgid / nig, fm = gid * WGM, gsz = (nM - fm) < WGM ? (nM - fm) : WGM;
        u.pm = fm + ((wgid % nig) % gsz); u.pn = (wgid % nig) / gsz; return true;
    }
    __device__ __forceinline__ void a_ready(const Unit&) const {}
    __device__ __forceinline__ void done(const Unit&) const {}
};

__device__ __forceinline__ unsigned cvt_pk_bf16(float lo, float hi) { unsigned r; asm volatile("v_cvt_pk_bf16_f32 %0, %1, %2" : "=v"(r) : "v"(lo), "v"(hi)); return r; }
__device__ __forceinline__ float bf_lo(unsigned w) { return __uint_as_float(w << 16); }
__device__ __forceinline__ float bf_hi(unsigned w) { return __uint_as_float(w & 0xffff0000u); }
__device__ __forceinline__ float sigmoidf_(float x) { return __builtin_amdgcn_rcpf(1.0f + __expf(-x)); }
__device__ __forceinline__ float siluf_(float x) { return x * __builtin_amdgcn_rcpf(1.0f + __expf(-x)); }
__device__ __forceinline__ u32x4 pack8bf(const f32x4& v0, const f32x4& v1) { u32x4 w; w.x = cvt_pk_bf16(v0[0], v0[1]); w.y = cvt_pk_bf16(v0[2], v0[3]); w.z = cvt_pk_bf16(v1[0], v1[1]); w.w = cvt_pk_bf16(v1[2], v1[3]); return w; }
__device__ __forceinline__ void unpack8bf(const u32x4& w, f32x4& v0, f32x4& v1) { v0 = (f32x4){bf_lo(w.x), bf_hi(w.x), bf_lo(w.y), bf_hi(w.y)}; v1 = (f32x4){bf_lo(w.z), bf_hi(w.z), bf_lo(w.w), bf_hi(w.w)}; }

#ifndef WT_STORES
#define WT_STORES 0
#endif
__device__ __forceinline__ void st16(void* p, const u32x4& v) {
#if WT_STORES
    asm volatile("global_store_dwordx4 %0, %1, off sc1\n\ts_nop 1" :: "v"(p), "v"(v) : "memory");
#else
    *(u32x4*)p = v;
#endif
}
__device__ __forceinline__ void st16p(void* p, const u32x4& v) { *(u32x4*)p = v; }
__device__ __forceinline__ void st16f(void* p, const f32x4& v) { *(f32x4*)p = v; }
constexpr int SEQ_ = 2048, NHEAD_ = 8;
struct EpiG1 {
    static constexpr bool PERM = true, AFTER_DRAIN = false, HOOK = false;
    unsigned char* wsQ; float* KMP; const float *qg, *kg; PG8_LAS float* scr; int hook_t;
    __device__ __forceinline__ void mid(f32x4 (&acc)[2][2][4][2], const Unit& u, int wr, int wc, int fr, int fq) const {}
    __device__ __forceinline__ void operator()(f32x4 (&acc)[2][2][4][2], const Unit& u, int wr, int wc, int fr, int fq) const {
        const int pn = u.pn; asm volatile("" : "+v"(fr), "+v"(fq));
        if (pn < 12) {
            if (pn < 8) {
#pragma unroll
                for (int ai = 0; ai < 2; ++ai)
#pragma unroll
                    for (int m = 0; m < 4; ++m)
#pragma unroll
                        for (int bj = 0; bj < 2; ++bj) {
                            const f32x4 a = acc[ai][bj][m][0], b = acc[ai][bj][m][1];
                            float s = (a[0] * a[0] + a[1] * a[1]) + (a[2] * a[2] + a[3] * a[3]) + (b[0] * b[0] + b[1] * b[1]) + (b[2] * b[2] + b[3] * b[3]);
                            s += __shfl_xor(s, 16); s += __shfl_xor(s, 32);
                            if (fq == 0) scr[((ai * HALF + wr * 64 + m * 16 + fr) * 2 + bj) * 4 + wc] = s;
                        }
                const f32x4 gq0 = *(const f32x4*)(qg + wc * 32 + 8 * fq), gq1 = *(const f32x4*)(qg + wc * 32 + 8 * fq + 4);
                const f32x4 gk0 = *(const f32x4*)(kg + wc * 32 + 8 * fq), gk1 = *(const f32x4*)(kg + wc * 32 + 8 * fq + 4);
                asm volatile("s_waitcnt lgkmcnt(0)" ::: "memory"); __builtin_amdgcn_s_barrier(); asm volatile("" ::: "memory");
                const f32x4 g0 = (pn < 4) ? gq0 : gk0, g1 = (pn < 4) ? gq1 : gk1;
#pragma unroll
                for (int ai = 0; ai < 2; ++ai)
#pragma unroll
                    for (int m = 0; m < 4; ++m)
#pragma unroll
                        for (int bj = 0; bj < 2; ++bj) {
                            const f32x4 p = *(const PG8_LAS f32x4*)(scr + ((ai * HALF + wr * 64 + m * 16 + fr) * 2 + bj) * 4);
                            const float rstd = __builtin_amdgcn_rsqf(((p[0] + p[1]) + (p[2] + p[3])) * (1.0f / 128.0f) + 1e-6f);
                            acc[ai][bj][m][0] = acc[ai][bj][m][0] * rstd * g0; acc[ai][bj][m][1] = acc[ai][bj][m][1] * rstd * g1;
                        }
                if (pn >= 4) {
#pragma unroll
                    for (int bj = 0; bj < 2; ++bj)
#pragma unroll
                        for (int n = 0; n < 2; ++n) {
                            f32x4 cs = (f32x4){0.f, 0.f, 0.f, 0.f};
#pragma unroll
                            for (int ai = 0; ai < 2; ++ai)
#pragma unroll
                                for (int m = 0; m < 4; ++m) cs += acc[ai][bj][m][n];
#pragma unroll
                            for (int o = 1; o < 16; o <<= 1) { cs[0] += __shfl_xor(cs[0], o); cs[1] += __shfl_xor(cs[1], o); cs[2] += __shfl_xor(cs[2], o); cs[3] += __shfl_xor(cs[3], o); }
                            if (fr == 0) *(f32x4*)(KMP + (size_t)(u.pm * 2 + wr) * 1024 + (pn - 4) * 256 + bj * HALF + wc * 32 + 8 * fq + 4 * n) = cs;
                        }
                }
            }
            bf16_t* base = (bf16_t*)(wsQ + (size_t)(pn >> 2) * (16u << 20));
            const int b = u.pm >> 3, s0 = (u.pm & 7) * 256 + wr * 64 + fr;
#pragma unroll
            for (int bj = 0; bj < 2; ++bj) {
                const int h = 2 * (pn & 3) + bj;
                bf16_t* hp = base + ((size_t)(b * NHEAD_ + h) * SEQ_ + s0) * 128 + wc * 32 + 8 * fq;
#pragma unroll
                for (int ai = 0; ai < 2; ++ai)
#pragma unroll
                    for (int m = 0; m < 4; ++m) st16p(hp + (size_t)(ai * HALF + m * 16) * 128, pack8bf(acc[ai][bj][m][0], acc[ai][bj][m][1]));
            }
        } else {
            bf16_t* base; int ldc, colt, act;
            if (pn < 24) { base = (bf16_t*)(wsQ + (size_t)(pn >> 2) * (16u << 20)); ldc = 1024; colt = (pn & 3) * 256; act = ((pn >> 2) == 4) ? 0 : 1; }
            else { base = (bf16_t*)(wsQ + (size_t)(96u << 20) + (size_t)((pn - 24) >> 3) * (32u << 20)); ldc = 2048; colt = ((pn - 24) & 7) * 256; act = 2; }
            const int row0 = u.pm * BM + wr * 64 + fr, col0 = colt + wc * 32 + 8 * fq;
#pragma unroll
            for (int ai = 0; ai < 2; ++ai)
#pragma unroll
                for (int m = 0; m < 4; ++m) { bf16_t* rowp = base + (size_t)(row0 + ai * HALF + m * 16) * ldc + col0;
#pragma unroll
                    for (int bj = 0; bj < 2; ++bj) { f32x4 v0 = acc[ai][bj][m][0], v1 = acc[ai][bj][m][1];
                        if (act != 0) {
#pragma unroll
                            for (int j = 0; j < 4; ++j) { const float e0 = __builtin_amdgcn_rcpf(1.0f + __expf(-v0[j])), e1 = __builtin_amdgcn_rcpf(1.0f + __expf(-v1[j]));
                                v0[j] = (act == 1) ? v0[j] * e0 : e0; v1[j] = (act == 1) ? v1[j] * e1 : e1; } }
                        st16p(rowp + bj * HALF, pack8bf(v0, v1)); } }
        }
    }
};

struct EpiG2 {
    static constexpr bool PERM = true, AFTER_DRAIN = false, HOOK = true;
    const bf16_t *SA, *SL; bf16_t* MG; int hook_t;
    __device__ __forceinline__ void mid(f32x4 (&acc)[2][2][4][2], const Unit& u, int wr, int wc, int fr, int fq) const {
        asm volatile("" : "+v"(fr), "+v"(fq)); const int row0 = u.pm * BM + wr * 64 + fr, col0 = u.pn * BM + wc * 32 + 8 * fq;
#pragma unroll
        for (int ai = 0; ai < 2; ++ai)
#pragma unroll
            for (int m = 0; m < 4; ++m) { const size_t off = (size_t)(row0 + ai * HALF + m * 16) * 2048 + col0;
#pragma unroll
                for (int bj = 0; bj < 2; ++bj) {
                    const u32x4 wa = *(const u32x4*)(SA + off + bj * HALF), wl = *(const u32x4*)(SL + off + bj * HALF);
                    f32x4 a0, a1, l0, l1; unpack8bf(wa, a0, a1); unpack8bf(wl, l0, l1);
#pragma unroll
                    for (int j = 0; j < 4; ++j) { acc[ai][bj][m][0][j] *= a0[j] * __builtin_amdgcn_rcpf(l0[j]); acc[ai][bj][m][1][j] *= a1[j] * __builtin_amdgcn_rcpf(l1[j]); }
                }
                if (m == 3) asm volatile("" ::: "memory"); }
    }
    __device__ __forceinline__ void operator()(f32x4 (&acc)[2][2][4][2], const Unit& u, int wr, int wc, int fr, int fq) const {
        asm volatile("" : "+v"(fr), "+v"(fq)); const int row0 = u.pm * BM + wr * 64 + fr, col0 = u.pn * BM + wc * 32 + 8 * fq;
        u32x4 wl[2][4][2];
#pragma unroll
        for (int ai = 0; ai < 2; ++ai)
#pragma unroll
            for (int m = 0; m < 4; ++m) { const size_t off = (size_t)(row0 + ai * HALF + m * 16) * 2048 + col0;
#pragma unroll
                for (int bj = 0; bj < 2; ++bj) wl[ai][m][bj] = *(const u32x4*)(SL + off + bj * HALF); }
        asm volatile("" ::: "memory");
#pragma unroll
        for (int ai = 0; ai < 2; ++ai)
#pragma unroll
            for (int m = 0; m < 4; ++m) { const size_t off = (size_t)(row0 + ai * HALF + m * 16) * 2048 + col0;
#pragma unroll
                for (int bj = 0; bj < 2; ++bj) {
                    f32x4 l0, l1; unpack8bf(wl[ai][m][bj], l0, l1);
                    st16(MG + off + bj * HALF, pack8bf(acc[ai][bj][m][0] * l0, acc[ai][bj][m][1] * l1));
                } }
    }
};

struct EpiG3 {
    static constexpr bool PERM = true, AFTER_DRAIN = false, HOOK = false;
    const float* X; float* OUT; bf16_t* X1G; float* SSQ; const float* gple; int hook_t;
    __device__ __forceinline__ void mid(f32x4 (&acc)[2][2][4][2], const Unit& u, int wr, int wc, int fr, int fq) const {}
    __device__ __forceinline__ void operator()(f32x4 (&acc)[2][2][4][2], const Unit& u, int wr, int wc, int fr, int fq) const {
        asm volatile("" : "+v"(fr), "+v"(fq)); const int row0 = u.pm * BM + wr * 64 + fr, col0 = u.pn * BM + wc * 32 + 8 * fq;
        f32x4 gv[2][2];
#pragma unroll
        for (int bj = 0; bj < 2; ++bj) { gv[bj][0] = *(const f32x4*)(gple + col0 + bj * HALF); gv[bj][1] = *(const f32x4*)(gple + col0 + bj * HALF + 4); }
#pragma unroll
        for (int ai = 0; ai < 2; ++ai) {
            f32x4 xl[4][2][2];
#pragma unroll
            for (int m = 0; m < 4; ++m) { const size_t off = (size_t)(row0 + ai * HALF + m * 16) * 2048 + col0;
#pragma unroll
                for (int bj = 0; bj < 2; ++bj) { xl[m][bj][0] = *(const f32x4*)(X + off + bj * HALF); xl[m][bj][1] = *(const f32x4*)(X + off + bj * HALF + 4); } }
            asm volatile("" ::: "memory");
#pragma unroll
            for (int m = 0; m < 4; ++m) { const int row = row0 + ai * HALF + m * 16; const size_t off = (size_t)row * 2048 + col0; float s = 0.f;
#pragma unroll
                for (int bj = 0; bj < 2; ++bj) {
                    const f32x4 x0 = xl[m][bj][0] + acc[ai][bj][m][0], x1 = xl[m][bj][1] + acc[ai][bj][m][1];
                    st16f(OUT + off + bj * HALF, x0); st16f(OUT + off + bj * HALF + 4, x1);
                    s += (x0[0] * x0[0] + x0[1] * x0[1]) + (x0[2] * x0[2] + x0[3] * x0[3]) + (x1[0] * x1[0] + x1[1] * x1[1]) + (x1[2] * x1[2] + x1[3] * x1[3]);
                    st16(X1G + off + bj * HALF, pack8bf(x0 * gv[bj][0], x1 * gv[bj][1]));
                }
                s += __shfl_xor(s, 16); s += __shfl_xor(s, 32);
                if (fq == 0) SSQ[(size_t)row * 32 + u.pn * 4 + wc] = s;
            }
            asm volatile("" ::: "memory");
        }
    }
};

struct EpiG4a {
    static constexpr bool PERM = true, AFTER_DRAIN = false, HOOK = false;
    bf16_t* PL; int hook_t;
    __device__ __forceinline__ void mid(f32x4 (&acc)[2][2][4][2], const Unit& u, int wr, int wc, int fr, int fq) const {}
    __device__ __forceinline__ void operator()(f32x4 (&acc)[2][2][4][2], const Unit& u, int wr, int wc, int fr, int fq) const {
        asm volatile("" : "+v"(fr), "+v"(fq)); const int row0 = u.pm * BM + wr * 64 + fr, col0 = u.pn * BM + wc * 32 + 8 * fq;
#pragma unroll
        for (int ai = 0; ai < 2; ++ai)
#pragma unroll
            for (int m = 0; m < 4; ++m) { const size_t off = (size_t)(row0 + ai * HALF + m * 16) * 2048 + col0;
#pragma unroll
                for (int bj = 0; bj < 2; ++bj) st16p(PL + off + bj * HALF, pack8bf(acc[ai][bj][m][0], acc[ai][bj][m][1])); }
    }
};

struct EpiG4b {
    static constexpr bool PERM = true, AFTER_DRAIN = false, HOOK = false;
    float* OUT; const bf16_t* PL; const float* SSQ; const float* bias; PG8_LAS float* scr; int hook_t;
    __device__ __forceinline__ void mid(f32x4 (&acc)[2][2][4][2], const Unit& u, int wr, int wc, int fr, int fq) const {}
    __device__ __forceinline__ void operator()(f32x4 (&acc)[2][2][4][2], const Unit& u, int wr, int wc, int fr, int fq) const {
        asm volatile("" : "+v"(fr), "+v"(fq)); const int row0 = u.pm * BM + wr * 64 + fr, col0 = u.pn * BM + wc * 32 + 8 * fq;
        {
            const int tid = threadIdx.x, hf = tid & 1; int rr = tid >> 1; asm volatile("" : "+v"(rr));
            f32x4 t = (f32x4){0.f, 0.f, 0.f, 0.f};
#pragma unroll
            for (int i = 0; i < 4; ++i) t += *(const f32x4*)(SSQ + (size_t)(u.pm * BM + rr) * 32 + hf * 16 + 4 * i);
            float s = (t[0] + t[1]) + (t[2] + t[3]); s += __shfl_xor(s, 1);
            if (hf == 0) scr[rr] = __builtin_amdgcn_rsqf(s * (1.0f / 2048.0f) + 1e-6f);
            asm volatile("s_waitcnt lgkmcnt(0)" ::: "memory"); __builtin_amdgcn_s_barrier(); asm volatile("" ::: "memory");
        }
        f32x4 bv[2][2];
#pragma unroll
        for (int bj = 0; bj < 2; ++bj) { bv[bj][0] = *(const f32x4*)(bias + col0 + bj * HALF); bv[bj][1] = *(const f32x4*)(bias + col0 + bj * HALF + 4); }
#pragma unroll
        for (int ai = 0; ai < 2; ++ai)
#pragma unroll
            for (int mp = 0; mp < 2; ++mp) {
                u32x4 wp[2][2]; f32x4 xo[2][2][2];
#pragma unroll
                for (int mm = 0; mm < 2; ++mm) { const size_t off = (size_t)(row0 + ai * HALF + (2 * mp + mm) * 16) * 2048 + col0;
#pragma unroll
                    for (int bj = 0; bj < 2; ++bj) { wp[mm][bj] = *(const u32x4*)(PL + off + bj * HALF); xo[mm][bj][0] = *(const f32x4*)(OUT + off + bj * HALF); xo[mm][bj][1] = *(const f32x4*)(OUT + off + bj * HALF + 4); } }
                asm volatile("" ::: "memory");
#pragma unroll
                for (int mm = 0; mm < 2; ++mm) { const int m = 2 * mp + mm; const size_t off = (size_t)(row0 + ai * HALF + m * 16) * 2048 + col0;
                    const float rstd = scr[ai * HALF + wr * 64 + m * 16 + fr];
#pragma unroll
                    for (int bj = 0; bj < 2; ++bj) {
                        f32x4 p0, p1; unpack8bf(wp[mm][bj], p0, p1);
                        f32x4 x0 = xo[mm][bj][0], x1 = xo[mm][bj][1];
                        const f32x4 z0 = acc[ai][bj][m][0] * rstd + bv[bj][0], z1 = acc[ai][bj][m][1] * rstd + bv[bj][1];
#pragma unroll
                        for (int j = 0; j < 4; ++j) { x0[j] += p0[j] * sigmoidf_(z0[j]); x1[j] += p1[j] * sigmoidf_(z1[j]); }
                        st16f(OUT + off + bj * HALF, x0); st16f(OUT + off + bj * HALF + 4, x1);
                    } }
                asm volatile("" ::: "memory");
            }
    }
};
template <class Epi, class Sched, bool ALIGN_EPI = false, bool SP2 = false>
__device__ __forceinline__ void gemm_phase(PG8_LAS unsigned char* lds, const Gemm g, const Sched& S, const Epi& E) {
    int tid_ = threadIdx.x; asm volatile("" : "+v"(tid_)); const int tid = tid_, wid = __builtin_amdgcn_readfirstlane(tid >> 6), lane = tid & 63, wr = wid >> 2, wc = wid & 3, fr = lane & 15, fq = lane >> 4;
    const int K = g.K, nt = K / BK;
    unsigned voffA[2], voffB[2];
#pragma unroll
    for (int i = 0; i < 2; ++i) { int R, C; stage_rc(tid * 16 + i * 8192, R, C); const int Rb = Epi::PERM ? ((R & ~31) + perm32(R & 31)) : R;
        voffA[i] = (unsigned)(R * K + C) * 2u; voffB[i] = (unsigned)(Rb * K + C) * 2u; }
    const size_t kstep = (size_t)(BK * 2);
    const size_t hstep = (size_t)HALF * K * 2;
    const size_t tstep = 2 * hstep;
    const unsigned ldsw = (unsigned)wid * 1024u;
    const int aoff = lds_byte(wr * 64 + fr, fq * 8), boff = lds_byte(wc * 32 + fr, fq * 8);
#define PG8_SA(b, h) (((b) * 2 + (h)) * HTB)
#define PG8_SB(b, h) ((4 + (b) * 2 + (h)) * HTB)
#define PG8_STAGE(bufoff, gbase, voff) do { _Pragma("unroll") for (int _i = 0; _i < 2; ++_i) \
        __builtin_amdgcn_global_load_lds((const unsigned*)((const char*)(gbase) + (voff)[_i]), (PG8_LAS unsigned*)(lds + (bufoff) + ldsw + _i * 8192), 16, 0, 0); } while (0)
#define PG8_LDA(dst, b, h) do { _Pragma("unroll") for (int m = 0; m < 4; ++m) _Pragma("unroll") for (int k = 0; k < 2; ++k) dst[m][k] = *(const PG8_LAS bf16x8*)(lds + PG8_SA(b, h) + aoff + m * 2048 + k * 1024); } while (0)
#define PG8_LDB(dst, b, h) do { _Pragma("unroll") for (int n = 0; n < 2; ++n) _Pragma("unroll") for (int k = 0; k < 2; ++k) dst[n][k] = *(const PG8_LAS bf16x8*)(lds + PG8_SB(b, h) + boff + n * 2048 + k * 1024); } while (0)
#define PG8_MMA(ai, bj, At, Bt) do { __builtin_amdgcn_s_setprio(1); _Pragma("unroll") for (int m = 0; m < 4; ++m) _Pragma("unroll") for (int n = 0; n < 2; ++n) _Pragma("unroll") for (int k = 0; k < 2; ++k) \
        acc[ai][bj][m][n] = __builtin_amdgcn_mfma_f32_16x16x32_bf16(Bt[n][k], At[m][k], acc[ai][bj][m][n], 0, 0, 0); __builtin_amdgcn_s_setprio(0); } while (0)
#define PG8_WAIT_V(n) asm volatile("s_waitcnt vmcnt(" #n ")" ::: "memory")
#define PG8_WAIT_L(n) asm volatile("s_waitcnt lgkmcnt(" #n ")" ::: "memory")
#define PG8_BAR __builtin_amdgcn_s_barrier()
#define PG8_SCHED __builtin_amdgcn_sched_barrier(0)
    Unit cur, nxt; int ui = 0;
    if (!S.next(0, cur)) return;
    f32x4 acc[2][2][4][2];
#pragma unroll
    for (int a = 0; a < 2; ++a)
#pragma unroll
        for (int b = 0; b < 2; ++b)
#pragma unroll
            for (int m = 0; m < 4; ++m)
#pragma unroll
                for (int n = 0; n < 2; ++n) acc[a][b][m][n] = (f32x4){0.f, 0.f, 0.f, 0.f};
    bf16x8 At[4][2], B0[2][2], B1[2][2];
    const char* cA = (const char*)g.A + (size_t)cur.pm * tstep; const char* cB = (const char*)g.Bt + (size_t)cur.pn * tstep;
    S.a_ready(cur);
    if constexpr (SP2) {
        PG8_STAGE(PG8_SB(0, 0), cB, voffB); PG8_STAGE(PG8_SB(0, 1), cB + hstep, voffB); PG8_STAGE(PG8_SA(0, 0), cA, voffA); PG8_STAGE(PG8_SA(0, 1), cA + hstep, voffA);
        if (wr == 1) PG8_BAR;
        PG8_WAIT_V(2); PG8_BAR;
        PG8_STAGE(PG8_SB(1, 0), cB + kstep, voffB); PG8_STAGE(PG8_SA(1, 0), cA + kstep, voffA); PG8_STAGE(PG8_SB(1, 1), cB + hstep + kstep, voffB);
        PG8_WAIT_V(6); PG8_BAR;
    } else {
        PG8_STAGE(PG8_SB(0, 0), cB, voffB); PG8_STAGE(PG8_SA(0, 0), cA, voffA); PG8_STAGE(PG8_SB(0, 1), cB + hstep, voffB); PG8_STAGE(PG8_SA(0, 1), cA + hstep, voffA);
        if (wr == 1) PG8_BAR;
        PG8_WAIT_V(4); PG8_BAR;
        PG8_STAGE(PG8_SB(1, 0), cB + kstep, voffB); PG8_STAGE(PG8_SA(1, 0), cA + kstep, voffA); PG8_STAGE(PG8_SB(1, 1), cB + hstep + kstep, voffB);
        PG8_WAIT_V(6); PG8_BAR;
    }
    for (;;) {
        const bool has_next = S.next(ui + 1, nxt);
        const char* nA = has_next ? (const char*)g.A + (size_t)nxt.pm * tstep : cA; const char* nB = has_next ? (const char*)g.Bt + (size_t)nxt.pn * tstep : cB;
        for (int t = 0; t < nt; t += 2) {
            const bool last = (t == nt - 2);
            if constexpr (Epi::HOOK) { if (t == E.hook_t) E.mid(acc, cur, wr, wc, fr, fq); }
            const char* a1 = cA + (size_t)(t + 1) * kstep;
            const char* a2 = last ? nA : cA + (size_t)(t + 2) * kstep; const char* b2 = last ? nB : cB + (size_t)(t + 2) * kstep;
            const char* a3 = a2 + kstep; const char* b3 = b2 + kstep;
            if (last && has_next) S.a_ready(nxt);
            if constexpr (SP2) {
            PG8_LDB(B0, 0, 0); PG8_LDB(B1, 0, 1); PG8_SCHED; PG8_LDA(At, 0, 0); PG8_STAGE(PG8_SA(1, 1), a1 + hstep, voffA);
            PG8_WAIT_V(8); PG8_WAIT_L(0); PG8_BAR; PG8_MMA(0, 0, At, B0); PG8_MMA(0, 1, At, B1); PG8_BAR; PG8_SCHED;
            PG8_LDA(At, 0, 1); PG8_STAGE(PG8_SB(0, 0), b2, voffB); PG8_STAGE(PG8_SB(0, 1), b2 + hstep, voffB); PG8_STAGE(PG8_SA(0, 0), a2, voffA);
            PG8_WAIT_V(8); PG8_WAIT_L(0); PG8_BAR; PG8_MMA(1, 0, At, B0); PG8_MMA(1, 1, At, B1); PG8_BAR; PG8_SCHED;
            PG8_LDB(B0, 1, 0); PG8_LDB(B1, 1, 1); PG8_SCHED; PG8_LDA(At, 1, 0); PG8_STAGE(PG8_SA(0, 1), a2 + hstep, voffA);
            PG8_WAIT_V(8); PG8_WAIT_L(0); PG8_BAR; PG8_MMA(0, 0, At, B0); PG8_MMA(0, 1, At, B1); PG8_BAR; PG8_SCHED;
            PG8_LDA(At, 1, 1); PG8_STAGE(PG8_SB(1, 0), b3, voffB); PG8_STAGE(PG8_SB(1, 1), b3 + hstep, voffB); PG8_STAGE(PG8_SA(1, 0), a3, voffA);
            PG8_WAIT_V(8); PG8_WAIT_L(0); PG8_BAR; PG8_MMA(1, 0, At, B0); PG8_MMA(1, 1, At, B1); PG8_BAR; PG8_SCHED;
            } else {
            PG8_LDB(B0, 0, 0); PG8_SCHED; PG8_LDA(At, 0, 0); PG8_STAGE(PG8_SA(1, 1), a1 + hstep, voffA);
            PG8_WAIT_L(8); PG8_BAR; PG8_WAIT_L(0); PG8_MMA(0, 0, At, B0); PG8_BAR; PG8_SCHED;
            PG8_LDB(B1, 0, 1); PG8_STAGE(PG8_SB(0, 0), b2, voffB);
            PG8_BAR; PG8_WAIT_L(0); PG8_MMA(0, 1, At, B1); PG8_BAR;
            PG8_LDA(At, 0, 1); PG8_STAGE(PG8_SA(0, 0), a2, voffA);
            PG8_BAR; PG8_WAIT_L(0); PG8_MMA(1, 0, At, B0); PG8_BAR; PG8_SCHED;
            PG8_STAGE(PG8_SB(0, 1), b2 + hstep, voffB);
            PG8_WAIT_V(6); PG8_BAR; PG8_MMA(1, 1, At, B1); PG8_BAR;
            PG8_LDB(B0, 1, 0); PG8_SCHED; PG8_LDA(At, 1, 0); PG8_STAGE(PG8_SA(0, 1), a2 + hstep, voffA);
            PG8_WAIT_L(8); PG8_BAR; PG8_WAIT_L(0); PG8_MMA(0, 0, At, B0); PG8_BAR; PG8_SCHED;
            PG8_LDB(B1, 1, 1); PG8_STAGE(PG8_SB(1, 0), b3, voffB);
            PG8_BAR; PG8_WAIT_L(0); PG8_MMA(0, 1, At, B1); PG8_BAR;
            PG8_LDA(At, 1, 1); PG8_STAGE(PG8_SA(1, 0), a3, voffA);
            PG8_BAR; PG8_WAIT_L(0); PG8_MMA(1, 0, At, B0); PG8_BAR; PG8_SCHED;
            PG8_STAGE(PG8_SB(1, 1), b3 + hstep, voffB);
            PG8_WAIT_V(6); PG8_BAR; PG8_MMA(1, 1, At, B1); PG8_BAR;
            }
        }
        if constexpr (ALIGN_EPI) { if (wr == 0) PG8_BAR; }
        if constexpr (!Epi::AFTER_DRAIN) { E(acc, cur, wr, wc, fr, fq); S.done(cur); }
        if (!has_next) break;
#pragma unroll
        for (int a = 0; a < 2; ++a)
#pragma unroll
            for (int b = 0; b < 2; ++b)
#pragma unroll
                for (int m = 0; m < 4; ++m)
#pragma unroll
                    for (int n = 0; n < 2; ++n) acc[a][b][m][n] = (f32x4){0.f, 0.f, 0.f, 0.f};
        cur = nxt; cA = nA; cB = nB; ++ui;
        if constexpr (ALIGN_EPI) { if (wr == 1) PG8_BAR; }
    }
    PG8_WAIT_V(0);
    if constexpr (!ALIGN_EPI) { if (wr == 0) PG8_BAR; }
    PG8_BAR;
#undef PG8_SA
#undef PG8_SB
#undef PG8_STAGE
#undef PG8_LDA
#undef PG8_LDB
#undef PG8_MMA
#undef PG8_WAIT_V
#undef PG8_WAIT_L
#undef PG8_BAR
#undef PG8_SCHED
}
}

namespace attn {
constexpr int D = 128;
constexpr float THR = 8.f;
constexpr bool WSKIP = false;
constexpr float SCALE = 0.08838834764831845f;
constexpr int NW = 8, QBLK = 32, KVBLK = 64, QB = NW * QBLK;
constexpr int SHM_V = KVBLK * D * 2, SHM_K = KVBLK * D * 2;
constexpr int LDS_BYTES = 2 * SHM_V + 2 * SHM_K + NW * 64 * 4;
constexpr int KM_OFF = 69632;
constexpr int LDO = 2048, LDG = 1024, STG_OFF = 73728;
#ifndef MOBA_ON
#define MOBA_ON 1
#endif
#ifndef GA_ON
#define GA_ON 1
#endif
using bf16 = __hip_bfloat16;
typedef short bf16x8 __attribute__((ext_vector_type(8)));
typedef short s16x4 __attribute__((ext_vector_type(4)));
typedef float f32x16 __attribute__((ext_vector_type(16)));
typedef float f32x4 __attribute__((ext_vector_type(4)));
typedef unsigned u32x4 __attribute__((ext_vector_type(4)));
template <class A, class Bt> struct same_t { static constexpr bool v = false; };
template <class A> struct same_t<A, A> { static constexpr bool v = true; };

#define KSWZ(row, colB) ((row) * 256 + ((colB) ^ (((row) & 7) << 4)))
#define SBAR() __builtin_amdgcn_sched_barrier(0)
__device__ __forceinline__ int v_st(int k, int c) { const int kk = (k & ~0xC) | ((k & 4) << 1) | ((k & 8) >> 1); return ((kk >> 3) * 4 + (c >> 5)) * 512 + ((kk & 7) * 32 + (c & 31)) * 2; }
__device__ __forceinline__ int v_rd_base(int lane) { return ((lane & 3) << 3) | (((lane >> 2) & 3) << 6) | (((lane >> 4) & 1) << 5) | (((lane >> 5) & 1) << 8); }
constexpr int v_rd_off(int d0, int ks, int half) { return d0 * 512 + ks * 4096 + half * 2048; }
__device__ __forceinline__ int crow(int r, int hi) { return (r & 3) + 8 * (r >> 2) + 4 * hi; }
__device__ __forceinline__ unsigned cvtpk(float lo, float hi) {
    unsigned r; asm volatile("v_cvt_pk_bf16_f32 %0, %1, %2" : "=v"(r) : "v"(lo), "v"(hi)); return r;
}
__device__ __forceinline__ bf16x8 pack8(f32x4 a, f32x4 b) {
    u32x4 w = {cvtpk(a[0], a[1]), cvtpk(a[2], a[3]), cvtpk(b[0], b[1]), cvtpk(b[2], b[3])};
    return *reinterpret_cast<bf16x8*>(&w);
}
template <class T> __device__ __forceinline__ bf16x8 load8(const T* p) {
    if constexpr (same_t<T, float>::v) { return pack8(*(const f32x4*)p, *(const f32x4*)(p + 4)); }
    else { return *reinterpret_cast<const bf16x8*>(p); }
}
__device__ __forceinline__ void mask_tile(f32x16& p0, f32x16& p1, int dq, unsigned W) {
    const float NEG = -__builtin_inff();
#pragma unroll
    for (int r = 0; r < 16; ++r) {
        const int c = (r & 3) + 8 * (r >> 2);
        if ((unsigned)(dq - c) >= W) p0[r] = NEG;
        if ((unsigned)(dq - c - 32) >= W) p1[r] = NEG;
    }
}
__device__ __forceinline__ void partialSM(bool dead, f32x16& p0, f32x16& p1, float& m_reg, float& mn, float& alpha) {
    float pmax = p0[0]; for (int r = 1; r < 16; ++r) pmax = fmaxf(pmax, p0[r]); for (int r = 0; r < 16; ++r) pmax = fmaxf(pmax, p1[r]);
    { auto rr = __builtin_amdgcn_permlane32_swap(__float_as_uint(pmax), __float_as_uint(pmax), false, false);
      pmax = fmaxf(__uint_as_float(rr[0]), __uint_as_float(rr[1])); }
    pmax = dead ? -__builtin_inff() : pmax;
    constexpr float C2 = 1.4426950408889634f * SCALE;
    if (__builtin_expect(__all((pmax - m_reg) * SCALE <= THR), 1)) { mn = m_reg; alpha = 1.f; }
    else { mn = fmaxf(m_reg, pmax); alpha = __builtin_amdgcn_exp2f((m_reg - mn) * C2); m_reg = mn; }
    const float mnL = dead ? -__builtin_inff() : -mn * C2;
    for (int r = 0; r < 16; ++r) p0[r] = fmaf(p0[r], C2, mnL); for (int r = 0; r < 16; ++r) p1[r] = fmaf(p1[r], C2, mnL);
    for (int r = 0; r < 16; ++r) p0[r] = __builtin_amdgcn_exp2f(p0[r]);
}
__device__ __forceinline__ void finishSM(f32x16& p0, f32x16& p1, float alpha, float& l_reg, bf16x8& pa0, bf16x8& pa1, bf16x8& pa2, bf16x8& pa3) {
    for (int r = 0; r < 16; ++r) p1[r] = __builtin_amdgcn_exp2f(p1[r]);
    float ps = 0; for (int r = 0; r < 16; ++r) ps += p0[r]; for (int r = 0; r < 16; ++r) ps += p1[r];
    { auto rr = __builtin_amdgcn_permlane32_swap(__float_as_uint(ps), __float_as_uint(ps), false, false);
      ps = __uint_as_float(rr[0]) + __uint_as_float(rr[1]); }
    l_reg = l_reg * alpha + ps;
#define PK4(P, B_, OUT) do { unsigned a0 = cvtpk(P[B_+0], P[B_+1]), a1 = cvtpk(P[B_+2], P[B_+3]);                          \
        unsigned b0 = cvtpk(P[B_+4], P[B_+5]), b1 = cvtpk(P[B_+6], P[B_+7]);                                             \
        auto r0 = __builtin_amdgcn_permlane32_swap(a0, b0, false, false); auto r1 = __builtin_amdgcn_permlane32_swap(a1, b1, false, false); \
        u32x4 w = {r0[0], r1[0], r0[1], r1[1]}; OUT = *reinterpret_cast<bf16x8*>(&w); } while (0)
    PK4(p0, 0, pa0); PK4(p0, 8, pa1); PK4(p1, 0, pa2); PK4(p1, 8, pa3);
#undef PK4
}
template <int KB, bool SK>
__device__ __forceinline__ void qkt(f32x16& p0, f32x16& p1, const char* K_lds, int r32, int hi, const bf16x8* qr, bool act) {
    if (SK && !act) { const float NEG = -__builtin_inff();
#pragma unroll
        for (int r = 0; r < 16; ++r) { p0[r] = NEG; p1[r] = NEG; } return; }
    p0 = f32x16{}; p1 = f32x16{};
    const char* kb[4];
#pragma unroll
    for (int dd = 0; dd < 4; ++dd) kb[dd] = K_lds + KB * SHM_K + KSWZ(r32, (dd * 16 + hi * 8) * 2);
#pragma unroll
    for (int d0 = 0; d0 < 8; ++d0) { const char* a = kb[d0 & 3] + (d0 >> 2) * 128;
        bf16x8 b0 = *reinterpret_cast<const bf16x8*>(a);
        bf16x8 b1 = *reinterpret_cast<const bf16x8*>(a + 32 * 256);
        p0 = __builtin_amdgcn_mfma_f32_32x32x16_bf16(b0, qr[d0], p0, 0, 0, 0);
        p1 = __builtin_amdgcn_mfma_f32_32x32x16_bf16(b1, qr[d0], p1, 0, 0, 0); }
}
template <int VB, bool SK>
__device__ __forceinline__ void pv_tile(f32x16* o, int vb0, bf16x8 pa0, bf16x8 pa1, bf16x8 pa2, bf16x8 pa3, bool act) {
    if (SK && !act) return;
#define TRRD(dst, off) asm volatile("ds_read_b64_tr_b16 %0, %1 offset:%2" : "=&v"(dst) : "v"(vb0), "i"(off) : "memory")
#define PV_D0(d0) do { s16x4 l0, l1, l2, l3, h0, h1, h2, h3; constexpr int b_ = VB * SHM_V + v_rd_off(d0, 0, 0);     \
        TRRD(l0, b_); TRRD(h0, b_ + 2048); TRRD(l1, b_ + 4096); TRRD(h1, b_ + 6144); TRRD(l2, b_ + 8192); TRRD(h2, b_ + 10240); TRRD(l3, b_ + 12288); TRRD(h3, b_ + 14336); \
        asm volatile("s_waitcnt lgkmcnt(0)" ::: "memory"); SBAR();                 \
        o[d0] = __builtin_amdgcn_mfma_f32_32x32x16_bf16(pa0, (bf16x8){l0[0], l0[1], l0[2], l0[3], h0[0], h0[1], h0[2], h0[3]}, o[d0], 0, 0, 0);   \
        o[d0] = __builtin_amdgcn_mfma_f32_32x32x16_bf16(pa1, (bf16x8){l1[0], l1[1], l1[2], l1[3], h1[0], h1[1], h1[2], h1[3]}, o[d0], 0, 0, 0);   \
        o[d0] = __builtin_amdgcn_mfma_f32_32x32x16_bf16(pa2, (bf16x8){l2[0], l2[1], l2[2], l2[3], h2[0], h2[1], h2[2], h2[3]}, o[d0], 0, 0, 0);   \
        o[d0] = __builtin_amdgcn_mfma_f32_32x32x16_bf16(pa3, (bf16x8){l3[0], l3[1], l3[2], l3[3], h3[0], h3[1], h3[2], h3[3]}, o[d0], 0, 0, 0); } while (0)
    PV_D0(0); PV_D0(1); PV_D0(2); PV_D0(3);
#undef PV_D0
#undef TRRD
}

template <class TIn, class TOut> struct BlockRef { const TIn* Q; const TIn* K; const TIn* V; TOut* O; int P0; const unsigned short* GA; const float* KM; int qb; };
template <class TIn> struct Seam {
    bf16x8 qr[8];
    bf16x8 st_v0, st_v1, st_k0, st_k1; f32x4 sf0, sf1, sf2, sf3;
    f32x4 tq[16];
};
__device__ __forceinline__ int swa_jlo(int P0, int W) { const int lowk = P0 - W + 1; return lowk > 0 ? lowk / KVBLK : 0; }
#define ROW(p, k0, rr) ((p) + (size_t)((k0) + (rr)) * D + sc)
#define VMW() asm volatile("s_waitcnt vmcnt(0)" ::: "memory")
#define VMWN(n) asm volatile("s_waitcnt vmcnt(%0)" :: "i"(n) : "memory")
#define SLOAD_H(Kp, Vp, k0) do { S.st_v0 = load8<TIn>(ROW(Vp, k0, sr)); S.st_v1 = load8<TIn>(ROW(Vp, k0, 32 + sr));              \
                         S.st_k0 = load8<TIn>(ROW(Kp, k0, sr)); S.st_k1 = load8<TIn>(ROW(Kp, k0, 32 + sr)); } while (0)
#define SWRITE_HK(bf) do { *(bf16x8*)(K_lds + (bf) * SHM_K + kws) = S.st_k0; *(bf16x8*)(K_lds + (bf) * SHM_K + kws + 32 * 256) = S.st_k1; } while (0)
#define SWRITE_HV(bf) do { *(bf16x8*)(V_lds + (bf) * SHM_V + vst0) = S.st_v0; *(bf16x8*)(V_lds + (bf) * SHM_V + vst1) = S.st_v1; } while (0)
#define SWRITE_H(bf) do { SWRITE_HV(bf); SWRITE_HK(bf); } while (0)
#define SLOAD_F(p, k0) do { S.sf0 = *(const f32x4*)ROW(p, k0, sr); S.sf1 = *(const f32x4*)(ROW(p, k0, sr) + 4);                \
                            S.sf2 = *(const f32x4*)ROW(p, k0, 32 + sr); S.sf3 = *(const f32x4*)(ROW(p, k0, 32 + sr) + 4); } while (0)
#define SWRITE_KF(bf) do { *(bf16x8*)(K_lds + (bf) * SHM_K + kws) = pack8(S.sf0, S.sf1); *(bf16x8*)(K_lds + (bf) * SHM_K + kws + 32 * 256) = pack8(S.sf2, S.sf3); } while (0)
#define SWRITE_VF(bf) do { *(bf16x8*)(V_lds + (bf) * SHM_V + vst0) = pack8(S.sf0, S.sf1); *(bf16x8*)(V_lds + (bf) * SHM_V + vst1) = pack8(S.sf2, S.sf3); } while (0)
template <class TIn, class TOut>
__device__ __forceinline__ void causal_swa_prime(const BlockRef<TIn, TOut>& cur, int W, char* lds, Seam<TIn>& S) {
    constexpr bool F32 = same_t<TIn, float>::v;
    int tid_ = threadIdx.x; asm volatile("" : "+v"(tid_)); const int tid = tid_, wid = __builtin_amdgcn_readfirstlane(tid >> 6), lane = tid & 63, r32 = lane & 31, hi = lane >> 5;
    const int sr = tid >> 4, sc = (tid & 15) * 8, kws = KSWZ(sr, sc * 2); char* K_lds = lds + 2 * SHM_V;
    const int kb0 = swa_jlo(cur.P0, W) * KVBLK;
    for (int d0 = 0; d0 < 8; ++d0) S.qr[d0] = load8<TIn>(cur.Q + (size_t)(wid * QBLK + r32) * D + d0 * 16 + hi * 8);
    if constexpr (F32) { SLOAD_F((const float*)cur.K, kb0); VMW(); SWRITE_KF(0); SBAR(); SLOAD_F((const float*)cur.V, kb0); }
    else { SLOAD_H(cur.K, cur.V, kb0); VMW(); SWRITE_HK(0); }
    __syncthreads();
}
template <class TIn, class TOut>
__device__ __forceinline__ void causal_swa_block(const BlockRef<TIn, TOut>& cur, const BlockRef<TIn, TOut>& nxt, int skv, int W, char* lds, Seam<TIn>& S) {
    constexpr bool F32 = same_t<TIn, float>::v;
    int tid_ = threadIdx.x; asm volatile("" : "+v"(tid_)); const int tid = tid_, wid = __builtin_amdgcn_readfirstlane(tid >> 6), lane = tid & 63, r32 = lane & 31, hi = lane >> 5;
    const int j_lo = swa_jlo(cur.P0, W);
    int j_hi = (cur.P0 + QB - 1) / KVBLK + 1; if (j_hi > skv / KVBLK) j_hi = skv / KVBLK;
    const int NT = j_hi - j_lo;
    const int kbn = swa_jlo(nxt.P0, W) * KVBLK;
    const int qlo = cur.P0 + wid * QBLK, qm = qlo + r32 - 4 * hi;
    char* V_lds = lds; char* K_lds = lds + 2 * SHM_V;
    float* ws = (float*)(lds + 2 * SHM_V + 2 * SHM_K) + wid * 64; float* li_l = ws, * al_l = ws + 32;
    float m_reg = -1e30f, l_reg = 0; f32x16 o[4] = {};
    const int sr = tid >> 4, sc = (tid & 15) * 8, vst0 = v_st(sr, sc), vst1 = v_st(32 + sr, sc), kws = KSWZ(sr, sc * 2);
    const int vb0 = (int)(uintptr_t)V_lds + v_rd_base(lane);
    const TIn* Kh = cur.K; const TIn* Vh = cur.V;
    unsigned pf0_ = 0u, pf1_ = 0u;
#define PREF(t, PF) do { asm volatile("" :: "v"(PF)); int tp_ = (t) + 2 + (wid >> 2); tp_ = tp_ < NT ? tp_ : NT - 1; \
        const char* pp_ = (const char*)((wid & 2) ? (const void*)Vh : (const void*)Kh) + (size_t)KBASE(tp_) * (D * 2) + (wid & 1) * 8192 + lane * 128; \
        PF = *(const __attribute__((address_space(1))) unsigned*)(unsigned long long)pp_; } while (0)
    unsigned selmask = 0xffu; const bool moba = cur.qb >= 4; bool mdead = false;
    {
        float* kml = (float*)(lds + KM_OFF);
        { float kv_[2];
#pragma unroll
          for (int i_ = 0; i_ < 2; ++i_) { const int idx = tid + i_ * 64 * NW, n_ = idx >> 7, d_ = idx & 127; kv_[i_] = (cur.KM[(size_t)n_ * 2048 + d_] + cur.KM[(size_t)n_ * 2048 + 1024 + d_]) * (1.0f / 256.0f); }
#pragma unroll
          for (int i_ = 0; i_ < 2; ++i_) ((__attribute__((address_space(3))) float*)kml)[tid + i_ * 64 * NW] = kv_[i_]; }
        __syncthreads();
        if (moba) {
            float g[7];
#pragma unroll
            for (int n_ = 0; n_ < 7; ++n_) { float s = 0.f;
                if (n_ < cur.qb) {
#pragma unroll
                    for (int d0 = 0; d0 < 8; ++d0) { const f32x4 k0 = *(const f32x4*)(kml + n_ * 128 + d0 * 16 + hi * 8), k1 = *(const f32x4*)(kml + n_ * 128 + d0 * 16 + hi * 8 + 4);
                        const bf16x8 qv = S.qr[d0];
#define B2F_(x) __uint_as_float(((unsigned)(unsigned short)(x)) << 16)
                        s += (B2F_(qv[0]) * k0[0] + B2F_(qv[1]) * k0[1]) + (B2F_(qv[2]) * k0[2] + B2F_(qv[3]) * k0[3]) + (B2F_(qv[4]) * k1[0] + B2F_(qv[5]) * k1[1]) + (B2F_(qv[6]) * k1[2] + B2F_(qv[7]) * k1[3]);
#undef B2F_
                    } }
                g[n_] = s + __shfl_xor(s, 32); }
            selmask = 0u;
#pragma unroll
            for (int rd = 0; rd < 3; ++rd) { float best = -__builtin_inff(); unsigned bi = 0u;
#pragma unroll
                for (int n_ = 0; n_ < 7; ++n_) { const bool ok = (n_ < cur.qb) && (((selmask >> n_) & 1u) == 0u) && (g[n_] > best); best = ok ? g[n_] : best; bi = ok ? (unsigned)n_ : bi; }
                selmask |= 1u << bi; }
        }
    }
#define RESC(a) do { if (__any((a) < 1.f)) { if (hi == 0) al_l[r32] = (a); asm volatile("s_waitcnt lgkmcnt(0)" ::: "memory");              \
                     for (int d_ = 0; d_ < 4; ++d_) for (int r = 0; r < 16; ++r) o[d_][r] *= al_l[crow(r, hi)]; } } while (0)
#define KBASE(t) ((j_lo + (t)) * KVBLK)
#define ACT(t) (KBASE(t) <= qlo + QBLK - 1 && KBASE(t) + KVBLK - 1 >= qlo - W + 1)
#define MASKT(P0_, P1_, t) do { const int kb_ = KBASE(t); if ((!SK || ACT(t)) && (kb_ + KVBLK - 1 > qlo || kb_ <= qlo + QBLK - 1 - W)) mask_tile(P0_, P1_, qm - kb_, (unsigned)W); \
        mdead = (MOBA_ON && moba && kb_ < cur.P0) ? (((selmask >> (kb_ >> 8)) & 1u) == 0u) : false; } while (0)
    constexpr int NQL = F32 ? 16 : 8;
    constexpr bool SK = WSKIP && !F32;
#define SEAM_K0() do { VMWN(NQL); if constexpr (F32) { SWRITE_KF(0); SBAR(); SLOAD_F((const float*)nxt.V, kbn); } else { SWRITE_HK(0); } SBAR(); } while (0)
    f32x16 pA0, pA1, pB0, pB1; float mnA, mnB, alA, alB; bf16x8 pa0, pa1, pa2, pa3;
    if constexpr (F32) { VMW(); SWRITE_VF(0); SBAR(); } else { SWRITE_HV(0); SBAR(); }
    if (NT > 1) { if constexpr (F32) SLOAD_F((const float*)Kh, KBASE(1)); else SLOAD_H(Kh, Vh, KBASE(1)); }
    SBAR(); qkt<0, SK>(pA0, pA1, K_lds, r32, hi, S.qr, ACT(0));
    if constexpr (F32) { if (NT > 1) { VMW(); SWRITE_KF(1); SBAR(); SLOAD_F((const float*)Vh, KBASE(1)); } }
    MASKT(pA0, pA1, 0); partialSM(mdead, pA0, pA1, m_reg, mnA, alA);
    if (NT > 1) { VMW(); if constexpr (F32) { SWRITE_VF(1); SBAR(); if (NT > 2) SLOAD_F((const float*)Kh, KBASE(2)); } else SWRITE_H(1); }
    __syncthreads();
#define HALF_STEP(PX0, PX1, mnX, alX, PY0, PY1, alY, t, KB, VB, SB) do {                                                      \
        SBAR(); qkt<KB, SK>(PX0, PX1, K_lds, r32, hi, S.qr, ACT(t));                                             \
        finishSM(PY0, PY1, alY, l_reg, pa0, pa1, pa2, pa3); SBAR();                                                           \
        if ((t) + 1 < NT) { if constexpr (F32) { VMW(); SWRITE_KF(SB); SBAR(); SLOAD_F((const float*)Vh, KBASE((t) + 1)); }  \
                            else { SLOAD_H(Kh, Vh, KBASE((t) + 1)); SBAR(); if (SB) PREF(t, pf1_); else PREF(t, pf0_); } SBAR(); }                                               \
        pv_tile<VB, SK>(o, vb0, pa0, pa1, pa2, pa3, ACT((t) - 1)); MASKT(PX0, PX1, (t)); partialSM(mdead, PX0, PX1, m_reg, mnX, alX);                                        \
        __syncthreads();                                                                                                      \
        if ((t) + 1 < NT) { if constexpr (F32) VMW(); else VMWN(1); if constexpr (F32) { SWRITE_VF(SB); SBAR(); if ((t) + 2 < NT) SLOAD_F((const float*)Kh, KBASE((t) + 2)); } \
                            else { SWRITE_H(SB); } }                                                                          \
        RESC(alX); __syncthreads(); } while (0)
    for (int t = 1; t + 1 < NT; t += 2) {
        HALF_STEP(pB0, pB1, mnB, alB, pA0, pA1, alA, t, 1, 0, 0);
        HALF_STEP(pA0, pA1, mnA, alA, pB0, pB1, alB, t + 1, 0, 1, 1);
    }
    const bool even = (NT & 1) == 0;
    if (even) { SBAR(); qkt<1, SK>(pB0, pB1, K_lds, r32, hi, S.qr, ACT(NT - 1)); SBAR(); }
#define QROW(e) (nxt.Q + (size_t)(wid * QBLK + r32) * D + ((e) >> 1) * 16 + hi * 8 + ((e) & 1) * 4)
    if constexpr (F32) { SLOAD_F((const float*)nxt.K, kbn); SBAR();
#pragma unroll
        for (int e = 0; e < 8; ++e) S.tq[e] = *(const f32x4*)QROW(e); }
    else { SLOAD_H(nxt.K, nxt.V, kbn); SBAR();
#pragma unroll
        for (int d0 = 0; d0 < 8; ++d0) S.qr[d0] = load8<TIn>(nxt.Q + (size_t)(wid * QBLK + r32) * D + d0 * 16 + hi * 8); }
    SBAR();
    finishSM(pA0, pA1, alA, l_reg, pa0, pa1, pa2, pa3); SBAR();
    if constexpr (F32) {
#pragma unroll
        for (int e = 8; e < 16; ++e) S.tq[e] = *(const f32x4*)QROW(e); SBAR(); }
#undef QROW
    pv_tile<0, SK>(o, vb0, pa0, pa1, pa2, pa3, ACT(even ? NT - 2 : NT - 1));
    if (even) { MASKT(pB0, pB1, NT - 1); partialSM(mdead, pB0, pB1, m_reg, mnB, alB); __syncthreads(); RESC(alB);
        finishSM(pB0, pB1, alB, l_reg, pa0, pa1, pa2, pa3); SBAR(); pv_tile<1, SK>(o, vb0, pa0, pa1, pa2, pa3, ACT(NT - 1)); }
    SBAR(); SEAM_K0();
    if (hi == 0) li_l[r32] = l_reg; asm volatile("s_waitcnt lgkmcnt(0)" ::: "memory");
    float rli[16];
#pragma unroll
    for (int r = 0; r < 16; ++r) rli[r] = __builtin_amdgcn_rcpf(li_l[crow(r, hi)]);
    { unsigned short* stg = (unsigned short*)(lds + STG_OFF) + wid * 4096;
      unsigned short* Ow = (unsigned short*)cur.O + (size_t)(wid * QBLK) * LDO; const unsigned short* Gw = cur.GA + (size_t)(wid * QBLK) * LDG;
      u32x4 gvv[8];
#pragma unroll
      for (int i = 0; i < 8; ++i) gvv[i] = *(const u32x4*)(Gw + (size_t)(i * 4 + (lane >> 4)) * LDG + (lane & 15) * 8);
#pragma unroll
      for (int r = 0; r < 16; ++r) { const int orow = crow(r, hi);
#pragma unroll
        for (int d0 = 0; d0 < 4; ++d0) { const float v = o[d0][r] * rli[r]; stg[orow * 128 + d0 * 32 + r32] = (unsigned short)(cvtpk(v, v) & 0xffffu); } }
      asm volatile("s_waitcnt lgkmcnt(0)" ::: "memory");
#pragma unroll
      for (int i = 0; i < 8; ++i) { const int row = i * 4 + (lane >> 4), ch = lane & 15;
          const u32x4 ov = *(const u32x4*)(stg + row * 128 + ch * 8); const u32x4 gv = gvv[i];
          u32x4 w;
#define MULPK_(a, b) cvtpk(__uint_as_float((a) << 16) * __uint_as_float((b) << 16), __uint_as_float((a) & 0xffff0000u) * __uint_as_float((b) & 0xffff0000u))
          w.x = MULPK_(ov.x, gv.x); w.y = MULPK_(ov.y, gv.y); w.z = MULPK_(ov.z, gv.z); w.w = MULPK_(ov.w, gv.w);
#undef MULPK_
          *(u32x4*)(Ow + (size_t)row * LDO + ch * 8) = w; } }
    if constexpr (F32) {
#pragma unroll
        for (int d0 = 0; d0 < 8; ++d0) S.qr[d0] = pack8(S.tq[2 * d0], S.tq[2 * d0 + 1]); }
    __syncthreads();
    asm volatile("" :: "v"(pf0_), "v"(pf1_));
#undef PREF
#undef RESC
#undef KBASE
#undef ACT
#undef MASKT
#undef SEAM_K0
#undef HALF_STEP
}
#undef ROW
#undef VMW
#undef VMWN
#undef SLOAD_H
#undef SWRITE_HK
#undef SWRITE_HV
#undef SWRITE_H
#undef SLOAD_F
#undef SWRITE_KF
#undef SWRITE_VF


typedef BlockRef<bf16, bf16> Ref;
__device__ __forceinline__ Ref make_ref(int L, const bf16* Q, const bf16* K, const bf16* V, bf16* Y, const bf16* GA, const float* KMP) {
    const int bh = L >> 3, qb = L & 7, b = bh >> 3, h = bh & 7; Ref r;
    r.Q = Q + ((size_t)bh * 2048 + (size_t)qb * QB) * D; r.K = K + (size_t)bh * 2048 * D; r.V = V + (size_t)bh * 2048 * D;
    r.O = Y + ((size_t)b * 2048 + (size_t)qb * QB) * LDO + h * 128; r.GA = (const unsigned short*)GA + ((size_t)b * 2048 + (size_t)qb * QB) * LDG + h * 128;
    r.P0 = qb * QB; r.KM = KMP + (size_t)b * 16 * 1024 + h * 128; r.qb = qb; return r;
}
__device__ __forceinline__ void phase(char* lds, const bf16* Q, const bf16* K, const bf16* V, bf16* Y, const bf16* GA, const float* KMP, int vcu, int G) {
    int L = vcu; if (L >= 256) return;
    Ref cur = make_ref(L, Q, K, V, Y, GA, KMP);
    Seam<bf16> S;
    causal_swa_prime<bf16, bf16>(cur, 2048, lds, S);
    for (;;) {
        const int Ln = L + G; const bool last = Ln >= 256;
        const Ref nxt = last ? cur : make_ref(Ln, Q, K, V, Y, GA, KMP);
        causal_swa_block<bf16, bf16>(cur, nxt, 2048, 2048, lds, S);
        if (last) break;
        cur = nxt; L = Ln;
    }
}
#undef KSWZ
#undef SBAR
}
#ifdef PROBE_TS
#ifndef PROBE_BLK
#define PROBE_BLK 0
#endif
#define LSTAMP(T, i) do { if (blockIdx.x == PROBE_BLK && threadIdx.x == 0) ((volatile unsigned long long*)((unsigned char*)(T).PUB - ((2u << 20) + (512u << 10)) + (600u << 10)))[i] = __builtin_amdgcn_s_memrealtime(); } while (0)
#else
#define LSTAMP(T, i) do { } while (0)
#endif
namespace lru {
#define LRU_LAS __attribute__((address_space(3)))
typedef short bf16x8 __attribute__((ext_vector_type(8)));
typedef float f32x4 __attribute__((ext_vector_type(4)));
typedef unsigned u32x4 __attribute__((ext_vector_type(4)));
typedef unsigned u32x2 __attribute__((ext_vector_type(2)));
constexpr int CH = 128  , XCP = 272  , LP = 36  ;
constexpr int OFF_XC = 0, OFF_WB = CH * XCP, OFF_A = OFF_WB + 256 * XCP, OFF_U = OFF_A + CH * LP * 4, OFF_SA = OFF_U + CH * LP * 4, OFF_SH = OFF_SA + 16 * 32 * 4, OFF_TA = OFF_SH + 16 * 32 * 4,
              OFF_TH = OFF_TA + 128 * 4, OFF_CR = OFF_TH + 128 * 4, OFF_CT = OFF_CR + 128 * 4, LRU_LDS = OFF_CT + 1024 * 4;
constexpr int CT_BR = 0, CT_BI = 128, CT_C8 = 256, CT_CW = 384, CT_CB = 896;
__device__ __forceinline__ float b2f(unsigned short x) { return __uint_as_float(((unsigned)x) << 16); }
__device__ __forceinline__ unsigned cvtpk(float lo, float hi) { unsigned r; asm volatile("v_cvt_pk_bf16_f32 %0, %1, %2" : "=v"(r) : "v"(lo), "v"(hi)); return r; }
struct Tensors { const unsigned short* XR; const unsigned short* GL; unsigned short* Y; unsigned short* Q1; const unsigned short* WrT; const unsigned short* WiT;
                 const float *cw, *cb, *br, *bi, *c8; float* PUB; unsigned* FLG; };
__device__ __forceinline__ int unit_tc(int q, int r) { const int base = (r == 0) ? 0 : (r == 1) ? 7 : (r == 2) ? 12 : 15, width = (r == 0) ? 7 : (r == 1) ? 5 : (r == 2) ? 3 : 1; return q < width ? base + q : -1; }

__device__ __forceinline__ void load_weights(LRU_LAS unsigned char* lds, const Tensors& T, int n) {
    const int tid = threadIdx.x;
#pragma unroll
    for (int i = 0; i < 8; ++i) { const int p = tid + 512 * i, o = p >> 4, c = p & 15;
        const unsigned short* src = (o < 128 ? T.WrT : T.WiT) + ((size_t)n * 128 + (o & 127)) * 128 + c * 8;
        *(LRU_LAS u32x4*)(lds + OFF_WB + o * XCP + c * 16) = *(const u32x4*)src; }
    if (tid < 128) { LRU_LAS float* CT = (LRU_LAS float*)(lds + OFF_CT); const int ch = n * 128 + tid;
        CT[CT_BR + tid] = T.br[ch]; CT[CT_BI + tid] = T.bi[ch]; CT[CT_C8 + tid] = T.c8[ch]; CT[CT_CB + tid] = T.cb[ch];
#pragma unroll
        for (int k = 0; k < 4; ++k) CT[CT_CW + k * 128 + tid] = T.cw[k * 1024 + ch]; }
    __syncthreads();
}

struct Raw { u32x4 w[4][4]; };
__device__ __forceinline__ void load_raw(const Tensors& T, int g, int tc, Raw& R) {
    const int tid = threadIdx.x, cg = tid & 15, trow = tid >> 4, b = g >> 3, n = g & 7; const int chb = n * 128 + cg * 8; const size_t rowb = (size_t)b * 2048;
#pragma unroll
    for (int i = 0; i < 4; ++i)
#pragma unroll
        for (int k = 0; k < 4; ++k) { const int tt = tc * CH + trow + 32 * i - 3 + k;
            R.w[i][k] = (u32x4){0u, 0u, 0u, 0u};
            if (tt >= 0) R.w[i][k] = *(const u32x4*)(T.XR + (rowb + tt) * 1024 + chb); }
}
__device__ __forceinline__ void conv_stage(LRU_LAS unsigned char* lds, const Tensors& T, int g, const Raw& R) {
    const int tid = threadIdx.x, cg = tid & 15, trow = tid >> 4, n = g & 7; const int chb = n * 128 + cg * 8;
    float cw[4][8], cb[8]; const LRU_LAS float* CT = (const LRU_LAS float*)(lds + OFF_CT);
#pragma unroll
    for (int k = 0; k < 4; ++k) { const f32x4 a = *(const LRU_LAS f32x4*)(CT + CT_CW + k * 128 + cg * 8), c = *(const LRU_LAS f32x4*)(CT + CT_CW + k * 128 + cg * 8 + 4);
#pragma unroll
        for (int j = 0; j < 4; ++j) { cw[k][j] = a[j]; cw[k][4 + j] = c[j]; } }
    { const f32x4 a = *(const LRU_LAS f32x4*)(CT + CT_CB + cg * 8), c = *(const LRU_LAS f32x4*)(CT + CT_CB + cg * 8 + 4);
#pragma unroll
      for (int j = 0; j < 4; ++j) { cb[j] = a[j]; cb[4 + j] = c[j]; } }
#pragma unroll
    for (int i = 0; i < 4; ++i) { const int tok = trow + 32 * i;
        float acc8[8];
#pragma unroll
        for (int j = 0; j < 8; ++j) acc8[j] = cb[j];
#pragma unroll
        for (int k = 0; k < 4; ++k) { const u32x4 w = R.w[i][k];
            acc8[0] += cw[k][0] * __uint_as_float(w.x << 16); acc8[1] += cw[k][1] * __uint_as_float(w.x & 0xffff0000u);
            acc8[2] += cw[k][2] * __uint_as_float(w.y << 16); acc8[3] += cw[k][3] * __uint_as_float(w.y & 0xffff0000u);
            acc8[4] += cw[k][4] * __uint_as_float(w.z << 16); acc8[5] += cw[k][5] * __uint_as_float(w.z & 0xffff0000u);
            acc8[6] += cw[k][6] * __uint_as_float(w.w << 16); acc8[7] += cw[k][7] * __uint_as_float(w.w & 0xffff0000u); }
        u32x4 o; o.x = cvtpk(acc8[0], acc8[1]); o.y = cvtpk(acc8[2], acc8[3]); o.z = cvtpk(acc8[4], acc8[5]); o.w = cvtpk(acc8[6], acc8[7]);
        *(LRU_LAS u32x4*)(lds + OFF_XC + tok * XCP + cg * 16) = o; }
    __syncthreads();
}
__device__ __forceinline__ void publish(LRU_LAS unsigned char* lds, const Tensors& T, int g, int tc) {
    const int tid = threadIdx.x; LRU_LAS float* TA = (LRU_LAS float*)(lds + OFF_TA); LRU_LAS float* TH = (LRU_LAS float*)(lds + OFF_TH);
    if (tid < 128) { float* pub = T.PUB + (size_t)(g * 16 + tc) * 256;
        __hip_atomic_store(pub + tid, TA[tid], __ATOMIC_RELAXED, __HIP_MEMORY_SCOPE_AGENT); __hip_atomic_store(pub + 128 + tid, TH[tid], __ATOMIC_RELAXED, __HIP_MEMORY_SCOPE_AGENT); }
    asm volatile("s_waitcnt vmcnt(0)" ::: "memory");
    __syncthreads();
    if (tid == 0) __hip_atomic_store(T.FLG + (size_t)(g * 16 + tc) * 16, 1u, __ATOMIC_RELAXED, __HIP_MEMORY_SCOPE_AGENT);
}
__device__ __forceinline__ void gate_stage(LRU_LAS unsigned char* lds, const Tensors& T, int g, int tc) {
    int tid_ = threadIdx.x; asm volatile("" : "+v"(tid_)); const int tid = tid_, lane = tid & 63, wid = __builtin_amdgcn_readfirstlane(tid >> 6), fr = lane & 15, fq = lane >> 4;
    const int b = g >> 3, n = g & 7;
    LRU_LAS float* LA = (LRU_LAS float*)(lds + OFF_A); LRU_LAS float* LU = (LRU_LAS float*)(lds + OFF_U);
    LRU_LAS float* SA = (LRU_LAS float*)(lds + OFF_SA); LRU_LAS float* SH = (LRU_LAS float*)(lds + OFF_SH);
    LRU_LAS float* TA = (LRU_LAS float*)(lds + OFF_TA); LRU_LAS float* TH = (LRU_LAS float*)(lds + OFF_TH);
    const size_t rowb = (size_t)b * 2048; const int t0 = tc * CH;
    const int tok = 16 * wid + fr;
    bf16x8 af[4];
#pragma unroll
    for (int ks = 0; ks < 4; ++ks) af[ks] = *(const LRU_LAS bf16x8*)(lds + OFF_XC + tok * XCP + (ks * 32 + fq * 8) * 2);
    const int se = tid & 31, sg = tid >> 5;
#pragma unroll 1
    for (int es = 0; es < 4; ++es) {
        LSTAMP(T, 30);
        const size_t chn = (size_t)n * 128 + es * 32 + se;
        unsigned short glr[8];
#pragma unroll
        for (int j = 0; j < 8; ++j) glr[j] = T.GL[(rowb + t0 + sg * 8 + j) * 1024 + chn];
        {
            f32x4 ar[2], ai_[2];
#pragma unroll
            for (int nb = 0; nb < 2; ++nb) { ar[nb] = (f32x4){0.f, 0.f, 0.f, 0.f}; ai_[nb] = (f32x4){0.f, 0.f, 0.f, 0.f}; }
#pragma unroll
            for (int ks = 0; ks < 4; ++ks)
#pragma unroll
                for (int nb = 0; nb < 2; ++nb) {
                    const bf16x8 wr_ = *(const LRU_LAS bf16x8*)(lds + OFF_WB + (es * 32 + nb * 16 + fr) * XCP + (ks * 32 + fq * 8) * 2);
                    const bf16x8 wi_ = *(const LRU_LAS bf16x8*)(lds + OFF_WB + (128 + es * 32 + nb * 16 + fr) * XCP + (ks * 32 + fq * 8) * 2);
                    ar[nb] = __builtin_amdgcn_mfma_f32_16x16x32_bf16(wr_, af[ks], ar[nb], 0, 0, 0);
                    ai_[nb] = __builtin_amdgcn_mfma_f32_16x16x32_bf16(wi_, af[ks], ai_[nb], 0, 0, 0); }
#pragma unroll
            for (int nb = 0; nb < 2; ++nb) {
                const LRU_LAS float* CT = (const LRU_LAS float*)(lds + OFF_CT) + es * 32 + nb * 16 + fq * 4;
                const f32x4 vbr = *(const LRU_LAS f32x4*)(CT + CT_BR), vbi = *(const LRU_LAS f32x4*)(CT + CT_BI), vc8 = *(const LRU_LAS f32x4*)(CT + CT_C8);
                const u32x2 xw = *(const LRU_LAS u32x2*)(lds + OFF_XC + tok * XCP + (es * 32 + nb * 16 + fq * 4) * 2);
                const float xv[4] = {__uint_as_float(xw.x << 16), __uint_as_float(xw.x & 0xffff0000u), __uint_as_float(xw.y << 16), __uint_as_float(xw.y & 0xffff0000u)};
                f32x4 av, uv;
#pragma unroll
                for (int j = 0; j < 4; ++j) {
                    const float dr = 1.0f + __expf(-(ar[nb][j] + vbr[j])), di = 1.0f + __expf(-(ai_[nb][j] + vbi[j]));
                    const float rc = __builtin_amdgcn_rcpf(dr * di);
                    const float r = rc * di, ig = rc * dr;
                    const float la = -r * vc8[j];
                    const float a = __expf(la);
                    const float y = -2.0f * la;
                    const float om = (y < 0.02f) ? y * (1.0f - y * 0.5f * (1.0f - y * (1.0f / 3.0f))) : (1.0f - a * a);
                    av[j] = a;
                    uv[j] = __builtin_amdgcn_sqrtf(om) * (ig * xv[j]);
                }
                *(LRU_LAS f32x4*)(LA + tok * LP + nb * 16 + fq * 4) = av; *(LRU_LAS f32x4*)(LU + tok * LP + nb * 16 + fq * 4) = uv;
            }
        }
        LSTAMP(T, 34);
        __syncthreads();
        LSTAMP(T, 31);
        float a8[8], u8[8];
        { float A = 1.f, Hh = 0.f;
#pragma unroll
          for (int j = 0; j < 8; ++j) { a8[j] = LA[(sg * 8 + j) * LP + se]; u8[j] = LU[(sg * 8 + j) * LP + se]; Hh = a8[j] * Hh + u8[j]; A *= a8[j]; }
          SA[sg * 32 + se] = A; SH[sg * 32 + se] = Hh; }
        __syncthreads();
        LSTAMP(T, 32);
        { float h = 0.f, Ap = 1.f;
#pragma unroll
          for (int s2 = 0; s2 < 15; ++s2) { const float sa = SA[s2 * 32 + se], sh = SH[s2 * 32 + se]; if (s2 < sg) { h = sa * h + sh; Ap *= sa; } }
#pragma unroll
          for (int j = 0; j < 8; ++j) { h = a8[j] * h + u8[j]; Ap *= a8[j]; const size_t row = rowb + t0 + sg * 8 + j;
              const float gl = b2f(glr[j]);
              const float y = h * gl, q = Ap * gl;
              const float yn = __int_as_float(__builtin_amdgcn_mov_dpp(__float_as_int(y), 0xB1, 0xF, 0xF, true)), qn = __int_as_float(__builtin_amdgcn_mov_dpp(__float_as_int(q), 0xB1, 0xF, 0xF, true));
              if ((se & 1) == 0) { *(unsigned*)(T.Y + row * 2048 + 1024 + chn) = cvtpk(y, yn); *(unsigned*)(T.Q1 + row * 1024 + chn) = cvtpk(q, qn); } }
          if (sg == 15) { TA[es * 32 + se] = Ap; TH[es * 32 + se] = h; } }
        LSTAMP(T, 33);
    }
    __syncthreads();
}

__device__ __forceinline__ void fix(LRU_LAS unsigned char* lds, const Tensors& T, int g, int tc) {
    if (tc == 0) return;
    const int tid = threadIdx.x; LRU_LAS float* CR = (LRU_LAS float*)(lds + OFF_CR);
    const int b = g >> 3, n = g & 7; const size_t rowb = (size_t)b * 2048 + tc * CH;
    const int cg = tid & 15, trow = tid >> 4;
    u32x4 yv[4], qv[4];
#pragma unroll
    for (int i = 0; i < 4; ++i) { const size_t row = rowb + trow + 32 * i;
        yv[i] = *(const u32x4*)(T.Y + row * 2048 + 1024 + n * 128 + cg * 8); qv[i] = *(const u32x4*)(T.Q1 + row * 1024 + n * 128 + cg * 8); }
    if (tid < tc) { unsigned sp = 0; while (__hip_atomic_load(T.FLG + (size_t)(g * 16 + tid) * 16, __ATOMIC_RELAXED, __HIP_MEMORY_SCOPE_AGENT) == 0u) { __builtin_amdgcn_s_sleep(2); if (++sp > (1u << 22)) break; } }
    __syncthreads();
    if (tid < 128) { float c = 0.f; float pa[15], ph[15];
#pragma unroll
        for (int t2 = 0; t2 < 15; ++t2) { pa[t2] = 1.f; ph[t2] = 0.f;
            if (t2 < tc) { const float* pub = T.PUB + (size_t)(g * 16 + t2) * 256;
                pa[t2] = __hip_atomic_load(pub + tid, __ATOMIC_RELAXED, __HIP_MEMORY_SCOPE_AGENT); ph[t2] = __hip_atomic_load(pub + 128 + tid, __ATOMIC_RELAXED, __HIP_MEMORY_SCOPE_AGENT); } }
#pragma unroll
        for (int t2 = 0; t2 < 15; ++t2) c = pa[t2] * c + ph[t2];
        CR[tid] = c; }
    __syncthreads();
    f32x4 c0 = *(const LRU_LAS f32x4*)(CR + cg * 8), c1 = *(const LRU_LAS f32x4*)(CR + cg * 8 + 4);
#pragma unroll
    for (int i = 0; i < 4; ++i) { const size_t row = rowb + trow + 32 * i;
        unsigned short* yp = T.Y + row * 2048 + 1024 + n * 128 + cg * 8; u32x4 o;
#define FIX2_(y, q, ca, cb_) cvtpk(__uint_as_float((y) << 16) + __uint_as_float((q) << 16) * (ca), __uint_as_float((y) & 0xffff0000u) + __uint_as_float((q) & 0xffff0000u) * (cb_))
        o.x = FIX2_(yv[i].x, qv[i].x, c0[0], c0[1]); o.y = FIX2_(yv[i].y, qv[i].y, c0[2], c0[3]); o.z = FIX2_(yv[i].z, qv[i].z, c1[0], c1[1]); o.w = FIX2_(yv[i].w, qv[i].w, c1[2], c1[3]);
#undef FIX2_
        *(u32x4*)yp = o; }
    __syncthreads();
}
}

namespace cg = cooperative_groups;
#ifndef ALIGN_SINGLE
#define ALIGN_SINGLE true
#endif
#ifndef REP_P0
#define REP_P0 1
#endif
#ifndef REP_P1
#define REP_P1 1
#endif
#ifndef REP_LRU
#define REP_LRU 1
#endif
#ifndef REP_ATT
#define REP_ATT 1
#endif
#ifndef REP_P3
#define REP_P3 1
#endif
#ifndef REP_P4
#define REP_P4 1
#endif
#ifndef EXTRA_SYNC
#define EXTRA_SYNC 0
#endif
constexpr int NWAVES = 8;
constexpr int BATCH = 4, SEQ = 2048, DM = 2048, M = BATCH * SEQ, DIN = 10240, AW = 1024, LW = 1024, PLE = 256, NH = 8, HD = 128;
constexpr size_t MiB = 1u << 20;
constexpr size_t WS_BAR = 512 * 1024, BAR_BYTES = 16384, WS_FLG = WS_BAR + BAR_BYTES, FLG_BYTES = 32768, WS_C8 = 576 * 1024, WS_PUB = 2 * MiB + 512 * 1024, WS_Q1 = 296 * MiB;
constexpr size_t WS_KMP = 0, WS_SSQ = 1 * MiB, WS_WRT = 2 * MiB, WS_WIT = 2 * MiB + 256 * 1024, WS_WPLE = 3 * MiB, WS_W2 = 4 * MiB, WS_WOUT = 12 * MiB, WS_WG = 20 * MiB, WS_WIN = 28 * MiB,
                 WS_H = 68 * MiB, WS_MG = 68 * MiB, WS_PB = 100 * MiB, WS_Q = 104 * MiB, WS_K = 120 * MiB, WS_V = 136 * MiB, WS_GA = 152 * MiB, WS_XR = 168 * MiB, WS_GL = 184 * MiB,
                 WS_SA = 200 * MiB, WS_SL = 232 * MiB, WS_Y = 264 * MiB, WS_X1G = 104 * MiB, WS_PL = 136 * MiB, WS_END = 312 * MiB;
static_assert(WS_K == WS_Q + 16 * MiB && WS_V == WS_Q + 32 * MiB && WS_GA == WS_Q + 48 * MiB && WS_XR == WS_Q + 64 * MiB && WS_GL == WS_Q + 80 * MiB && WS_SA == WS_Q + 96 * MiB && WS_SL == WS_SA + 32 * MiB, "EpiG1 destination arithmetic");
constexpr int RING_BYTES = 131072, SCR_OFF = RING_BYTES, KM_LDS_OFF = 69632;
constexpr int LDS_BYTES = 155648, MISC_OFF = LDS_BYTES - 64;
static_assert(attn::STG_OFF + 65536 <= LDS_BYTES && attn::KM_OFF == KM_LDS_OFF && attn::KM_OFF + 4096 <= attn::STG_OFF, "attention LDS map");
static_assert(attn::LDS_BYTES <= KM_LDS_OFF && KM_LDS_OFF + 4096 <= RING_BYTES && lru::LRU_LDS <= MISC_OFF && SCR_OFF + 8192 <= LDS_BYTES, "LDS map");

#define GAS __attribute__((address_space(1)))
#define LAS __attribute__((address_space(3)))
typedef unsigned short bf16;
typedef unsigned v4u __attribute__((ext_vector_type(4)));
typedef float f32x4 __attribute__((ext_vector_type(4)));
#define LDS_WAIT() asm volatile("s_waitcnt lgkmcnt(0)" ::: "memory")
__device__ __forceinline__ unsigned f2bf(float f) { unsigned u = __builtin_bit_cast(unsigned, f); return (u + 0x7fffu + ((u >> 16) & 1u)) >> 16; }
__device__ __forceinline__ unsigned pk2(float lo, float hi) { return f2bf(lo) | (f2bf(hi) << 16); }
__device__ __forceinline__ float wave_sum(float v) {
#pragma unroll
    for (int o = 1; o < 64; o <<= 1) v += __shfl_xor(v, o);
    return v;
}
__device__ __forceinline__ void p0_transpose_item(const float* W, int N, bf16* WT, int ldk, int row_off, int k_off, LAS float* scr, int kb, int nb, int lane) {
    const int k0 = 64 * kb, n0 = 32 * nb;
#pragma unroll 8
    for (int i = 0; i < 32; ++i) { const int kk = 2 * i + (lane >> 5); scr[kk * 33 + (lane & 31)] = W[(size_t)(k0 + kk) * N + n0 + (lane & 31)]; }
    LDS_WAIT(); asm volatile("" ::: "memory");
    const int c = lane & 7;
#pragma unroll
    for (int j = 0; j < 4; ++j) { const int n = (lane >> 3) + 8 * j; const LAS float* s = scr + (8 * c) * 33 + n;
        v4u o; o.x = pk2(s[0 * 33], s[1 * 33]); o.y = pk2(s[2 * 33], s[3 * 33]); o.z = pk2(s[4 * 33], s[5 * 33]); o.w = pk2(s[6 * 33], s[7 * 33]);
        *(GAS v4u*)(WT + (size_t)(row_off + n0 + n) * ldk + k_off + k0 + 8 * c) = o; }
    LDS_WAIT(); asm volatile("" ::: "memory");
}

#define RLX_AGENT __ATOMIC_RELAXED, __HIP_MEMORY_SCOPE_AGENT
#define XB_TMO      128
#define XB_XCNT(j)  (256  + 64 * (j))
#define XB_XSUB(j)  (1280 + 64 * (j))
#define XB_XGEN(j)  (2304 + 64 * (j))
#define XB_TOP      3328
#define XB_TOPGEN   3392
#define XCD_BAR_WORDS 3456
#define XB_SPIN_CAP (1u << 18)

__device__ __forceinline__ unsigned xb_ld(unsigned* p)              { return __hip_atomic_load(p, __ATOMIC_RELAXED, __HIP_MEMORY_SCOPE_AGENT); }
__device__ __forceinline__ unsigned xb_add(unsigned* p, unsigned v) { return __hip_atomic_fetch_add(p, v, __ATOMIC_RELAXED, __HIP_MEMORY_SCOPE_AGENT); }
__device__ __forceinline__ unsigned xb_xcc_id() { return (unsigned)__builtin_amdgcn_s_getreg((3 << 11) | 20) & 0xFu; }
#define XB_SPIN(cond, bar) do { unsigned _sp = 0; while (cond) { __builtin_amdgcn_s_sleep(1); \
    if ((++_sp & 255u) == 0u) { if (xb_ld(&(bar)[XB_TMO])) break; if (_sp > XB_SPIN_CAP) { atomicAdd(&(bar)[XB_TMO], 1u); break; } } } } while (0)

struct XcdBarrier {
    unsigned* bar; unsigned x;
    volatile LAS unsigned* st;
};

__device__ __forceinline__ XcdBarrier xcd_barrier_post(unsigned* bar, volatile LAS unsigned* st) {
    XcdBarrier b; b.bar = bar; b.x = xb_xcc_id(); b.st = st;
    if (threadIdx.x == 0) (void)xb_add(&bar[XB_XCNT(b.x)], 1u);
    return b;
}
__device__ __forceinline__ void xcd_barrier_complete(unsigned* bar, unsigned x, unsigned& nloc, unsigned& nx) {
    const unsigned G = gridDim.x * gridDim.y * gridDim.z;
    unsigned sum, cnt, mine, sp = 0u;
    for (;;) {
        sum = 0u; cnt = 0u; mine = 0u;
#pragma unroll
        for (unsigned j = 0; j < 16; ++j) { const unsigned c = xb_ld(&bar[XB_XCNT(j)]); sum += c; cnt += (c > 0u) ? 1u : 0u; mine = (j == x) ? c : mine; }
        if (sum == G) break;
        __builtin_amdgcn_s_sleep(1);
        if ((++sp & 255u) == 0u) { if (xb_ld(&bar[XB_TMO])) break; if (sp > XB_SPIN_CAP) { atomicAdd(&bar[XB_TMO], 1u); break; } }
    }
    nloc = mine > 0u ? mine : 1u; nx = cnt > 0u ? cnt : 1u;
}

__device__ __forceinline__ void xcd_barrier(const XcdBarrier& b) {
    asm volatile("s_waitcnt vmcnt(0)" ::: "memory");
    __syncthreads();
    if (threadIdx.x == 0) {
        unsigned* bar = b.bar;
        __builtin_amdgcn_s_waitcnt(0);
        unsigned nloc = b.st[0], nx = b.st[1];
        if (nloc == 0u) { xcd_barrier_complete(bar, b.x, nloc, nx); b.st[0] = nloc; b.st[1] = nx; }
        const unsigned old = xb_add(&bar[XB_XSUB(b.x)], 1u);
        const unsigned gen = old / nloc;
        if (old + 1u == (gen + 1u) * nloc) {
            __builtin_amdgcn_fence(__ATOMIC_RELEASE, "agent");
            asm volatile("s_waitcnt vmcnt(0)" ::: "memory");
            const unsigned og = xb_add(&bar[XB_TOP], 1u);
            const unsigned tg = og / nx;
            if (og + 1u == (tg + 1u) * nx) xb_add(&bar[XB_TOPGEN], 1u);
            else XB_SPIN(xb_ld(&bar[XB_TOPGEN]) == tg, bar);
            __builtin_amdgcn_fence(__ATOMIC_ACQUIRE, "agent");
            xb_add(&bar[XB_XGEN(b.x)], 1u);
            asm volatile("s_waitcnt vmcnt(0)" ::: "memory");
        } else {
            XB_SPIN(xb_ld(&bar[XB_XGEN(b.x)]) == gen, bar);
            __builtin_amdgcn_fence(__ATOMIC_ACQUIRE, "agent");
            asm volatile("s_waitcnt vmcnt(0)" ::: "memory");
        }
    }
    __syncthreads();
}

struct Args { const float* in[20]; float* out; unsigned char* ws; };

__device__ __forceinline__ void p0_prologue(const Args& args, LAS unsigned char* ldsl, int vcu, int G, int wave, int lane, bf16* Win_t, bf16* W2_t, bf16* Wout_t, bf16* Wg_t, bf16* Wple_t, bf16* Wr_t, bf16* Wi_t, bf16* Hb, bf16* PB, float* C8) {
    {
        LAS float* scr = (LAS float*)(ldsl + wave * 16384);
        const int gw = vcu * NWAVES + wave, NGW = G * NWAVES;
        constexpr int I0 = 32 * 320, I1 = 16 * 64, I2 = 16 * 64, I3 = 32 * 64, I4 = 32 * 64, I5 = 4 * 64, I6 = 64, I7 = 64;
        constexpr int NITEMS = I0 + I1 + I2 + I3 + I4 + I5 + I6 + I7;
        for (int it = gw; it < NITEMS; it += NGW) {
            int r = it;
            if (r < I0) { p0_transpose_item(args.in[3], DIN, Win_t, 2048, 0, 0, scr, r / 320, r % 320, lane); continue; } r -= I0;
            if (r < I1) { p0_transpose_item(args.in[13], DM, W2_t, 2048, 0, 0, scr, r / 64, r % 64, lane); continue; } r -= I1;
            if (r < I2) { p0_transpose_item(args.in[14], DM, W2_t, 2048, 0, 1024, scr, r / 64, r % 64, lane); continue; } r -= I2;
            if (r < I3) { p0_transpose_item(args.in[15], DM, Wout_t, 2048, 0, 0, scr, r / 64, r % 64, lane); continue; } r -= I3;
            if (r < I4) { p0_transpose_item(args.in[17], DM, Wg_t, 2048, 0, 0, scr, r / 64, r % 64, lane); continue; } r -= I4;
            if (r < I5) { p0_transpose_item(args.in[19], DM, Wple_t, 256, 0, 0, scr, r / 64, r % 64, lane); continue; } r -= I5;
            if (r < I6) { const int n = r >> 3, s = r & 7; p0_transpose_item(args.in[8] + (size_t)n * 16384, 128, Wr_t, 128, n * 128, 0, scr, s >> 2, s & 3, lane); continue; } r -= I6;
            { const int n = r >> 3, s = r & 7; p0_transpose_item(args.in[10] + (size_t)n * 16384, 128, Wi_t, 128, n * 128, 0, scr, s >> 2, s & 3, lane); }
        }
        const float* x = args.in[0]; const float* ng = args.in[2];
        {
            const GAS f32x4* gr = (const GAS f32x4*)ng + lane; f32x4 gg[8];
#pragma unroll
            for (int j = 0; j < 8; ++j) gg[j] = gr[64 * j];
            int m = gw; f32x4 v[8], vn[8];
            if (m < M) { const GAS f32x4* xr = (const GAS f32x4*)(x + (size_t)m * DM) + lane;
#pragma unroll
                for (int j = 0; j < 8; ++j) v[j] = xr[64 * j]; }
            while (m < M) {
                const int mn = m + NGW;
                if (mn < M) { const GAS f32x4* xr = (const GAS f32x4*)(x + (size_t)mn * DM) + lane;
#pragma unroll
                    for (int j = 0; j < 8; ++j) vn[j] = xr[64 * j]; }
                float s = 0.f;
#pragma unroll
                for (int j = 0; j < 8; ++j) s += (v[j].x * v[j].x + v[j].y * v[j].y) + (v[j].z * v[j].z + v[j].w * v[j].w);
                const float rstd = 1.0f / sqrtf(wave_sum(s) * (1.0f / DM) + 1e-6f);
                GAS unsigned long long* o8 = (GAS unsigned long long*)(Hb + (size_t)m * DM) + lane;
#pragma unroll
                for (int j = 0; j < 8; ++j) { const f32x4 g = gg[j];
                    o8[64 * j] = (unsigned long long)pk2(v[j].x * rstd * g.x, v[j].y * rstd * g.y) | ((unsigned long long)pk2(v[j].z * rstd * g.z, v[j].w * rstd * g.w) << 32); }
#pragma unroll
                for (int j = 0; j < 8; ++j) v[j] = vn[j];
                m = mn; }
        }
        if (gw < 16) { const int i = gw * 64 + lane; const float x = -args.in[12][i]; C8[i] = 8.0f * (fmaxf(x, 0.f) + log1pf(expf(-fabsf(x)))); }
        const float* p = args.in[1];
        for (int m0 = gw; m0 < M; m0 += 4 * NGW) {
            f32x4 pv[4];
#pragma unroll
            for (int i = 0; i < 4; ++i) { const int m = m0 + i * NGW; pv[i] = (f32x4){0.f, 0.f, 0.f, 0.f}; if (m < M) pv[i] = ((const GAS f32x4*)(p + (size_t)m * PLE))[lane]; }
#pragma unroll
            for (int i = 0; i < 4; ++i) { const int m = m0 + i * NGW;
                if (m < M) ((GAS unsigned long long*)(PB + (size_t)m * PLE))[lane] = (unsigned long long)pk2(pv[i].x, pv[i].y) | ((unsigned long long)pk2(pv[i].z, pv[i].w) << 32); }
        }
    }
}

#ifdef PROBE_TS
#ifndef PROBE_SCALE
#define PROBE_SCALE 0.002f
#endif
#ifndef PROBE_BLK
#define PROBE_BLK 0
#endif
#define STAMP(i) do { if (blockIdx.x == PROBE_BLK && threadIdx.x == 0) ((volatile unsigned long long*)(args.ws + (600u << 10)))[i] = __builtin_amdgcn_s_memrealtime(); } while (0)
#else
#define STAMP(i) do { } while (0)
#endif

template <bool DO_LRU, bool DO_ATT, bool WPRE = false> __device__ __forceinline__ void p2_phase(const Args& args, unsigned char* lds, LAS unsigned char* ldsl, int vcu, int G, bf16* Qb, bf16* Kb, bf16* Vb, bf16* GA, bf16* XR, bf16* GL, bf16* Yb, bf16* Wr_t, bf16* Wi_t, float* KMP, bf16* Q1b, float* PUB, unsigned* FLG, const float* C8) {
    const lru::Tensors T{XR, GL, Yb, Q1b, Wr_t, Wi_t, args.in[6], args.in[7], args.in[9], args.in[11], C8, PUB, FLG};
#ifndef SKIP_LRU
    if constexpr (DO_LRU)
    for (int L = vcu; L < 256; L += G) { const int g = L >> 3, q = L & 7;
        int tcs[4]; int nu = 0;
#pragma unroll
        for (int r = 0; r < 4; ++r) { const int tc = lru::unit_tc(q, r); tcs[r] = tc; if (tc >= 0) nu = r + 1; }
        if (nu > 0) {
        lru::Raw R; lru::load_raw(T, g, tcs[0], R);
        if (!(WPRE && L == vcu)) lru::load_weights(ldsl, T, g & 7);
#pragma unroll
        for (int k = 0; k < 4; ++k) if (k < nu) {
            LSTAMP(T, 20);
            lru::conv_stage(ldsl, T, g, R);
            LSTAMP(T, 21);
            if (k > 0) lru::publish(ldsl, T, g, tcs[k - 1]);
            if (k + 1 < nu) lru::load_raw(T, g, tcs[k + 1], R);
            LSTAMP(T, 23);
            lru::gate_stage(ldsl, T, g, tcs[k]); LSTAMP(T, 22); }
        lru::publish(ldsl, T, g, nu == 4 ? tcs[3] : (nu == 3 ? tcs[2] : (nu == 2 ? tcs[1] : tcs[0])));
        }
    }
#endif
    STAMP(10);
#ifndef SKIP_ATTN
    if constexpr (DO_ATT)
    attn::phase((char*)lds, (const attn::bf16*)Qb, (const attn::bf16*)Kb, (const attn::bf16*)Vb, (attn::bf16*)Yb, (const attn::bf16*)GA, KMP, vcu, G);
#endif
    STAMP(11);
#ifndef SKIP_LRU
    if constexpr (DO_LRU)
    for (int L = vcu; L < 256; L += G) { const int g = L >> 3, q = L & 7;
#pragma unroll 1
        for (int r = 0; r < 4; ++r) { const int tc = lru::unit_tc(q, r); if (tc > 0) lru::fix(ldsl, T, g, tc); }
    }
#endif
    STAMP(12);
}

__global__ void __launch_bounds__(NWAVES * 64, 2) moba_rglru_fwd(Args args) {
    extern __shared__ __attribute__((aligned(16))) unsigned char lds[];
    cg::grid_group grid = cg::this_grid();
    LAS unsigned char* ldsl = (LAS unsigned char*)lds;
    const int tid = threadIdx.x, lane = tid & 63, wave = __builtin_amdgcn_readfirstlane(tid >> 6);
    const int G = gridDim.x; const int bx = blockIdx.x; const int vcu = (G % 8 == 0) ? (bx % 8) * (G / 8) + bx / 8 : bx;
    unsigned char* ws = args.ws;
    volatile LAS unsigned* MISC = (volatile LAS unsigned*)(ldsl + MISC_OFF);
    if (tid < 16) MISC[tid] = 0u;
    __syncthreads();
    XcdBarrier bar = xcd_barrier_post((unsigned*)(ws + WS_BAR), MISC);
#ifdef KEEP_CG_DESCRIPTOR
    if (G > (1 << 20)) grid.sync();
#endif
#define GRID_BAR(i) do { xcd_barrier(bar); STAMP(i); } while (0)
    STAMP(0);
    bf16* Win_t = (bf16*)(ws + WS_WIN); bf16* W2_t = (bf16*)(ws + WS_W2); bf16* Wout_t = (bf16*)(ws + WS_WOUT); bf16* Wg_t = (bf16*)(ws + WS_WG); bf16* Wple_t = (bf16*)(ws + WS_WPLE);
    bf16* Wr_t = (bf16*)(ws + WS_WRT); bf16* Wi_t = (bf16*)(ws + WS_WIT);
    bf16* Hb = (bf16*)(ws + WS_H); bf16* MG = (bf16*)(ws + WS_MG); bf16* PB = (bf16*)(ws + WS_PB);
    bf16* Qb = (bf16*)(ws + WS_Q); bf16* Kb = (bf16*)(ws + WS_K); bf16* Vb = (bf16*)(ws + WS_V); bf16* GA = (bf16*)(ws + WS_GA); bf16* XR = (bf16*)(ws + WS_XR); bf16* GL = (bf16*)(ws + WS_GL);
    bf16* SAb = (bf16*)(ws + WS_SA); bf16* SLb = (bf16*)(ws + WS_SL); bf16* Yb = (bf16*)(ws + WS_Y); bf16* X1G = (bf16*)(ws + WS_X1G); bf16* PL = (bf16*)(ws + WS_PL);
    float* KMP = (float*)(ws + WS_KMP); float* SSQ = (float*)(ws + WS_SSQ);
    bf16* Q1b = (bf16*)(ws + WS_Q1); float* PUB = (float*)(ws + WS_PUB); unsigned* FLG = (unsigned*)(ws + WS_FLG); float* C8 = (float*)(ws + WS_C8);

#ifndef SKIP_P0
    p0_prologue(args, ldsl, vcu, G, wave, lane, Win_t, W2_t, Wout_t, Wg_t, Wple_t, Wr_t, Wi_t, Hb, PB, C8);
#if REP_P0 >= 2
    p0_prologue(args, ldsl, vcu, G, wave, lane, Win_t, W2_t, Wout_t, Wg_t, Wple_t, Wr_t, Wi_t, Hb, PB, C8);
#endif
#if REP_P0 >= 3
    p0_prologue(args, ldsl, vcu, G, wave, lane, Win_t, W2_t, Wout_t, Wg_t, Wple_t, Wr_t, Wi_t, Hb, PB, C8);
#endif
#endif
    GRID_BAR(1);

    for (int es_ = 0; es_ < EXTRA_SYNC; ++es_) GRID_BAR(99);
#ifndef SKIP_P1
    for (int rep_ = 0; rep_ < REP_P1; ++rep_) {
    {
        pg8::Gemm g{Hb, Win_t, M, DIN, DM}; pg8::StaticOrder S; S.init(M, DIN, G, bx);
        pg8::EpiG1 E{ws + WS_Q, KMP, args.in[4], args.in[5], (LAS float*)(ldsl + SCR_OFF), 0};
        pg8::gemm_phase<pg8::EpiG1, pg8::StaticOrder, true, true>(ldsl, g, S, E);
    }
    }
#endif
#if !defined(SKIP_P2) && !defined(SKIP_LRU)
    if (vcu < 256 && lru::unit_tc(vcu & 7, 0) >= 0) {
        const lru::Tensors T{XR, GL, Yb, Q1b, Wr_t, Wi_t, args.in[6], args.in[7], args.in[9], args.in[11], C8, PUB, FLG};
        lru::load_weights(ldsl, T, (vcu >> 3) & 7); }
#endif
    GRID_BAR(2);

#ifndef SKIP_P2
    p2_phase<true, true, true>(args, lds, ldsl, vcu, G, Qb, Kb, Vb, GA, XR, GL, Yb, Wr_t, Wi_t, KMP, Q1b, PUB, FLG, C8);
#if REP_LRU >= 2
    p2_phase<true, false>(args, lds, ldsl, vcu, G, Qb, Kb, Vb, GA, XR, GL, Yb, Wr_t, Wi_t, KMP, Q1b, PUB, FLG, C8);
#endif
#if REP_ATT >= 2
    p2_phase<false, true>(args, lds, ldsl, vcu, G, Qb, Kb, Vb, GA, XR, GL, Yb, Wr_t, Wi_t, KMP, Q1b, PUB, FLG, C8);
#endif
#if REP_LRU >= 3
    p2_phase<true, false>(args, lds, ldsl, vcu, G, Qb, Kb, Vb, GA, XR, GL, Yb, Wr_t, Wi_t, KMP, Q1b, PUB, FLG, C8);
#endif
#if REP_ATT >= 3
    p2_phase<false, true>(args, lds, ldsl, vcu, G, Qb, Kb, Vb, GA, XR, GL, Yb, Wr_t, Wi_t, KMP, Q1b, PUB, FLG, C8);
#endif
#endif
    GRID_BAR(3);

#ifndef SKIP_P3
    for (int rep_ = 0; rep_ < REP_P3; ++rep_) {
    {
        size_t zw3 = 0; asm volatile("" : "+s"(zw3)); unsigned char* w3 = args.ws + zw3;
        pg8::Gemm g{(bf16*)(w3 + WS_Y), (bf16*)(w3 + WS_W2), M, DM, DM}; pg8::StaticOrder S; S.init(M, DM, G, bx);
        pg8::EpiG2 E{(bf16*)(w3 + WS_SA), (bf16*)(w3 + WS_SL), (bf16*)(w3 + WS_MG), 16};
        pg8::gemm_phase<pg8::EpiG2, pg8::StaticOrder, ALIGN_SINGLE, true>(ldsl, g, S, E);
    }
    }
#endif
    GRID_BAR(4);

#ifndef SKIP_P4
    for (int rep_ = 0; rep_ < REP_P4; ++rep_) {
    {
        size_t zw4 = 0; asm volatile("" : "+s"(zw4)); unsigned char* w4 = args.ws + zw4;
        pg8::Gemm g{(bf16*)(w4 + WS_MG), (bf16*)(w4 + WS_WOUT), M, DM, DM}; pg8::StaticOrder S; S.init(M, DM, G, bx);
        pg8::EpiG3 E{args.in[0], args.out, (bf16*)(w4 + WS_X1G), (float*)(w4 + WS_SSQ), args.in[16], 0};
        pg8::gemm_phase<pg8::EpiG3, pg8::StaticOrder, ALIGN_SINGLE, true>(ldsl, g, S, E);
    }
    }
#endif
#ifndef SKIP_P5
    {
        size_t zw5a = 0; asm volatile("" : "+s"(zw5a)); unsigned char* w5 = args.ws + zw5a;
        { pg8::Gemm g{(bf16*)(w5 + WS_PB), (bf16*)(w5 + WS_WPLE), M, DM, PLE}; pg8::StaticOrder S; S.init(M, DM, G, bx);
          pg8::EpiG4a E{(bf16*)(w5 + WS_PL), 0};
          pg8::gemm_phase<pg8::EpiG4a, pg8::StaticOrder, ALIGN_SINGLE, true>(ldsl, g, S, E); }
        asm volatile("s_waitcnt vmcnt(0)" ::: "memory"); __syncthreads();
    }
#endif
    GRID_BAR(5);

#ifndef SKIP_P5
    {
        size_t zw5 = 0; asm volatile("" : "+s"(zw5)); unsigned char* w5 = args.ws + zw5;
        { pg8::Gemm g{(bf16*)(w5 + WS_X1G), (bf16*)(w5 + WS_WG), M, DM, DM}; pg8::StaticOrder S; S.init(M, DM, G, bx);
          pg8::EpiG4b E{args.out, (bf16*)(w5 + WS_PL), (float*)(w5 + WS_SSQ), args.in[18], (LAS float*)(ldsl + SCR_OFF), 0};
          pg8::gemm_phase<pg8::EpiG4b, pg8::StaticOrder, ALIGN_SINGLE, true>(ldsl, g, S, E); }
    }
#endif
#ifdef PROBE_TS
    asm volatile("s_waitcnt vmcnt(0)" ::: "memory"); __syncthreads();
    STAMP(6);
    if (blockIdx.x == PROBE_BLK && threadIdx.x == 0) { volatile unsigned long long* ts_ = (volatile unsigned long long*)(args.ws + (600u << 10)); const float us = (float)(ts_[PROBE_TE] - ts_[PROBE_TS]) * 0.01f; args.out[0] += us * PROBE_SCALE; }
#endif
}

extern "C" void kernel_launch(void* const* d_in, const int* in_sizes, int n_in, void* d_out, int out_size, void* d_ws, size_t ws_size, hipStream_t stream) {
    static int grid_blocks = 0;
    if (grid_blocks == 0) {
        if (n_in != 20 || in_sizes[0] != M * DM || out_size != M * DM || ws_size < WS_END) { fprintf(stderr, "kernel_launch: unexpected shapes (n_in %d, in0 %d, out %d, ws %zu)\n", n_in, n_in > 0 ? in_sizes[0] : -1, out_size, ws_size); grid_blocks = -1; return; }
        int dev = 0, cus = 0, per_cu = 0;
        (void)hipGetDevice(&dev);
        (void)hipDeviceGetAttribute(&cus, hipDeviceAttributeMultiprocessorCount, dev);
        if (hipFuncSetAttribute((const void*)moba_rglru_fwd, hipFuncAttributeMaxDynamicSharedMemorySize, LDS_BYTES) != hipSuccess) { fprintf(stderr, "kernel_launch: hipFuncSetAttribute failed\n"); }
        if (hipOccupancyMaxActiveBlocksPerMultiprocessor(&per_cu, (const void*)moba_rglru_fwd, NWAVES * 64, LDS_BYTES) != hipSuccess || per_cu < 1) { fprintf(stderr, "kernel_launch: occupancy query failed (%d)\n", per_cu); per_cu = 1; }
        (void)hipGetLastError();
        if (per_cu > 1) per_cu = 1;
        grid_blocks = cus * per_cu;
        if (grid_blocks > 256) grid_blocks = 256;
    }
    if (grid_blocks < 0) return;
    if (hipMemsetAsync((char*)d_ws + WS_BAR, 0, BAR_BYTES + FLG_BYTES, stream) != hipSuccess) { fprintf(stderr, "kernel_launch: hipMemsetAsync failed\n"); return; }
    Args a{};
    for (int i = 0; i < 20; ++i) a.in[i] = (const float*)d_in[i];
    a.out = (float*)d_out; a.ws = (unsigned char*)d_ws;
    void* kargs[] = {&a};
    hipError_t e = hipLaunchCooperativeKernel((const void*)moba_rglru_fwd, dim3(grid_blocks), dim3(NWAVES * 64), kargs, LDS_BYTES, stream);
    if (e != hipSuccess) fprintf(stderr, "cooperative launch failed: %s (grid %d)\n", hipGetErrorString(e), grid_blocks);
}
```

```cpp
#include <hip/hip_runtime.h>
#include <hip/hip_bf16.h>
#include <hip/hip_cooperative_groups.h>
#include <cstdio>
#include <cstdint>
#include <cmath>
namespace pg8 {
#define PG8_LAS __attribute__((address_space(3)))
typedef unsigned short bf16_t;
typedef short bf16x8 __attribute__((ext_vector_type(8)));
typedef float f32x4 __attribute__((ext_vector_type(4)));
typedef unsigned u32x4 __attribute__((ext_vector_type(4)));
constexpr int BM = 256, BK = 64, HALF = 128, HTB = HALF * BK * 2  , STAGE_BYTES = 8 * HTB, NXCD = 8, WGM = 8;

__host__ __device__ __forceinline__ int lds_byte(int r, int c) { const int st = (r >> 4) * 2 + (c >> 5), rr = r & 15, cc = c & 31, ob = rr * 64 + cc * 2; return st * 1024 + (ob ^ (((ob >> 9) & 1) << 5)); }
__host__ __device__ __forceinline__ void stage_rc(int b, int& R, int& C) { const int st = b / 1024, sb = b % 1024, swz = sb ^ (((sb >> 9) & 1) << 5); R = (st >> 1) * 16 + swz / 64; C = (st & 1) * 32 + (swz % 64) / 2; }
__host__ __device__ __forceinline__ int perm32(int rho) { const int n = rho >> 4, i = rho & 15; return 8 * (i >> 2) + 4 * n + (i & 3); }

struct Unit { int pm, pn; };
struct Gemm { const bf16_t* A; const bf16_t* Bt; int M, N, K; };

struct StaticOrder {
    int nM, nN, nwg, G, c;
    __host__ __device__ void init(int M, int N, int G_, int c_) { nM = M / BM; nN = N / BM; nwg = nM * nN; G = G_; c = c_; }
    __host__ __device__ bool next(int i, Unit& u) const {
        const long L = (long)i * G + c; if (L >= nwg) return false;
        int wgid = (int)L; { const int q = nwg / NXCD, r = nwg % NXCD, xcd = wgid % NXCD, off = wgid / NXCD; wgid = (xcd < r ? xcd * (q + 1) : r * (q + 1) + (xcd - r) * q) + off; }
        const int nig = WGM * nN, gid = wgid / nig, fm = gid * WGM, gsz = (nM - fm) < WGM ? (nM - fm) : WGM;
        u.pm = fm + ((wgid % nig) % gsz); u.pn = (wgid % nig) / gsz; return true;
    }
    __device__ __forceinline__ void a_ready(const Unit&) const {}
    __device__ __forceinline__ void done(const Unit&) const {}
};

__device__ __forceinline__ unsigned cvt_pk_bf16(float lo, float hi) { unsigned r; asm volatile("v_cvt_pk_bf16_f32 %0, %1, %2" : "=v"(r) : "v"(lo), "v"(hi)); return r; }
__device__ __forceinline__ float bf_lo(unsigned w) { return __uint_as_float(w << 16); }
__device__ __forceinline__ float bf_hi(unsigned w) { return __uint_as_float(w & 0xffff0000u); }
__device__ __forceinline__ float sigmoidf_(float x) { return __builtin_amdgcn_rcpf(1.0f + __expf(-x)); }
__device__ __forceinline__ float siluf_(float x) { return x * __builtin_amdgcn_rcpf(1.0f + __expf(-x)); }
__device__ __forceinline__ u32x4 pack8bf(const f32x4& v0, const f32x4& v1) { u32x4 w; w.x = cvt_pk_bf16(v0[0], v0[1]); w.y = cvt_pk_bf16(v0[2], v0[3]); w.z = cvt_pk_bf16(v1[0], v1[1]); w.w = cvt_pk_bf16(v1[2], v1[3]); return w; }
__device__ __forceinline__ void unpack8bf(const u32x4& w, f32x4& v0, f32x4& v1) { v0 = (f32x4){bf_lo(w.x), bf_hi(w.x), bf_lo(w.y), bf_hi(w.y)}; v1 = (f32x4){bf_lo(w.z), bf_hi(w.z), bf_lo(w.w), bf_hi(w.w)}; }

#ifndef WT_STORES
#define WT_STORES 0
#endif
__device__ __forceinline__ void st16(void* p, const u32x4& v) {
#if WT_STORES
    asm volatile("global_store_dwordx4 %0, %1, off sc1\n\ts_nop 1" :: "v"(p), "v"(v) : "memory");
#else
    *(u32x4*)p = v;
#endif
}
__device__ __forceinline__ void st16p(void* p, const u32x4& v) { *(u32x4*)p = v; }
__device__ __forceinline__ void st16f(void* p, const f32x4& v) { *(f32x4*)p = v; }
constexpr int SEQ_ = 2048, NHEAD_ = 8;
struct EpiG1 {
    static constexpr bool PERM = true, AFTER_DRAIN = false, HOOK = false;
    unsigned char* wsQ; float* KMP; const float *qg, *kg; PG8_LAS float* scr; int hook_t;
    __device__ __forceinline__ void mid(f32x4 (&acc)[2][2][4][2], const Unit& u, int wr, int wc, int fr, int fq) const {}
    __device__ __forceinline__ void operator()(f32x4 (&acc)[2][2][4][2], const Unit& u, int wr, int wc, int fr, int fq) const {
        const int pn = u.pn; asm volatile("" : "+v"(fr), "+v"(fq));
        if (pn < 12) {
            if (pn < 8) {
#pragma unroll
                for (int ai = 0; ai < 2; ++ai)
#pragma unroll
                    for (int m = 0; m < 4; ++m)
#pragma unroll
                        for (int bj = 0; bj < 2; ++bj) {
                            const f32x4 a = acc[ai][bj][m][0], b = acc[ai][bj][m][1];
                            float s = (a[0] * a[0] + a[1] * a[1]) + (a[2] * a[2] + a[3] * a[3]) + (b[0] * b[0] + b[1] * b[1]) + (b[2] * b[2] + b[3] * b[3]);
                            s += __shfl_xor(s, 16); s += __shfl_xor(s, 32);
                            if (fq == 0) scr[((ai * HALF + wr * 64 + m * 16 + fr) * 2 + bj) * 4 + wc] = s;
                        }
                const f32x4 gq0 = *(const f32x4*)(qg + wc * 32 + 8 * fq), gq1 = *(const f32x4*)(qg + wc * 32 + 8 * fq + 4);
                const f32x4 gk0 = *(const f32x4*)(kg + wc * 32 + 8 * fq), gk1 = *(const f32x4*)(kg + wc * 32 + 8 * fq + 4);
                asm volatile("s_waitcnt lgkmcnt(0)" ::: "memory"); __builtin_amdgcn_s_barrier(); asm volatile("" ::: "memory");
                const f32x4 g0 = (pn < 4) ? gq0 : gk0, g1 = (pn < 4) ? gq1 : gk1;
#pragma unroll
                for (int ai = 0; ai < 2; ++ai)
#pragma unroll
                    for (int m = 0; m < 4; ++m)
#pragma unroll
                        for (int bj = 0; bj < 2; ++bj) {
                            const f32x4 p = *(const PG8_LAS f32x4*)(scr + ((ai * HALF + wr * 64 + m * 16 + fr) * 2 + bj) * 4);
                            const float rstd = __builtin_amdgcn_rsqf(((p[0] + p[1]) + (p[2] + p[3])) * (1.0f / 128.0f) + 1e-6f);
                            acc[ai][bj][m][0] = acc[ai][bj][m][0] * rstd * g0; acc[ai][bj][m][1] = acc[ai][bj][m][1] * rstd * g1;
                        }
                if (pn >= 4) {
#pragma unroll
                    for (int bj = 0; bj < 2; ++bj)
#pragma unroll
                        for (int n = 0; n < 2; ++n) {
                            f32x4 cs = (f32x4){0.f, 0.f, 0.f, 0.f};
#pragma unroll
                            for (int ai = 0; ai < 2; ++ai)
#pragma unroll
                                for (int m = 0; m < 4; ++m) cs += acc[ai][bj][m][n];
#pragma unroll
                            for (int o = 1; o < 16; o <<= 1) { cs[0] += __shfl_xor(cs[0], o); cs[1] += __shfl_xor(cs[1], o); cs[2] += __shfl_xor(cs[2], o); cs[3] += __shfl_xor(cs[3], o); }
                            if (fr == 0) *(f32x4*)(KMP + (size_t)(u.pm * 2 + wr) * 1024 + (pn - 4) * 256 + bj * HALF + wc * 32 + 8 * fq + 4 * n) = cs;
                        }
                }
            }
            bf16_t* base = (bf16_t*)(wsQ + (size_t)(pn >> 2) * (16u << 20));
            const int b = u.pm >> 3, s0 = (u.pm & 7) * 256 + wr * 64 + fr;
#pragma unroll
            for (int bj = 0; bj < 2; ++bj) {
                const int h = 2 * (pn & 3) + bj;
                bf16_t* hp = base + ((size_t)(b * NHEAD_ + h) * SEQ_ + s0) * 128 + wc * 32 + 8 * fq;
#pragma unroll
                for (int ai = 0; ai < 2; ++ai)
#pragma unroll
                    for (int m = 0; m < 4; ++m) st16p(hp + (size_t)(ai * HALF + m * 16) * 128, pack8bf(acc[ai][bj][m][0], acc[ai][bj][m][1]));
            }
        } else {
            bf16_t* base; int ldc, colt, act;
            if (pn < 24) { base = (bf16_t*)(wsQ + (size_t)(pn >> 2) * (16u << 20)); ldc = 1024; colt = (pn & 3) * 256; act = ((pn >> 2) == 4) ? 0 : 1; }
            else { base = (bf16_t*)(wsQ + (size_t)(96u << 20) + (size_t)((pn - 24) >> 3) * (32u << 20)); ldc = 2048; colt = ((pn - 24) & 7) * 256; act = 2; }
            const int row0 = u.pm * BM + wr * 64 + fr, col0 = colt + wc * 32 + 8 * fq;
#pragma unroll
            for (int ai = 0; ai < 2; ++ai)
#pragma unroll
                for (int m = 0; m < 4; ++m) { bf16_t* rowp = base + (size_t)(row0 + ai * HALF + m * 16) * ldc + col0;
#pragma unroll
                    for (int bj = 0; bj < 2; ++bj) { f32x4 v0 = acc[ai][bj][m][0], v1 = acc[ai][bj][m][1];
                        if (act != 0) {
#pragma unroll
                            for (int j = 0; j < 4; ++j) { const float e0 = __builtin_amdgcn_rcpf(1.0f + __expf(-v0[j])), e1 = __builtin_amdgcn_rcpf(1.0f + __expf(-v1[j]));
                                v0[j] = (act == 1) ? v0[j] * e0 : e0; v1[j] = (act == 1) ? v1[j] * e1 : e1; } }
                        st16p(rowp + bj * HALF, pack8bf(v0, v1)); } }
        }
    }
};

struct EpiG2 {
    static constexpr bool PERM = true, AFTER_DRAIN = false, HOOK = true;
    const bf16_t *SA, *SL; bf16_t* MG; int hook_t;
    __device__ __forceinline__ void mid(f32x4 (&acc)[2][2][4][2], const Unit& u, int wr, int wc, int fr, int fq) const {
        asm volatile("" : "+v"(fr), "+v"(fq)); const int row0 = u.pm * BM + wr * 64 + fr, col0 = u.pn * BM + wc * 32 + 8 * fq;
#pragma unroll
        for (int ai = 0; ai < 2; ++ai)
#pragma unroll
            for (int m = 0; m < 4; ++m) { const size_t off = (size_t)(row0 + ai * HALF + m * 16) * 2048 + col0;
#pragma unroll
                for (int bj = 0; bj < 2; ++bj) {
                    const u32x4 wa = *(const u32x4*)(SA + off + bj * HALF), wl = *(const u32x4*)(SL + off + bj * HALF);
                    f32x4 a0, a1, l0, l1; unpack8bf(wa, a0, a1); unpack8bf(wl, l0, l1);
#pragma unroll
                    for (int j = 0; j < 4; ++j) { acc[ai][bj][m][0][j] *= a0[j] * __builtin_amdgcn_rcpf(l0[j]); acc[ai][bj][m][1][j] *= a1[j] * __builtin_amdgcn_rcpf(l1[j]); }
                }
                if (m == 3) asm volatile("" ::: "memory"); }
    }
    __device__ __forceinline__ void operator()(f32x4 (&acc)[2][2][4][2], const Unit& u, int wr, int wc, int fr, int fq) const {
        asm volatile("" : "+v"(fr), "+v"(fq)); const int row0 = u.pm * BM + wr * 64 + fr, col0 = u.pn * BM + wc * 32 + 8 * fq;
        u32x4 wl[2][4][2];
#pragma unroll
        for (int ai = 0; ai < 2; ++ai)
#pragma unroll
            for (int m = 0; m < 4; ++m) { const size_t off = (size_t)(row0 + ai * HALF + m * 16) * 2048 + col0;
#pragma unroll
                for (int bj = 0; bj < 2; ++bj) wl[ai][m][bj] = *(const u32x4*)(SL + off + bj * HALF); }
        asm volatile("" ::: "memory");
#pragma unroll
        for (int ai = 0; ai < 2; ++ai)
#pragma unroll
            for (int m = 0; m < 4; ++m) { const size_t off = (size_t)(row0 + ai * HALF + m * 16) * 2048 + col0;
#pragma unroll
                for (int bj = 0; bj < 2; ++bj) {
                    f32x4 l0, l1; unpack8bf(wl[ai][m][bj], l0, l1);
                    st16(MG + off + bj * HALF, pack8bf(acc[ai][bj][m][0] * l0, acc[ai][bj][m][1] * l1));
                } }
    }
};

struct EpiG3 {
    static constexpr bool PERM = true, AFTER_DRAIN = false, HOOK = false;
    const float* X; float* OUT; bf16_t* X1G; float* SSQ; const float* gple; int hook_t;
    __device__ __forceinline__ void mid(f32x4 (&acc)[2][2][4][2], const Unit& u, int wr, int wc, int fr, int fq) const {}
    __device__ __forceinline__ void operator()(f32x4 (&acc)[2][2][4][2], const Unit& u, int wr, int wc, int fr, int fq) const {
        asm volatile("" : "+v"(fr), "+v"(fq)); const int row0 = u.pm * BM + wr * 64 + fr, col0 = u.pn * BM + wc * 32 + 8 * fq;
        f32x4 gv[2][2];
#pragma unroll
        for (int bj = 0; bj < 2; ++bj) { gv[bj][0] = *(const f32x4*)(gple + col0 + bj * HALF); gv[bj][1] = *(const f32x4*)(gple + col0 + bj * HALF + 4); }
#pragma unroll
        for (int ai = 0; ai < 2; ++ai) {
            f32x4 xl[4][2][2];
#pragma unroll
            for (int m = 0; m < 4; ++m) { const size_t off = (size_t)(row0 + ai * HALF + m * 16) * 2048 + col0;
#pragma unroll
                for (int bj = 0; bj < 2; ++bj) { xl[m][bj][0] = *(const f32x4*)(X + off + bj * HALF); xl[m][bj][1] = *(const f32x4*)(X + off + bj * HALF + 4); } }
            asm volatile("" ::: "memory");
#pragma unroll
            for (int m = 0; m < 4; ++m) { const int row = row0 + ai * HALF + m * 16; const size_t off = (size_t)row * 2048 + col0; float s = 0.f;
#pragma unroll
                for (int bj = 0; bj < 2; ++bj) {
                    const f32x4 x0 = xl[m][bj][0] + acc[ai][bj][m][0], x1 = xl[m][bj][1] + acc[ai][bj][m][1];
                    st16f(OUT + off + bj * HALF, x0); st16f(OUT + off + bj * HALF + 4, x1);
                    s += (x0[0] * x0[0] + x0[1] * x0[1]) + (x0[2] * x0[2] + x0[3] * x0[3]) + (x1[0] * x1[0] + x1[1] * x1[1]) + (x1[2] * x1[2] + x1[3] * x1[3]);
                    st16(X1G + off + bj * HALF, pack8bf(x0 * gv[bj][0], x1 * gv[bj][1]));
                }
                s += __shfl_xor(s, 16); s += __shfl_xor(s, 32);
                if (fq == 0) SSQ[(size_t)row * 32 + u.pn * 4 + wc] = s;
            }
            asm volatile("" ::: "memory");
        }
    }
};

struct EpiG4a {
    static constexpr bool PERM = true, AFTER_DRAIN = false, HOOK = false;
    bf16_t* PL; int hook_t;
    __device__ __forceinline__ void mid(f32x4 (&acc)[2][2][4][2], const Unit& u, int wr, int wc, int fr, int fq) const {}
    __device__ __forceinline__ void operator()(f32x4 (&acc)[2][2][4][2], const Unit& u, int wr, int wc, int fr, int fq) const {
        asm volatile("" : "+v"(fr), "+v"(fq)); const int row0 = u.pm * BM + wr * 64 + fr, col0 = u.pn * BM + wc * 32 + 8 * fq;
#pragma unroll
        for (int ai = 0; ai < 2; ++ai)
#pragma unroll
            for (int m = 0; m < 4; ++m) { const size_t off = (size_t)(row0 + ai * HALF + m * 16) * 2048 + col0;
#pragma unroll
                for (int bj = 0; bj < 2; ++bj) st16p(PL + off + bj * HALF, pack8bf(acc[ai][bj][m][0], acc[ai][bj][m][1])); }
    }
};

struct EpiG4b {
    static constexpr bool PERM = true, AFTER_DRAIN = false, HOOK = false;
    float* OUT; const bf16_t* PL; const float* SSQ; const float* bias; PG8_LAS float* scr; int hook_t;
    __device__ __forceinline__ void mid(f32x4 (&acc)[2][2][4][2], const Unit& u, int wr, int wc, int fr, int fq) const {}
    __device__ __forceinline__ void operator()(f32x4 (&acc)[2][2][4][2], const Unit& u, int wr, int wc, int fr, int fq) const {
        asm volatile("" : "+v"(fr), "+v"(fq)); const int row0 = u.pm * BM + wr * 64 + fr, col0 = u.pn * BM + wc * 32 + 8 * fq;
        {
            const int tid = threadIdx.x, hf = tid & 1; int rr = tid >> 1; asm volatile("" : "+v"(rr));
            f32x4 t = (f32x4){0.f, 0.f, 0.f, 0.f};
#pragma unroll
            for (int i = 0; i < 4; ++i) t += *(const f32x4*)(SSQ + (size_t)(u.pm * BM + rr) * 32 + hf * 16 + 4 * i);
            float s = (t[0] + t[1]) + (t[2] + t[3]); s += __shfl_xor(s, 1);
            if (hf == 0) scr[rr] = __builtin_amdgcn_rsqf(s * (1.0f / 2048.0f) + 1e-6f);
            asm volatile("s_waitcnt lgkmcnt(0)" ::: "memory"); __builtin_amdgcn_s_barrier(); asm volatile("" ::: "memory");
        }
        f32x4 bv[2][2];
#pragma unroll
        for (int bj = 0; bj < 2; ++bj) { bv[bj][0] = *(const f32x4*)(bias + col0 + bj * HALF); bv[bj][1] = *(const f32x4*)(bias + col0 + bj * HALF + 4); }
#pragma unroll
        for (int ai = 0; ai < 2; ++ai)
#pragma unroll
            for (int mp = 0; mp < 2; ++mp) {
                u32x4 wp[2][2]; f32x4 xo[2][2][2];
#pragma unroll
                for (int mm = 0; mm < 2; ++mm) { const size_t off = (size_t)(row0 + ai * HALF + (2 * mp + mm) * 16) * 2048 + col0;
#pragma unroll
                    for (int bj = 0; bj < 2; ++bj) { wp[mm][bj] = *(const u32x4*)(PL + off + bj * HALF); xo[mm][bj][0] = *(const f32x4*)(OUT + off + bj * HALF); xo[mm][bj][1] = *(const f32x4*)(OUT + off + bj * HALF + 4); } }
                asm volatile("" ::: "memory");
#pragma unroll
                for (int mm = 0; mm < 2; ++mm) { const int m = 2 * mp + mm; const size_t off = (size_t)(row0 + ai * HALF + m * 16) * 2048 + col0;
                    const float rstd = scr[ai * HALF + wr * 64 + m * 16 + fr];
#pragma unroll
                    for (int bj = 0; bj < 2; ++bj) {
                        f32x4 p0, p1; unpack8bf(wp[mm][bj], p0, p1);
                        f32x4 x0 = xo[mm][bj][0], x1 = xo[mm][bj][1];
                        const f32x4 z0 = acc[ai][bj][m][0] * rstd + bv[bj][0], z1 = acc[ai][bj][m][1] * rstd + bv[bj][1];
#pragma unroll
                        for (int j = 0; j < 4; ++j) { x0[j] += p0[j] * sigmoidf_(z0[j]); x1[j] += p1[j] * sigmoidf_(z1[j]); }
                        st16f(OUT + off + bj * HALF, x0); st16f(OUT + off + bj * HALF + 4, x1);
                    } }
                asm volatile("" ::: "memory");
            }
    }
};
template <class Epi, class Sched, bool ALIGN_EPI = false, bool SP2 = false>
__device__ __forceinline__ void gemm_phase(PG8_LAS unsigned char* lds, const Gemm g, const Sched& S, const Epi& E) {
    int tid_ = threadIdx.x; asm volatile("" : "+v"(tid_)); const int tid = tid_, wid = __builtin_amdgcn_readfirstlane(tid >> 6), lane = tid & 63, wr = wid >> 2, wc = wid & 3, fr = lane & 15, fq = lane >> 4;
    const int K = g.K, nt = K / BK;
    unsigned voffA[2], voffB[2];
#pragma unroll
    for (int i = 0; i < 2; ++i) { int R, C; stage_rc(tid * 16 + i * 8192, R, C); const int Rb = Epi::PERM ? ((R & ~31) + perm32(R & 31)) : R;
        voffA[i] = (unsigned)(R * K + C) * 2u; voffB[i] = (unsigned)(Rb * K + C) * 2u; }
    const size_t kstep = (size_t)(BK * 2);
    const size_t hstep = (size_t)HALF * K * 2;
    const size_t tstep = 2 * hstep;
    const unsigned ldsw = (unsigned)wid * 1024u;
    const int aoff = lds_byte(wr * 64 + fr, fq * 8), boff = lds_byte(wc * 32 + fr, fq * 8);
#define PG8_SA(b, h) (((b) * 2 + (h)) * HTB)
#define PG8_SB(b, h) ((4 + (b) * 2 + (h)) * HTB)
#define PG8_STAGE(bufoff, gbase, voff) do { _Pragma("unroll") for (int _i = 0; _i < 2; ++_i) \
        __builtin_amdgcn_global_load_lds((const unsigned*)((const char*)(gbase) + (voff)[_i]), (PG8_LAS unsigned*)(lds + (bufoff) + ldsw + _i * 8192), 16, 0, 0); } while (0)
#define PG8_LDA(dst, b, h) do { _Pragma("unroll") for (int m = 0; m < 4; ++m) _Pragma("unroll") for (int k = 0; k < 2; ++k) dst[m][k] = *(const PG8_LAS bf16x8*)(lds + PG8_SA(b, h) + aoff + m * 2048 + k * 1024); } while (0)
#define PG8_LDB(dst, b, h) do { _Pragma("unroll") for (int n = 0; n < 2; ++n) _Pragma("unroll") for (int k = 0; k < 2; ++k) dst[n][k] = *(const PG8_LAS bf16x8*)(lds + PG8_SB(b, h) + boff + n * 2048 + k * 1024); } while (0)
#define PG8_MMA(ai, bj, At, Bt) do { __builtin_amdgcn_s_setprio(1); _Pragma("unroll") for (int m = 0; m < 4; ++m) _Pragma("unroll") for (int n = 0; n < 2; ++n) _Pragma("unroll") for (int k = 0; k < 2; ++k) \
        acc[ai][bj][m][n] = __builtin_amdgcn_mfma_f32_16x16x32_bf16(Bt[n][k], At[m][k], acc[ai][bj][m][n], 0, 0, 0); __builtin_amdgcn_s_setprio(0); } while (0)
#define PG8_WAIT_V(n) asm volatile("s_waitcnt vmcnt(" #n ")" ::: "memory")
#define PG8_WAIT_L(n) asm volatile("s_waitcnt lgkmcnt(" #n ")" ::: "memory")
#define PG8_BAR __builtin_amdgcn_s_barrier()
#define PG8_SCHED __builtin_amdgcn_sched_barrier(0)
    Unit cur, nxt; int ui = 0;
    if (!S.next(0, cur)) return;
    f32x4 acc[2][2][4][2];
#pragma unroll
    for (int a = 0; a < 2; ++a)
#pragma unroll
        for (int b = 0; b < 2; ++b)
#pragma unroll
            for (int m = 0; m < 4; ++m)
#pragma unroll
                for (int n = 0; n < 2; ++n) acc[a][b][m][n] = (f32x4){0.f, 0.f, 0.f, 0.f};
    bf16x8 At[4][2], B0[2][2], B1[2][2];
    const char* cA = (const char*)g.A + (size_t)cur.pm * tstep; const char* cB = (const char*)g.Bt + (size_t)cur.pn * tstep;
    S.a_ready(cur);
    if constexpr (SP2) {
        PG8_STAGE(PG8_SB(0, 0), cB, voffB); PG8_STAGE(PG8_SB(0, 1), cB + hstep, voffB); PG8_STAGE(PG8_SA(0, 0), cA, voffA); PG8_STAGE(PG8_SA(0, 1), cA + hstep, voffA);
        if (wr == 1) PG8_BAR;
        PG8_WAIT_V(2); PG8_BAR;
        PG8_STAGE(PG8_SB(1, 0), cB + kstep, voffB); PG8_STAGE(PG8_SA(1, 0), cA + kstep, voffA); PG8_STAGE(PG8_SB(1, 1), cB + hstep + kstep, voffB);
        PG8_WAIT_V(6); PG8_BAR;
    } else {
        PG8_STAGE(PG8_SB(0, 0), cB, voffB); PG8_STAGE(PG8_SA(0, 0), cA, voffA); PG8_STAGE(PG8_SB(0, 1), cB + hstep, voffB); PG8_STAGE(PG8_SA(0, 1), cA + hstep, voffA);
        if (wr == 1) PG8_BAR;
        PG8_WAIT_V(4); PG8_BAR;
        PG8_STAGE(PG8_SB(1, 0), cB + kstep, voffB); PG8_STAGE(PG8_SA(1, 0), cA + kstep, voffA); PG8_STAGE(PG8_SB(1, 1), cB + hstep + kstep, voffB);
        PG8_WAIT_V(6); PG8_BAR;
    }
    for (;;) {
        const bool has_next = S.next(ui + 1, nxt);
        const char* nA = has_next ? (const char*)g.A + (size_t)nxt.pm * tstep : cA; const char* nB = has_next ? (const char*)g.Bt + (size_t)nxt.pn * tstep : cB;
        for (int t = 0; t < nt; t += 2) {
            const bool last = (t == nt - 2);
            if constexpr (Epi::HOOK) { if (t == E.hook_t) E.mid(acc, cur, wr, wc, fr, fq); }
            const char* a1 = cA + (size_t)(t + 1) * kstep;
            const char* a2 = last ? nA : cA + (size_t)(t + 2) * kstep; const char* b2 = last ? nB : cB + (size_t)(t + 2) * kstep;
            const char* a3 = a2 + kstep; const char* b3 = b2 + kstep;
            if (last && has_next) S.a_ready(nxt);
            if constexpr (SP2) {
            PG8_LDB(B0, 0, 0); PG8_LDB(B1, 0, 1); PG8_SCHED; PG8_LDA(At, 0, 0); PG8_STAGE(PG8_SA(1, 1), a1 + hstep, voffA);
            PG8_WAIT_V(8); PG8_WAIT_L(0); PG8_BAR; PG8_MMA(0, 0, At, B0); PG8_MMA(0, 1, At, B1); PG8_BAR; PG8_SCHED;
            PG8_LDA(At, 0, 1); PG8_STAGE(PG8_SB(0, 0), b2, voffB); PG8_STAGE(PG8_SB(0, 1), b2 + hstep, voffB); PG8_STAGE(PG8_SA(0, 0), a2, voffA);
            PG8_WAIT_V(8); PG8_WAIT_L(0); PG8_BAR; PG8_MMA(1, 0, At, B0); PG8_MMA(1, 1, At, B1); PG8_BAR; PG8_SCHED;
            PG8_LDB(B0, 1, 0); PG8_LDB(B1, 1, 1); PG8_SCHED; PG8_LDA(At, 1, 0); PG8_STAGE(PG8_SA(0, 1), a2 + hstep, voffA);
            PG8_WAIT_V(8); PG8_WAIT_L(0); PG8_BAR; PG8_MMA(0, 0, At, B0); PG8_MMA(0, 1, At, B1); PG8_BAR; PG8_SCHED;
            PG8_LDA(At, 1, 1); PG8_STAGE(PG8_SB(1, 0), b3, voffB); PG8_STAGE(PG8_SB(1, 1), b3 + hstep, voffB); PG8_STAGE(PG8_SA(1, 0), a3, voffA);
            PG8_WAIT_V(8); PG8_WAIT_L(0); PG8_BAR; PG8_MMA(1, 0, At, B0); PG8_MMA(1, 1, At, B1); PG8_BAR; PG8_SCHED;
            } else {
            PG8_LDB(B0, 0, 0); PG8_SCHED; PG8_LDA(At, 0, 0); PG8_STAGE(PG8_SA(1, 1), a1 + hstep, voffA);
            PG8_WAIT_L(8); PG8_BAR; PG8_WAIT_L(0); PG8_MMA(0, 0, At, B0); PG8_BAR; PG8_SCHED;
            PG8_LDB(B1, 0, 1); PG8_STAGE(PG8_SB(0, 0), b2, voffB);
            PG8_BAR; PG8_WAIT_L(0); PG8_MMA(0, 1, At, B1); PG8_BAR;
            PG8_LDA(At, 0, 1); PG8_STAGE(PG8_SA(0, 0), a2, voffA);
            PG8_BAR; PG8_WAIT_L(0); PG8_MMA(1, 0, At, B0); PG8_BAR; PG8_SCHED;
            PG8_STAGE(PG8_SB(0, 1), b2 + hstep, voffB);
            PG8_WAIT_V(6); PG8_BAR; PG8_MMA(1, 1, At, B1); PG8_BAR;
            PG8_LDB(B0, 1, 0); PG8_SCHED; PG8_LDA(At, 1, 0); PG8_STAGE(PG8_SA(0, 1), a2 + hstep, voffA);
            PG8_WAIT_L(8); PG8_BAR; PG8_WAIT_L(0); PG8_MMA(0, 0, At, B0); PG8_BAR; PG8_SCHED;
            PG8_LDB(B1, 1, 1); PG8_STAGE(PG8_SB(1, 0), b3, voffB);
            PG8_BAR; PG8_WAIT_L(0); PG8_MMA(0, 1, At, B1); PG8_BAR;
            PG8_LDA(At, 1, 1); PG8_STAGE(PG8_SA(1, 0), a3, voffA);
            PG8_BAR; PG8_WAIT_L(0); PG8_MMA(1, 0, At, B0); PG8_BAR; PG8_SCHED;
            PG8_STAGE(PG8_SB(1, 1), b3 + hstep, voffB);
            PG8_WAIT_V(6); PG8_BAR; PG8_MMA(1, 1, At, B1); PG8_BAR;
            }
        }
        if constexpr (ALIGN_EPI) { if (wr == 0) PG8_BAR; }
        if constexpr (!Epi::AFTER_DRAIN) { E(acc, cur, wr, wc, fr, fq); S.done(cur); }
        if (!has_next) break;
#pragma unroll
        for (int a = 0; a < 2; ++a)
#pragma unroll
            for (int b = 0; b < 2; ++b)
#pragma unroll
                for (int m = 0; m < 4; ++m)
#pragma unroll
                    for (int n = 0; n < 2; ++n) acc[a][b][m][n] = (f32x4){0.f, 0.f, 0.f, 0.f};
        cur = nxt; cA = nA; cB = nB; ++ui;
        if constexpr (ALIGN_EPI) { if (wr == 1) PG8_BAR; }
    }
    PG8_WAIT_V(0);
    if constexpr (!ALIGN_EPI) { if (wr == 0) PG8_BAR; }
    PG8_BAR;
#undef PG8_SA
#undef PG8_SB
#undef PG8_STAGE
#undef PG8_LDA
#undef PG8_LDB
#undef PG8_MMA
#undef PG8_WAIT_V
#undef PG8_WAIT_L
#undef PG8_BAR
#undef PG8_SCHED
}
}

namespace attn {
constexpr int D = 128;
constexpr float THR = 8.f;
constexpr bool WSKIP = false;
constexpr float SCALE = 0.08838834764831845f;
constexpr int NW = 8, QBLK = 32, KVBLK = 64, QB = NW * QBLK;
constexpr int SHM_V = KVBLK * D * 2, SHM_K = KVBLK * D * 2;
constexpr int LDS_BYTES = 2 * SHM_V + 2 * SHM_K + NW * 64 * 4;
constexpr int KM_OFF = 69632;
constexpr int LDO = 2048, LDG = 1024, STG_OFF = 73728;
#ifndef MOBA_ON
#define MOBA_ON 1
#endif
#ifndef GA_ON
#define GA_ON 1
#endif
using bf16 = __hip_bfloat16;
typedef short bf16x8 __attribute__((ext_vector_type(8)));
typedef short s16x4 __attribute__((ext_vector_type(4)));
typedef float f32x16 __attribute__((ext_vector_type(16)));
typedef float f32x4 __attribute__((ext_vector_type(4)));
typedef unsigned u32x4 __attribute__((ext_vector_type(4)));
template <class A, class Bt> struct same_t { static constexpr bool v = false; };
template <class A> struct same_t<A, A> { static constexpr bool v = true; };

#define KSWZ(row, colB) ((row) * 256 + ((colB) ^ (((row) & 7) << 4)))
#define SBAR() __builtin_amdgcn_sched_barrier(0)
__device__ __forceinline__ int v_st(int k, int c) { const int kk = (k & ~0xC) | ((k & 4) << 1) | ((k & 8) >> 1); return ((kk >> 3) * 4 + (c >> 5)) * 512 + ((kk & 7) * 32 + (c & 31)) * 2; }
__device__ __forceinline__ int v_rd_base(int lane) { return ((lane & 3) << 3) | (((lane >> 2) & 3) << 6) | (((lane >> 4) & 1) << 5) | (((lane >> 5) & 1) << 8); }
constexpr int v_rd_off(int d0, int ks, int half) { return d0 * 512 + ks * 4096 + half * 2048; }
__device__ __forceinline__ int crow(int r, int hi) { return (r & 3) + 8 * (r >> 2) + 4 * hi; }
__device__ __forceinline__ unsigned cvtpk(float lo, float hi) {
    unsigned r; asm volatile("v_cvt_pk_bf16_f32 %0, %1, %2" : "=v"(r) : "v"(lo), "v"(hi)); return r;
}
__device__ __forceinline__ bf16x8 pack8(f32x4 a, f32x4 b) {
    u32x4 w = {cvtpk(a[0], a[1]), cvtpk(a[2], a[3]), cvtpk(b[0], b[1]), cvtpk(b[2], b[3])};
    return *reinterpret_cast<bf16x8*>(&w);
}
template <class T> __device__ __forceinline__ bf16x8 load8(const T* p) {
    if constexpr (same_t<T, float>::v) { return pack8(*(const f32x4*)p, *(const f32x4*)(p + 4)); }
    else { return *reinterpret_cast<const bf16x8*>(p); }
}
__device__ __forceinline__ void mask_tile(f32x16& p0, f32x16& p1, int dq, unsigned W) {
    const float NEG = -__builtin_inff();
#pragma unroll
    for (int r = 0; r < 16; ++r) {
        const int c = (r & 3) + 8 * (r >> 2);
        if ((unsigned)(dq - c) >= W) p0[r] = NEG;
        if ((unsigned)(dq - c - 32) >= W) p1[r] = NEG;
    }
}
__device__ __forceinline__ void partialSM(bool dead, f32x16& p0, f32x16& p1, float& m_reg, float& mn, float& alpha) {
    float pmax = p0[0]; for (int r = 1; r < 16; ++r) pmax = fmaxf(pmax, p0[r]); for (int r = 0; r < 16; ++r) pmax = fmaxf(pmax, p1[r]);
    { auto rr = __builtin_amdgcn_permlane32_swap(__float_as_uint(pmax), __float_as_uint(pmax), false, false);
      pmax = fmaxf(__uint_as_float(rr[0]), __uint_as_float(rr[1])); }
    pmax = dead ? -__builtin_inff() : pmax;
    constexpr float C2 = 1.4426950408889634f * SCALE;
    if (__builtin_expect(__all((pmax - m_reg) * SCALE <= THR), 1)) { mn = m_reg; alpha = 1.f; }
    else { mn = fmaxf(m_reg, pmax); alpha = __builtin_amdgcn_exp2f((m_reg - mn) * C2); m_reg = mn; }
    const float mnL = dead ? -__builtin_inff() : -mn * C2;
    for (int r = 0; r < 16; ++r) p0[r] = fmaf(p0[r], C2, mnL); for (int r = 0; r < 16; ++r) p1[r] = fmaf(p1[r], C2, mnL);
    for (int r = 0; r < 16; ++r) p0[r] = __builtin_amdgcn_exp2f(p0[r]);
}
__device__ __forceinline__ void finishSM(f32x16& p0, f32x16& p1, float alpha, float& l_reg, bf16x8& pa0, bf16x8& pa1, bf16x8& pa2, bf16x8& pa3) {
    for (int r = 0; r < 16; ++r) p1[r] = __builtin_amdgcn_exp2f(p1[r]);
    float ps = 0; for (int r = 0; r < 16; ++r) ps += p0[r]; for (int r = 0; r < 16; ++r) ps += p1[r];
    { auto rr = __builtin_amdgcn_permlane32_swap(__float_as_uint(ps), __float_as_uint(ps), false, false);
      ps = __uint_as_float(rr[0]) + __uint_as_float(rr[1]); }
    l_reg = l_reg * alpha + ps;
#define PK4(P, B_, OUT) do { unsigned a0 = cvtpk(P[B_+0], P[B_+1]), a1 = cvtpk(P[B_+2], P[B_+3]);                          \
        unsigned b0 = cvtpk(P[B_+4], P[B_+5]), b1 = cvtpk(P[B_+6], P[B_+7]);                                             \
        auto r0 = __builtin_amdgcn_permlane32_swap(a0, b0, false, false); auto r1 = __builtin_amdgcn_permlane32_swap(a1, b1, false, false); \
        u32x4 w = {r0[0], r1[0], r0[1], r1[1]}; OUT = *reinterpret_cast<bf16x8*>(&w); } while (0)
    PK4(p0, 0, pa0); PK4(p0, 8, pa1); PK4(p1, 0, pa2); PK4(p1, 8, pa3);
#undef PK4
}
template <int KB, bool SK>
__device__ __forceinline__ void qkt(f32x16& p0, f32x16& p1, const char* K_lds, int r32, int hi, const bf16x8* qr, bool act) {
    if (SK && !act) { const float NEG = -__builtin_inff();
#pragma unroll
        for (int r = 0; r < 16; ++r) { p0[r] = NEG; p1[r] = NEG; } return; }
    p0 = f32x16{}; p1 = f32x16{};
    const char* kb[4];
#pragma unroll
    for (int dd = 0; dd < 4; ++dd) kb[dd] = K_lds + KB * SHM_K + KSWZ(r32, (dd * 16 + hi * 8) * 2);
#pragma unroll
    for (int d0 = 0; d0 < 8; ++d0) { const char* a = kb[d0 & 3] + (d0 >> 2) * 128;
        bf16x8 b0 = *reinterpret_cast<const bf16x8*>(a);
        bf16x8 b1 = *reinterpret_cast<const bf16x8*>(a + 32 * 256);
        p0 = __builtin_amdgcn_mfma_f32_32x32x16_bf16(b0, qr[d0], p0, 0, 0, 0);
        p1 = __builtin_amdgcn_mfma_f32_32x32x16_bf16(b1, qr[d0], p1, 0, 0, 0); }
}
template <int VB, bool SK>
__device__ __forceinline__ void pv_tile(f32x16* o, int vb0, bf16x8 pa0, bf16x8 pa1, bf16x8 pa2, bf16x8 pa3, bool act) {
    if (SK && !act) return;
#define TRRD(dst, off) asm volatile("ds_read_b64_tr_b16 %0, %1 offset:%2" : "=&v"(dst) : "v"(vb0), "i"(off) : "memory")
#define PV_D0(d0) do { s16x4 l0, l1, l2, l3, h0, h1, h2, h3; constexpr int b_ = VB * SHM_V + v_rd_off(d0, 0, 0);     \
        TRRD(l0, b_); TRRD(h0, b_ + 2048); TRRD(l1, b_ + 4096); TRRD(h1, b_ + 6144); TRRD(l2, b_ + 8192); TRRD(h2, b_ + 10240); TRRD(l3, b_ + 12288); TRRD(h3, b_ + 14336); \
        asm volatile("s_waitcnt lgkmcnt(0)" ::: "memory"); SBAR();                 \
        o[d0] = __builtin_amdgcn_mfma_f32_32x32x16_bf16(pa0, (bf16x8){l0[0], l0[1], l0[2], l0[3], h0[0], h0[1], h0[2], h0[3]}, o[d0], 0, 0, 0);   \
        o[d0] = __builtin_amdgcn_mfma_f32_32x32x16_bf16(pa1, (bf16x8){l1[0], l1[1], l1[2], l1[3], h1[0], h1[1], h1[2], h1[3]}, o[d0], 0, 0, 0);   \
        o[d0] = __builtin_amdgcn_mfma_f32_32x32x16_bf16(pa2, (bf16x8){l2[0], l2[1], l2[2], l2[3], h2[0], h2[1], h2[2], h2[3]}, o[d0], 0, 0, 0);   \
        o[d0] = __builtin_amdgcn_mfma_f32_32x32x16_bf16(pa3, (bf16x8){l3[0], l3[1], l3[2], l3[3], h3[0], h3[1], h3[2], h3[3]}, o[d0], 0, 0, 0); } while (0)
    PV_D0(0); PV_D0(1); PV_D0(2); PV_D0(3);
#undef PV_D0
#undef TRRD
}

template <class TIn, class TOut> struct BlockRef { const TIn* Q; const TIn* K; const TIn* V; TOut* O; int P0; const unsigned short* GA; const float* KM; int qb; };
template <class TIn> struct Seam {
    bf16x8 qr[8];
    bf16x8 st_v0, st_v1, st_k0, st_k1; f32x4 sf0, sf1, sf2, sf3;
    f32x4 tq[16];
};
__device__ __forceinline__ int swa_jlo(int P0, int W) { const int lowk = P0 - W + 1; return lowk > 0 ? lowk / KVBLK : 0; }
#define ROW(p, k0, rr) ((p) + (size_t)((k0) + (rr)) * D + sc)
#define VMW() asm volatile("s_waitcnt vmcnt(0)" ::: "memory")
#define VMWN(n) asm volatile("s_waitcnt vmcnt(%0)" :: "i"(n) : "memory")
#define SLOAD_H(Kp, Vp, k0) do { S.st_v0 = load8<TIn>(ROW(Vp, k0, sr)); S.st_v1 = load8<TIn>(ROW(Vp, k0, 32 + sr));              \
                         S.st_k0 = load8<TIn>(ROW(Kp, k0, sr)); S.st_k1 = load8<TIn>(ROW(Kp, k0, 32 + sr)); } while (0)
#define SWRITE_HK(bf) do { *(bf16x8*)(K_lds + (bf) * SHM_K + kws) = S.st_k0; *(bf16x8*)(K_lds + (bf) * SHM_K + kws + 32 * 256) = S.st_k1; } while (0)
#define SWRITE_HV(bf) do { *(bf16x8*)(V_lds + (bf) * SHM_V + vst0) = S.st_v0; *(bf16x8*)(V_lds + (bf) * SHM_V + vst1) = S.st_v1; } while (0)
#define SWRITE_H(bf) do { SWRITE_HV(bf); SWRITE_HK(bf); } while (0)
#define SLOAD_F(p, k0) do { S.sf0 = *(const f32x4*)ROW(p, k0, sr); S.sf1 = *(const f32x4*)(ROW(p, k0, sr) + 4);                \
                            S.sf2 = *(const f32x4*)ROW(p, k0, 32 + sr); S.sf3 = *(const f32x4*)(ROW(p, k0, 32 + sr) + 4); } while (0)
#define SWRITE_KF(bf) do { *(bf16x8*)(K_lds + (bf) * SHM_K + kws) = pack8(S.sf0, S.sf1); *(bf16x8*)(K_lds + (bf) * SHM_K + kws + 32 * 256) = pack8(S.sf2, S.sf3); } while (0)
#define SWRITE_VF(bf) do { *(bf16x8*)(V_lds + (bf) * SHM_V + vst0) = pack8(S.sf0, S.sf1); *(bf16x8*)(V_lds + (bf) * SHM_V + vst1) = pack8(S.sf2, S.sf3); } while (0)
template <class TIn, class TOut>
__device__ __forceinline__ void causal_swa_prime(const BlockRef<TIn, TOut>& cur, int W, char* lds, Seam<TIn>& S) {
    constexpr bool F32 = same_t<TIn, float>::v;
    int tid_ = threadIdx.x; asm volatile("" : "+v"(tid_)); const int tid = tid_, wid = __builtin_amdgcn_readfirstlane(tid >> 6), lane = tid & 63, r32 = lane & 31, hi = lane >> 5;
    const int sr = tid >> 4, sc = (tid & 15) * 8, kws = KSWZ(sr, sc * 2); char* K_lds = lds + 2 * SHM_V;
    const int kb0 = swa_jlo(cur.P0, W) * KVBLK;
    for (int d0 = 0; d0 < 8; ++d0) S.qr[d0] = load8<TIn>(cur.Q + (size_t)(wid * QBLK + r32) * D + d0 * 16 + hi * 8);
    if constexpr (F32) { SLOAD_F((const float*)cur.K, kb0); VMW(); SWRITE_KF(0); SBAR(); SLOAD_F((const float*)cur.V, kb0); }
    else { SLOAD_H(cur.K, cur.V, kb0); VMW(); SWRITE_HK(0); }
    __syncthreads();
}
template <class TIn, class TOut>
__device__ __forceinline__ void causal_swa_block(const BlockRef<TIn, TOut>& cur, const BlockRef<TIn, TOut>& nxt, int skv, int W, char* lds, Seam<TIn>& S) {
    constexpr bool F32 = same_t<TIn, float>::v;
    int tid_ = threadIdx.x; asm volatile("" : "+v"(tid_)); const int tid = tid_, wid = __builtin_amdgcn_readfirstlane(tid >> 6), lane = tid & 63, r32 = lane & 31, hi = lane >> 5;
    const int j_lo = swa_jlo(cur.P0, W);
    int j_hi = (cur.P0 + QB - 1) / KVBLK + 1; if (j_hi > skv / KVBLK) j_hi = skv / KVBLK;
    const int NT = j_hi - j_lo;
    const int kbn = swa_jlo(nxt.P0, W) * KVBLK;
    const int qlo = cur.P0 + wid * QBLK, qm = qlo + r32 - 4 * hi;
    char* V_lds = lds; char* K_lds = lds + 2 * SHM_V;
    float* ws = (float*)(lds + 2 * SHM_V + 2 * SHM_K) + wid * 64; float* li_l = ws, * al_l = ws + 32;
    float m_reg = -1e30f, l_reg = 0; f32x16 o[4] = {};
    const int sr = tid >> 4, sc = (tid & 15) * 8, vst0 = v_st(sr, sc), vst1 = v_st(32 + sr, sc), kws = KSWZ(sr, sc * 2);
    const int vb0 = (int)(uintptr_t)V_lds + v_rd_base(lane);
    const TIn* Kh = cur.K; const TIn* Vh = cur.V;
    unsigned pf0_ = 0u, pf1_ = 0u;
#define PREF(t, PF) do { asm volatile("" :: "v"(PF)); int tp_ = (t) + 2 + (wid >> 2); tp_ = tp_ < NT ? tp_ : NT - 1; \
        const char* pp_ = (const char*)((wid & 2) ? (const void*)Vh : (const void*)Kh) + (size_t)KBASE(tp_) * (D * 2) + (wid & 1) * 8192 + lane * 128; \
        PF = *(const __attribute__((address_space(1))) unsigned*)(unsigned long long)pp_; } while (0)
    unsigned selmask = 0xffu; const bool moba = cur.qb >= 4; bool mdead = false;
    {
        float* kml = (float*)(lds + KM_OFF);
        { float kv_[2];
#pragma unroll
          for (int i_ = 0; i_ < 2; ++i_) { const int idx = tid + i_ * 64 * NW, n_ = idx >> 7, d_ = idx & 127; kv_[i_] = (cur.KM[(size_t)n_ * 2048 + d_] + cur.KM[(size_t)n_ * 2048 + 1024 + d_]) * (1.0f / 256.0f); }
#pragma unroll
          for (int i_ = 0; i_ < 2; ++i_) ((__attribute__((address_space(3))) float*)kml)[tid + i_ * 64 * NW] = kv_[i_]; }
        __syncthreads();
        if (moba) {
            float g[7];
#pragma unroll
            for (int n_ = 0; n_ < 7; ++n_) { float s = 0.f;
                if (n_ < cur.qb) {
#pragma unroll
                    for (int d0 = 0; d0 < 8; ++d0) { const f32x4 k0 = *(const f32x4*)(kml + n_ * 128 + d0 * 16 + hi * 8), k1 = *(const f32x4*)(kml + n_ * 128 + d0 * 16 + hi * 8 + 4);
                        const bf16x8 qv = S.qr[d0];
#define B2F_(x) __uint_as_float(((unsigned)(unsigned short)(x)) << 16)
                        s += (B2F_(qv[0]) * k0[0] + B2F_(qv[1]) * k0[1]) + (B2F_(qv[2]) * k0[2] + B2F_(qv[3]) * k0[3]) + (B2F_(qv[4]) * k1[0] + B2F_(qv[5]) * k1[1]) + (B2F_(qv[6]) * k1[2] + B2F_(qv[7]) * k1[3]);
#undef B2F_
                    } }
                g[n_] = s + __shfl_xor(s, 32); }
            selmask = 0u;
#pragma unroll
            for (int rd = 0; rd < 3; ++rd) { float best = -__builtin_inff(); unsigned bi = 0u;
#pragma unroll
                for (int n_ = 0; n_ < 7; ++n_) { const bool ok = (n_ < cur.qb) && (((selmask >> n_) & 1u) == 0u) && (g[n_] > best); best = ok ? g[n_] : best; bi = ok ? (unsigned)n_ : bi; }
                selmask |= 1u << bi; }
        }
    }
#define RESC(a) do { if (__any((a) < 1.f)) { if (hi == 0) al_l[r32] = (a); asm volatile("s_waitcnt lgkmcnt(0)" ::: "memory");              \
                     for (int d_ = 0; d_ < 4; ++d_) for (int r = 0; r < 16; ++r) o[d_][r] *= al_l[crow(r, hi)]; } } while (0)
#define KBASE(t) ((j_lo + (t)) * KVBLK)
#define ACT(t) (KBASE(t) <= qlo + QBLK - 1 && KBASE(t) + KVBLK - 1 >= qlo - W + 1)
#define MASKT(P0_, P1_, t) do { const int kb_ = KBASE(t); if ((!SK || ACT(t)) && (kb_ + KVBLK - 1 > qlo || kb_ <= qlo + QBLK - 1 - W)) mask_tile(P0_, P1_, qm - kb_, (unsigned)W); \
        mdead = (MOBA_ON && moba && kb_ < cur.P0) ? (((selmask >> (kb_ >> 8)) & 1u) == 0u) : false; } while (0)
    constexpr int NQL = F32 ? 16 : 8;
    constexpr bool SK = WSKIP && !F32;
#define SEAM_K0() do { VMWN(NQL); if constexpr (F32) { SWRITE_KF(0); SBAR(); SLOAD_F((const float*)nxt.V, kbn); } else { SWRITE_HK(0); } SBAR(); } while (0)
    f32x16 pA0, pA1, pB0, pB1; float mnA, mnB, alA, alB; bf16x8 pa0, pa1, pa2, pa3;
    if constexpr (F32) { VMW(); SWRITE_VF(0); SBAR(); } else { SWRITE_HV(0); SBAR(); }
    if (NT > 1) { if constexpr (F32) SLOAD_F((const float*)Kh, KBASE(1)); else SLOAD_H(Kh, Vh, KBASE(1)); }
    SBAR(); qkt<0, SK>(pA0, pA1, K_lds, r32, hi, S.qr, ACT(0));
    if constexpr (F32) { if (NT > 1) { VMW(); SWRITE_KF(1); SBAR(); SLOAD_F((const float*)Vh, KBASE(1)); } }
    MASKT(pA0, pA1, 0); partialSM(mdead, pA0, pA1, m_reg, mnA, alA);
    if (NT > 1) { VMW(); if constexpr (F32) { SWRITE_VF(1); SBAR(); if (NT > 2) SLOAD_F((const float*)Kh, KBASE(2)); } else SWRITE_H(1); }
    __syncthreads();
#define HALF_STEP(PX0, PX1, mnX, alX, PY0, PY1, alY, t, KB, VB, SB) do {                                                      \
        SBAR(); qkt<KB, SK>(PX0, PX1, K_lds, r32, hi, S.qr, ACT(t));                                             \
        finishSM(PY0, PY1, alY, l_reg, pa0, pa1, pa2, pa3); SBAR();                                                           \
        if ((t) + 1 < NT) { if constexpr (F32) { VMW(); SWRITE_KF(SB); SBAR(); SLOAD_F((const float*)Vh, KBASE((t) + 1)); }  \
                            else { SLOAD_H(Kh, Vh, KBASE((t) + 1)); SBAR(); if (SB) PREF(t, pf1_); else PREF(t, pf0_); } SBAR(); }                                               \
        pv_tile<VB, SK>(o, vb0, pa0, pa1, pa2, pa3, ACT((t) - 1)); MASKT(PX0, PX1, (t)); partialSM(mdead, PX0, PX1, m_reg, mnX, alX);                                        \
        __syncthreads();                                                                                                      \
        if ((t) + 1 < NT) { if constexpr (F32) VMW(); else VMWN(1); if constexpr (F32) { SWRITE_VF(SB); SBAR(); if ((t) + 2 < NT) SLOAD_F((const float*)Kh, KBASE((t) + 2)); } \
                            else { SWRITE_H(SB); } }                                                                          \
        RESC(alX); __syncthreads(); } while (0)
    for (int t = 1; t + 1 < NT; t += 2) {
        HALF_STEP(pB0, pB1, mnB, alB, pA0, pA1, alA, t, 1, 0, 0);
        HALF_STEP(pA0, pA1, mnA, alA, pB0, pB1, alB, t + 1, 0, 1, 1);
    }
    const bool even = (NT & 1) == 0;
    if (even) { SBAR(); qkt<1, SK>(pB0, pB1, K_lds, r32, hi, S.qr, ACT(NT - 1)); SBAR(); }
#define QROW(e) (nxt.Q + (size_t)(wid * QBLK + r32) * D + ((e) >> 1) * 16 + hi * 8 + ((e) & 1) * 4)
    if constexpr (F32) { SLOAD_F((const float*)nxt.K, kbn); SBAR();
#pragma unroll
        for (int e = 0; e < 8; ++e) S.tq[e] = *(const f32x4*)QROW(e); }
    else { SLOAD_H(nxt.K, nxt.V, kbn); SBAR();
#pragma unroll
        for (int d0 = 0; d0 < 8; ++d0) S.qr[d0] = load8<TIn>(nxt.Q + (size_t)(wid * QBLK + r32) * D + d0 * 16 + hi * 8); }
    SBAR();
    finishSM(pA0, pA1, alA, l_reg, pa0, pa1, pa2, pa3); SBAR();
    if constexpr (F32) {
#pragma unroll
        for (int e = 8; e < 16; ++e) S.tq[e] = *(const f32x4*)QROW(e); SBAR(); }
#undef QROW
    pv_tile<0, SK>(o, vb0, pa0, pa1, pa2, pa3, ACT(even ? NT - 2 : NT - 1));
    if (even) { MASKT(pB0, pB1, NT - 1); partialSM(mdead, pB0, pB1, m_reg, mnB, alB); __syncthreads(); RESC(alB);
        finishSM(pB0, pB1, alB, l_reg, pa0, pa1, pa2, pa3); SBAR(); pv_tile<1, SK>(o, vb0, pa0, pa1, pa2, pa3, ACT(NT - 1)); }
    SBAR(); SEAM_K0();
    if (hi == 0) li_l[r32] = l_reg; asm volatile("s_waitcnt lgkmcnt(0)" ::: "memory");
    float rli[16];
#pragma unroll
    for (int r = 0; r < 16; ++r) rli[r] = __builtin_amdgcn_rcpf(li_l[crow(r, hi)]);
    { unsigned short* stg = (unsigned short*)(lds + STG_OFF) + wid * 4096;
      unsigned short* Ow = (unsigned short*)cur.O + (size_t)(wid * QBLK) * LDO; const unsigned short* Gw = cur.GA + (size_t)(wid * QBLK) * LDG;
      u32x4 gvv[8];
#pragma unroll
      for (int i = 0; i < 8; ++i) gvv[i] = *(const u32x4*)(Gw + (size_t)(i * 4 + (lane >> 4)) * LDG + (lane & 15) * 8);
#pragma unroll
      for (int r = 0; r < 16; ++r) { const int orow = crow(r, hi);
#pragma unroll
        for (int d0 = 0; d0 < 4; ++d0) { const float v = o[d0][r] * rli[r]; stg[orow * 128 + d0 * 32 + r32] = (unsigned short)(cvtpk(v, v) & 0xffffu); } }
      asm volatile("s_waitcnt lgkmcnt(0)" ::: "memory");
#pragma unroll
      for (int i = 0; i < 8; ++i) { const int row = i * 4 + (lane >> 4), ch = lane & 15;
          const u32x4 ov = *(const u32x4*)(stg + row * 128 + ch * 8); const u32x4 gv = gvv[i];
          u32x4 w;
#define MULPK_(a, b) cvtpk(__uint_as_float((a) << 16) * __uint_as_float((b) << 16), __uint_as_float((a) & 0xffff0000u) * __uint_as_float((b) & 0xffff0000u))
          w.x = MULPK_(ov.x, gv.x); w.y = MULPK_(ov.y, gv.y); w.z = MULPK_(ov.z, gv.z); w.w = MULPK_(ov.w, gv.w);
#undef MULPK_
          *(u32x4*)(Ow + (size_t)row * LDO + ch * 8) = w; } }
    if constexpr (F32) {
#pragma unroll
        for (int d0 = 0; d0 < 8; ++d0) S.qr[d0] = pack8(S.tq[2 * d0], S.tq[2 * d0 + 1]); }
    __syncthreads();
    asm volatile("" :: "v"(pf0_), "v"(pf1_));
#undef PREF
#undef RESC
#undef KBASE
#undef ACT
#undef MASKT
#undef SEAM_K0
#undef HALF_STEP
}
#undef ROW
#undef VMW
#undef VMWN
#undef SLOAD_H
#undef SWRITE_HK
#undef SWRITE_HV
#undef SWRITE_H
#undef SLOAD_F
#undef SWRITE_KF
#undef SWRITE_VF


typedef BlockRef<bf16, bf16> Ref;
__device__ __forceinline__ Ref make_ref(int L, const bf16* Q, const bf16* K, const bf16* V, bf16* Y, const bf16* GA, const float* KMP) {
    const int bh = L >> 3, qb = L & 7, b = bh >> 3, h = bh & 7; Ref r;
    r.Q = Q + ((size_t)bh * 2048 + (size_t)qb * QB) * D; r.K = K + (size_t)bh * 2048 * D; r.V = V + (size_t)bh * 2048 * D;
    r.O = Y + ((size_t)b * 2048 + (size_t)qb * QB) * LDO + h * 128; r.GA = (const unsigned short*)GA + ((size_t)b * 2048 + (size_t)qb * QB) * LDG + h * 128;
    r.P0 = qb * QB; r.KM = KMP + (size_t)b * 16 * 1024 + h * 128; r.qb = qb; return r;
}
__device__ __forceinline__ void phase(char* lds, const bf16* Q, const bf16* K, const bf16* V, bf16* Y, const bf16* GA, const float* KMP, int vcu, int G) {
    int L = vcu; if (L >= 256) return;
    Ref cur = make_ref(L, Q, K, V, Y, GA, KMP);
    Seam<bf16> S;
    causal_swa_prime<bf16, bf16>(cur, 2048, lds, S);
    for (;;) {
        const int Ln = L + G; const bool last = Ln >= 256;
        const Ref nxt = last ? cur : make_ref(Ln, Q, K, V, Y, GA, KMP);
        causal_swa_block<bf16, bf16>(cur, nxt, 2048, 2048, lds, S);
        if (last) break;
        cur = nxt; L = Ln;
    }
}
#undef KSWZ
#undef SBAR
}
#ifdef PROBE_TS
#ifndef PROBE_BLK
#define PROBE_BLK 0
#endif
#define LSTAMP(T, i) do { if (blockIdx.x == PROBE_BLK && threadIdx.x == 0) ((volatile unsigned long long*)((unsigned char*)(T).PUB - ((2u << 20) + (512u << 10)) + (600u << 10)))[i] = __builtin_amdgcn_s_memrealtime(); } while (0)
#else
#define LSTAMP(T, i) do { } while (0)
#endif
namespace lru {
#define LRU_LAS __attribute__((address_space(3)))
typedef short bf16x8 __attribute__((ext_vector_type(8)));
typedef float f32x4 __attribute__((ext_vector_type(4)));
typedef unsigned u32x4 __attribute__((ext_vector_type(4)));
typedef unsigned u32x2 __attribute__((ext_vector_type(2)));
constexpr int CH = 128  , XCP = 272  , LP = 36  ;
constexpr int OFF_XC = 0, OFF_WB = CH * XCP, OFF_A = OFF_WB + 256 * XCP, OFF_U = OFF_A + CH * LP * 4, OFF_SA = OFF_U + CH * LP * 4, OFF_SH = OFF_SA + 16 * 32 * 4, OFF_TA = OFF_SH + 16 * 32 * 4,
              OFF_TH = OFF_TA + 128 * 4, OFF_CR = OFF_TH + 128 * 4, OFF_CT = OFF_CR + 128 * 4, LRU_LDS = OFF_CT + 1024 * 4;
constexpr int CT_BR = 0, CT_BI = 128, CT_C8 = 256, CT_CW = 384, CT_CB = 896;
__device__ __forceinline__ float b2f(unsigned short x) { return __uint_as_float(((unsigned)x) << 16); }
__device__ __forceinline__ unsigned cvtpk(float lo, float hi) { unsigned r; asm volatile("v_cvt_pk_bf16_f32 %0, %1, %2" : "=v"(r) : "v"(lo), "v"(hi)); return r; }
struct Tensors { const unsigned short* XR; const unsigned short* GL; unsigned short* Y; unsigned short* Q1; const unsigned short* WrT; const unsigned short* WiT;
                 const float *cw, *cb, *br, *bi, *c8; float* PUB; unsigned* FLG; };
__device__ __forceinline__ int unit_tc(int q, int r) { const int base = (r == 0) ? 0 : (r == 1) ? 7 : (r == 2) ? 12 : 15, width = (r == 0) ? 7 : (r == 1) ? 5 : (r == 2) ? 3 : 1; return q < width ? base + q : -1; }

__device__ __forceinline__ void load_weights(LRU_LAS unsigned char* lds, const Tensors& T, int n) {
    const int tid = threadIdx.x;
#pragma unroll
    for (int i = 0; i < 8; ++i) { const int p = tid + 512 * i, o = p >> 4, c = p & 15;
        const unsigned short* src = (o < 128 ? T.WrT : T.WiT) + ((size_t)n * 128 + (o & 127)) * 128 + c * 8;
        *(LRU_LAS u32x4*)(lds + OFF_WB + o * XCP + c * 16) = *(const u32x4*)src; }
    if (tid < 128) { LRU_LAS float* CT = (LRU_LAS float*)(lds + OFF_CT); const int ch = n * 128 + tid;
        CT[CT_BR + tid] = T.br[ch]; CT[CT_BI + tid] = T.bi[ch]; CT[CT_C8 + tid] = T.c8[ch]; CT[CT_CB + tid] = T.cb[ch];
#pragma unroll
        for (int k = 0; k < 4; ++k) CT[CT_CW + k * 128 + tid] = T.cw[k * 1024 + ch]; }
    __syncthreads();
}

struct Raw { u32x4 w[4][4]; };
__device__ __forceinline__ void load_raw(const Tensors& T, int g, int tc, Raw& R) {
    const int tid = threadIdx.x, cg = tid & 15, trow = tid >> 4, b = g >> 3, n = g & 7; const int chb = n * 128 + cg * 8; const size_t rowb = (size_t)b * 2048;
#pragma unroll
    for (int i = 0; i < 4; ++i)
#pragma unroll
        for (int k = 0; k < 4; ++k) { const int tt = tc * CH + trow + 32 * i - 3 + k;
            R.w[i][k] = (u32x4){0u, 0u, 0u, 0u};
            if (tt >= 0) R.w[i][k] = *(const u32x4*)(T.XR + (rowb + tt) * 1024 + chb); }
}
__device__ __forceinline__ void conv_stage(LRU_LAS unsigned char* lds, const Tensors& T, int g, const Raw& R) {
    const int tid = threadIdx.x, cg = tid & 15, trow = tid >> 4, n = g & 7; const int chb = n * 128 + cg * 8;
    float cw[4][8], cb[8]; const LRU_LAS float* CT = (const LRU_LAS float*)(lds + OFF_CT);
#pragma unroll
    for (int k = 0; k < 4; ++k) { const f32x4 a = *(const LRU_LAS f32x4*)(CT + CT_CW + k * 128 + cg * 8), c = *(const LRU_LAS f32x4*)(CT + CT_CW + k * 128 + cg * 8 + 4);
#pragma unroll
        for (int j = 0; j < 4; ++j) { cw[k][j] = a[j]; cw[k][4 + j] = c[j]; } }
    { const f32x4 a = *(const LRU_LAS f32x4*)(CT + CT_CB + cg * 8), c = *(const LRU_LAS f32x4*)(CT + CT_CB + cg * 8 + 4);
#pragma unroll
      for (int j = 0; j < 4; ++j) { cb[j] = a[j]; cb[4 + j] = c[j]; } }
#pragma unroll
    for (int i = 0; i < 4; ++i) { const int tok = trow + 32 * i;
        float acc8[8];
#pragma unroll
        for (int j = 0; j < 8; ++j) acc8[j] = cb[j];
#pragma unroll
        for (int k = 0; k < 4; ++k) { const u32x4 w = R.w[i][k];
            acc8[0] += cw[k][0] * __uint_as_float(w.x << 16); acc8[1] += cw[k][1] * __uint_as_float(w.x & 0xffff0000u);
            acc8[2] += cw[k][2] * __uint_as_float(w.y << 16); acc8[3] += cw[k][3] * __uint_as_float(w.y & 0xffff0000u);
            acc8[4] += cw[k][4] * __uint_as_float(w.z << 16); acc8[5] += cw[k][5] * __uint_as_float(w.z & 0xffff0000u);
            acc8[6] += cw[k][6] * __uint_as_float(w.w << 16); acc8[7] += cw[k][7] * __uint_as_float(w.w & 0xffff0000u); }
        u32x4 o; o.x = cvtpk(acc8[0], acc8[1]); o.y = cvtpk(acc8[2], acc8[3]); o.z = cvtpk(acc8[4], acc8[5]); o.w = cvtpk(acc8[6], acc8[7]);
        *(LRU_LAS u32x4*)(lds + OFF_XC + tok * XCP + cg * 16) = o; }
    __syncthreads();
}
__device__ __forceinline__ void publish(LRU_LAS unsigned char* lds, const Tensors& T, int g, int tc) {
    const int tid = threadIdx.x; LRU_LAS float* TA = (LRU_LAS float*)(lds + OFF_TA); LRU_LAS float* TH = (LRU_LAS float*)(lds + OFF_TH);
    if (tid < 128) { float* pub = T.PUB + (size_t)(g * 16 + tc) * 256;
        __hip_atomic_store(pub + tid, TA[tid], __ATOMIC_RELAXED, __HIP_MEMORY_SCOPE_AGENT); __hip_atomic_store(pub + 128 + tid, TH[tid], __ATOMIC_RELAXED, __HIP_MEMORY_SCOPE_AGENT); }
    asm volatile("s_waitcnt vmcnt(0)" ::: "memory");
    __syncthreads();
    if (tid == 0) __hip_atomic_store(T.FLG + (size_t)(g * 16 + tc) * 16, 1u, __ATOMIC_RELAXED, __HIP_MEMORY_SCOPE_AGENT);
}
__device__ __forceinline__ void gate_stage(LRU_LAS unsigned char* lds, const Tensors& T, int g, int tc) {
    int tid_ = threadIdx.x; asm volatile("" : "+v"(tid_)); const int tid = tid_, lane = tid & 63, wid = __builtin_amdgcn_readfirstlane(tid >> 6), fr = lane & 15, fq = lane >> 4;
    const int b = g >> 3, n = g & 7;
    LRU_LAS float* LA = (LRU_LAS float*)(lds + OFF_A); LRU_LAS float* LU = (LRU_LAS float*)(lds + OFF_U);
    LRU_LAS float* SA = (LRU_LAS float*)(lds + OFF_SA); LRU_LAS float* SH = (LRU_LAS float*)(lds + OFF_SH);
    LRU_LAS float* TA = (LRU_LAS float*)(lds + OFF_TA); LRU_LAS float* TH = (LRU_LAS float*)(lds + OFF_TH);
    const size_t rowb = (size_t)b * 2048; const int t0 = tc * CH;
    const int tok = 16 * wid + fr;
    bf16x8 af[4];
#pragma unroll
    for (int ks = 0; ks < 4; ++ks) af[ks] = *(const LRU_LAS bf16x8*)(lds + OFF_XC + tok * XCP + (ks * 32 + fq * 8) * 2);
    const int se = tid & 31, sg = tid >> 5;
#pragma unroll 1
    for (int es = 0; es < 4; ++es) {
        LSTAMP(T, 30);
        const size_t chn = (size_t)n * 128 + es * 32 + se;
        unsigned short glr[8];
#pragma unroll
        for (int j = 0; j < 8; ++j) glr[j] = T.GL[(rowb + t0 + sg * 8 + j) * 1024 + chn];
        {
            f32x4 ar[2], ai_[2];
#pragma unroll
            for (int nb = 0; nb < 2; ++nb) { ar[nb] = (f32x4){0.f, 0.f, 0.f, 0.f}; ai_[nb] = (f32x4){0.f, 0.f, 0.f, 0.f}; }
#pragma unroll
            for (int ks = 0; ks < 4; ++ks)
#pragma unroll
                for (int nb = 0; nb < 2; ++nb) {
                    const bf16x8 wr_ = *(const LRU_LAS bf16x8*)(lds + OFF_WB + (es * 32 + nb * 16 + fr) * XCP + (ks * 32 + fq * 8) * 2);
                    const bf16x8 wi_ = *(const LRU_LAS bf16x8*)(lds + OFF_WB + (128 + es * 32 + nb * 16 + fr) * XCP + (ks * 32 + fq * 8) * 2);
                    ar[nb] = __builtin_amdgcn_mfma_f32_16x16x32_bf16(wr_, af[ks], ar[nb], 0, 0, 0);
                    ai_[nb] = __builtin_amdgcn_mfma_f32_16x16x32_bf16(wi_, af[ks], ai_[nb], 0, 0, 0); }
#pragma unroll
            for (int nb = 0; nb < 2; ++nb) {
                const LRU_LAS float* CT = (const LRU_LAS float*)(lds + OFF_CT) + es * 32 + nb * 16 + fq * 4;
                const f32x4 vbr = *(const LRU_LAS f32x4*)(CT + CT_BR), vbi = *(const LRU_LAS f32x4*)(CT + CT_BI), vc8 = *(const LRU_LAS f32x4*)(CT + CT_C8);
                const u32x2 xw = *(const LRU_LAS u32x2*)(lds + OFF_XC + tok * XCP + (es * 32 + nb * 16 + fq * 4) * 2);
                const float xv[4] = {__uint_as_float(xw.x << 16), __uint_as_float(xw.x & 0xffff0000u), __uint_as_float(xw.y << 16), __uint_as_float(xw.y & 0xffff0000u)};
                f32x4 av, uv;
#pragma unroll
                for (int j = 0; j < 4; ++j) {
                    const float dr = 1.0f + __expf(-(ar[nb][j] + vbr[j])), di = 1.0f + __expf(-(ai_[nb][j] + vbi[j]));
                    const float rc = __builtin_amdgcn_rcpf(dr * di);
                    const float r = rc * di, ig = rc * dr;
                    const float la = -r * vc8[j];
                    const float a = __expf(la);
                    const float y = -2.0f * la;
                    const float om = (y < 0.02f) ? y * (1.0f - y * 0.5f * (1.0f - y * (1.0f / 3.0f))) : (1.0f - a * a);
                    av[j] = a;
                    uv[j] = __builtin_amdgcn_sqrtf(om) * (ig * xv[j]);
                }
                *(LRU_LAS f32x4*)(LA + tok * LP + nb * 16 + fq * 4) = av; *(LRU_LAS f32x4*)(LU + tok * LP + nb * 16 + fq * 4) = uv;
            }
        }
        LSTAMP(T, 34);
        __syncthreads();
        LSTAMP(T, 31);
        float a8[8], u8[8];
        { float A = 1.f, Hh = 0.f;
#pragma unroll
          for (int j = 0; j < 8; ++j) { a8[j] = LA[(sg * 8 + j) * LP + se]; u8[j] = LU[(sg * 8 + j) * LP + se]; Hh = a8[j] * Hh + u8[j]; A *= a8[j]; }
          SA[sg * 32 + se] = A; SH[sg * 32 + se] = Hh; }
        __syncthreads();
        LSTAMP(T, 32);
        { float h = 0.f, Ap = 1.f;
#pragma unroll
          for (int s2 = 0; s2 < 15; ++s2) { const bool on_ = s2 < sg; const float sa = on_ ? SA[s2 * 32 + se] : 1.0f, sh = on_ ? SH[s2 * 32 + se] : 0.0f; h = sa * h + sh; Ap *= sa; }
#pragma unroll
          for (int j = 0; j < 8; ++j) { h = a8[j] * h + u8[j]; Ap *= a8[j]; const size_t row = rowb + t0 + sg * 8 + j;
              const float gl = b2f(glr[j]);
              const float y = h * gl, q = Ap * gl;
              const float yn = __int_as_float(__builtin_amdgcn_mov_dpp(__float_as_int(y), 0xB1, 0xF, 0xF, true)), qn = __int_as_float(__builtin_amdgcn_mov_dpp(__float_as_int(q), 0xB1, 0xF, 0xF, true));
              if ((se & 1) == 0) { *(unsigned*)(T.Y + row * 2048 + 1024 + chn) = cvtpk(y, yn); *(unsigned*)(T.Q1 + row * 1024 + chn) = cvtpk(q, qn); } }
          if (sg == 15) { TA[es * 32 + se] = Ap; TH[es * 32 + se] = h; } }
        LSTAMP(T, 33);
    }
    __syncthreads();
}

__device__ __forceinline__ void fix(LRU_LAS unsigned char* lds, const Tensors& T, int g, int tc) {
    if (tc == 0) return;
    const int tid = threadIdx.x; LRU_LAS float* CR = (LRU_LAS float*)(lds + OFF_CR);
    const int b = g >> 3, n = g & 7; const size_t rowb = (size_t)b * 2048 + tc * CH;
    const int cg = tid & 15, trow = tid >> 4;
    u32x4 yv[4], qv[4];
#pragma unroll
    for (int i = 0; i < 4; ++i) { const size_t row = rowb + trow + 32 * i;
        yv[i] = *(const u32x4*)(T.Y + row * 2048 + 1024 + n * 128 + cg * 8); qv[i] = *(const u32x4*)(T.Q1 + row * 1024 + n * 128 + cg * 8); }
    if (tid < tc) { unsigned sp = 0; while (__hip_atomic_load(T.FLG + (size_t)(g * 16 + tid) * 16, __ATOMIC_RELAXED, __HIP_MEMORY_SCOPE_AGENT) == 0u) { __builtin_amdgcn_s_sleep(2); if (++sp > (1u << 22)) break; } }
    __syncthreads();
    if (tid < 128) { float c = 0.f; float pa[15], ph[15];
#pragma unroll
        for (int t2 = 0; t2 < 15; ++t2) { pa[t2] = 1.f; ph[t2] = 0.f;
            if (t2 < tc) { const float* pub = T.PUB + (size_t)(g * 16 + t2) * 256;
                pa[t2] = __hip_atomic_load(pub + tid, __ATOMIC_RELAXED, __HIP_MEMORY_SCOPE_AGENT); ph[t2] = __hip_atomic_load(pub + 128 + tid, __ATOMIC_RELAXED, __HIP_MEMORY_SCOPE_AGENT); } }
#pragma unroll
        for (int t2 = 0; t2 < 15; ++t2) c = pa[t2] * c + ph[t2];
        CR[tid] = c; }
    __syncthreads();
    f32x4 c0 = *(const LRU_LAS f32x4*)(CR + cg * 8), c1 = *(const LRU_LAS f32x4*)(CR + cg * 8 + 4);
#pragma unroll
    for (int i = 0; i < 4; ++i) { const size_t row = rowb + trow + 32 * i;
        unsigned short* yp = T.Y + row * 2048 + 1024 + n * 128 + cg * 8; u32x4 o;
#define FIX2_(y, q, ca, cb_) cvtpk(__uint_as_float((y) << 16) + __uint_as_float((q) << 16) * (ca), __uint_as_float((y) & 0xffff0000u) + __uint_as_float((q) & 0xffff0000u) * (cb_))
        o.x = FIX2_(yv[i].x, qv[i].x, c0[0], c0[1]); o.y = FIX2_(yv[i].y, qv[i].y, c0[2], c0[3]); o.z = FIX2_(yv[i].z, qv[i].z, c1[0], c1[1]); o.w = FIX2_(yv[i].w, qv[i].w, c1[2], c1[3]);
#undef FIX2_
        *(u32x4*)yp = o; }
    __syncthreads();
}
}

namespace cg = cooperative_groups;
#ifndef ALIGN_SINGLE
#define ALIGN_SINGLE true
#endif
#ifndef REP_P0
#define REP_P0 1
#endif
#ifndef REP_P1
#define REP_P1 1
#endif
#ifndef REP_LRU
#define REP_LRU 1
#endif
#ifndef REP_ATT
#define REP_ATT 1
#endif
#ifndef REP_P3
#define REP_P3 1
#endif
#ifndef REP_P4
#define REP_P4 1
#endif
#ifndef EXTRA_SYNC
#define EXTRA_SYNC 0
#endif
constexpr int NWAVES = 8;
constexpr int BATCH = 4, SEQ = 2048, DM = 2048, M = BATCH * SEQ, DIN = 10240, AW = 1024, LW = 1024, PLE = 256, NH = 8, HD = 128;
constexpr size_t MiB = 1u << 20;
constexpr size_t WS_BAR = 512 * 1024, BAR_BYTES = 16384, WS_FLG = WS_BAR + BAR_BYTES, FLG_BYTES = 32768, WS_C8 = 576 * 1024, WS_PUB = 2 * MiB + 512 * 1024, WS_Q1 = 296 * MiB;
constexpr size_t WS_KMP = 0, WS_SSQ = 1 * MiB, WS_WRT = 2 * MiB, WS_WIT = 2 * MiB + 256 * 1024, WS_WPLE = 3 * MiB, WS_W2 = 4 * MiB, WS_WOUT = 12 * MiB, WS_WG = 20 * MiB, WS_WIN = 28 * MiB,
                 WS_H = 68 * MiB, WS_MG = 68 * MiB, WS_PB = 100 * MiB, WS_Q = 104 * MiB, WS_K = 120 * MiB, WS_V = 136 * MiB, WS_GA = 152 * MiB, WS_XR = 168 * MiB, WS_GL = 184 * MiB,
                 WS_SA = 200 * MiB, WS_SL = 232 * MiB, WS_Y = 264 * MiB, WS_X1G = 104 * MiB, WS_PL = 136 * MiB, WS_END = 312 * MiB;
static_assert(WS_K == WS_Q + 16 * MiB && WS_V == WS_Q + 32 * MiB && WS_GA == WS_Q + 48 * MiB && WS_XR == WS_Q + 64 * MiB && WS_GL == WS_Q + 80 * MiB && WS_SA == WS_Q + 96 * MiB && WS_SL == WS_SA + 32 * MiB, "EpiG1 destination arithmetic");
constexpr int RING_BYTES = 131072, SCR_OFF = RING_BYTES, KM_LDS_OFF = 69632;
constexpr int LDS_BYTES = 155648, MISC_OFF = LDS_BYTES - 64;
static_assert(attn::STG_OFF + 65536 <= LDS_BYTES && attn::KM_OFF == KM_LDS_OFF && attn::KM_OFF + 4096 <= attn::STG_OFF, "attention LDS map");
static_assert(attn::LDS_BYTES <= KM_LDS_OFF && KM_LDS_OFF + 4096 <= RING_BYTES && lru::LRU_LDS <= MISC_OFF && SCR_OFF + 8192 <= LDS_BYTES, "LDS map");

#define GAS __attribute__((address_space(1)))
#define LAS __attribute__((address_space(3)))
typedef unsigned short bf16;
typedef unsigned v4u __attribute__((ext_vector_type(4)));
typedef float f32x4 __attribute__((ext_vector_type(4)));
#define LDS_WAIT() asm volatile("s_waitcnt lgkmcnt(0)" ::: "memory")
__device__ __forceinline__ unsigned f2bf(float f) { unsigned u = __builtin_bit_cast(unsigned, f); return (u + 0x7fffu + ((u >> 16) & 1u)) >> 16; }
__device__ __forceinline__ unsigned pk2(float lo, float hi) { return f2bf(lo) | (f2bf(hi) << 16); }
__device__ __forceinline__ float wave_sum(float v) {
#pragma unroll
    for (int o = 1; o < 64; o <<= 1) v += __shfl_xor(v, o);
    return v;
}
__device__ __forceinline__ void p0_transpose_item(const float* W, int N, bf16* WT, int ldk, int row_off, int k_off, LAS float* scr, int kb, int nb, int lane) {
    const int k0 = 64 * kb, n0 = 32 * nb;
#pragma unroll 8
    for (int i = 0; i < 32; ++i) { const int kk = 2 * i + (lane >> 5); scr[kk * 33 + (lane & 31)] = W[(size_t)(k0 + kk) * N + n0 + (lane & 31)]; }
    LDS_WAIT(); asm volatile("" ::: "memory");
    const int c = lane & 7;
#pragma unroll
    for (int j = 0; j < 4; ++j) { const int n = (lane >> 3) + 8 * j; const LAS float* s = scr + (8 * c) * 33 + n;
        v4u o; o.x = pk2(s[0 * 33], s[1 * 33]); o.y = pk2(s[2 * 33], s[3 * 33]); o.z = pk2(s[4 * 33], s[5 * 33]); o.w = pk2(s[6 * 33], s[7 * 33]);
        *(GAS v4u*)(WT + (size_t)(row_off + n0 + n) * ldk + k_off + k0 + 8 * c) = o; }
    LDS_WAIT(); asm volatile("" ::: "memory");
}

#define RLX_AGENT __ATOMIC_RELAXED, __HIP_MEMORY_SCOPE_AGENT
#define XB_TMO      128
#define XB_XCNT(j)  (256  + 64 * (j))
#define XB_XSUB(j)  (1280 + 64 * (j))
#define XB_XGEN(j)  (2304 + 64 * (j))
#define XB_TOP      3328
#define XB_TOPGEN   3392
#define XCD_BAR_WORDS 3456
#define XB_SPIN_CAP (1u << 18)

__device__ __forceinline__ unsigned xb_ld(unsigned* p)              { return __hip_atomic_load(p, __ATOMIC_RELAXED, __HIP_MEMORY_SCOPE_AGENT); }
__device__ __forceinline__ unsigned xb_add(unsigned* p, unsigned v) { return __hip_atomic_fetch_add(p, v, __ATOMIC_RELAXED, __HIP_MEMORY_SCOPE_AGENT); }
__device__ __forceinline__ unsigned xb_xcc_id() { return (unsigned)__builtin_amdgcn_s_getreg((3 << 11) | 20) & 0xFu; }
#define XB_SPIN(cond, bar) do { unsigned _sp = 0; while (cond) { __builtin_amdgcn_s_sleep(1); \
    if ((++_sp & 255u) == 0u) { if (xb_ld(&(bar)[XB_TMO])) break; if (_sp > XB_SPIN_CAP) { atomicAdd(&(bar)[XB_TMO], 1u); break; } } } } while (0)

struct XcdBarrier {
    unsigned* bar; unsigned x;
    volatile LAS unsigned* st;
};

__device__ __forceinline__ XcdBarrier xcd_barrier_post(unsigned* bar, volatile LAS unsigned* st) {
    XcdBarrier b; b.bar = bar; b.x = xb_xcc_id(); b.st = st;
    if (threadIdx.x == 0) (void)xb_add(&bar[XB_XCNT(b.x)], 1u);
    return b;
}
__device__ __forceinline__ void xcd_barrier_complete(unsigned* bar, unsigned x, unsigned& nloc, unsigned& nx) {
    const unsigned G = gridDim.x * gridDim.y * gridDim.z;
    unsigned sum, cnt, mine, sp = 0u;
    for (;;) {
        sum = 0u; cnt = 0u; mine = 0u;
#pragma unroll
        for (unsigned j = 0; j < 16; ++j) { const unsigned c = xb_ld(&bar[XB_XCNT(j)]); sum += c; cnt += (c > 0u) ? 1u : 0u; mine = (j == x) ? c : mine; }
        if (sum == G) break;
        __builtin_amdgcn_s_sleep(1);
        if ((++sp & 255u) == 0u) { if (xb_ld(&bar[XB_TMO])) break; if (sp > XB_SPIN_CAP) { atomicAdd(&bar[XB_TMO], 1u); break; } }
    }
    nloc = mine > 0u ? mine : 1u; nx = cnt > 0u ? cnt : 1u;
}

__device__ __forceinline__ void xcd_barrier(const XcdBarrier& b) {
    asm volatile("s_waitcnt vmcnt(0)" ::: "memory");
    __syncthreads();
    if (threadIdx.x == 0) {
        unsigned* bar = b.bar;
        __builtin_amdgcn_s_waitcnt(0);
        unsigned nloc = b.st[0], nx = b.st[1];
        if (nloc == 0u) { xcd_barrier_complete(bar, b.x, nloc, nx); b.st[0] = nloc; b.st[1] = nx; }
        const unsigned old = xb_add(&bar[XB_XSUB(b.x)], 1u);
        const unsigned gen = old / nloc;
        if (old + 1u == (gen + 1u) * nloc) {
            __builtin_amdgcn_fence(__ATOMIC_RELEASE, "agent");
            asm volatile("s_waitcnt vmcnt(0)" ::: "memory");
            const unsigned og = xb_add(&bar[XB_TOP], 1u);
            const unsigned tg = og / nx;
            if (og + 1u == (tg + 1u) * nx) xb_add(&bar[XB_TOPGEN], 1u);
            else XB_SPIN(xb_ld(&bar[XB_TOPGEN]) == tg, bar);
            __builtin_amdgcn_fence(__ATOMIC_ACQUIRE, "agent");
            xb_add(&bar[XB_XGEN(b.x)], 1u);
            asm volatile("s_waitcnt vmcnt(0)" ::: "memory");
        } else {
            XB_SPIN(xb_ld(&bar[XB_XGEN(b.x)]) == gen, bar);
            __builtin_amdgcn_fence(__ATOMIC_ACQUIRE, "agent");
            asm volatile("s_waitcnt vmcnt(0)" ::: "memory");
        }
    }
    __syncthreads();
}

struct Args { const float* in[20]; float* out; unsigned char* ws; };

__device__ __forceinline__ void p0_prologue(const Args& args, LAS unsigned char* ldsl, int vcu, int G, int wave, int lane, bf16* Win_t, bf16* W2_t, bf16* Wout_t, bf16* Wg_t, bf16* Wple_t, bf16* Wr_t, bf16* Wi_t, bf16* Hb, bf16* PB, float* C8) {
    {
        LAS float* scr = (LAS float*)(ldsl + wave * 16384);
        const int gw = vcu * NWAVES + wave, NGW = G * NWAVES;
        constexpr int I0 = 32 * 320, I1 = 16 * 64, I2 = 16 * 64, I3 = 32 * 64, I4 = 32 * 64, I5 = 4 * 64, I6 = 64, I7 = 64;
        constexpr int NITEMS = I0 + I1 + I2 + I3 + I4 + I5 + I6 + I7;
        for (int it = gw; it < NITEMS; it += NGW) {
            int r = it;
            if (r < I0) { p0_transpose_item(args.in[3], DIN, Win_t, 2048, 0, 0, scr, r / 320, r % 320, lane); continue; } r -= I0;
            if (r < I1) { p0_transpose_item(args.in[13], DM, W2_t, 2048, 0, 0, scr, r / 64, r % 64, lane); continue; } r -= I1;
            if (r < I2) { p0_transpose_item(args.in[14], DM, W2_t, 2048, 0, 1024, scr, r / 64, r % 64, lane); continue; } r -= I2;
            if (r < I3) { p0_transpose_item(args.in[15], DM, Wout_t, 2048, 0, 0, scr, r / 64, r % 64, lane); continue; } r -= I3;
            if (r < I4) { p0_transpose_item(args.in[17], DM, Wg_t, 2048, 0, 0, scr, r / 64, r % 64, lane); continue; } r -= I4;
            if (r < I5) { p0_transpose_item(args.in[19], DM, Wple_t, 256, 0, 0, scr, r / 64, r % 64, lane); continue; } r -= I5;
            if (r < I6) { const int n = r >> 3, s = r & 7; p0_transpose_item(args.in[8] + (size_t)n * 16384, 128, Wr_t, 128, n * 128, 0, scr, s >> 2, s & 3, lane); continue; } r -= I6;
            { const int n = r >> 3, s = r & 7; p0_transpose_item(args.in[10] + (size_t)n * 16384, 128, Wi_t, 128, n * 128, 0, scr, s >> 2, s & 3, lane); }
        }
        const float* x = args.in[0]; const float* ng = args.in[2];
        {
            const GAS f32x4* gr = (const GAS f32x4*)ng + lane; f32x4 gg[8];
#pragma unroll
            for (int j = 0; j < 8; ++j) gg[j] = gr[64 * j];
            int m = gw; f32x4 v[8], vn[8];
            if (m < M) { const GAS f32x4* xr = (const GAS f32x4*)(x + (size_t)m * DM) + lane;
#pragma unroll
                for (int j = 0; j < 8; ++j) v[j] = xr[64 * j]; }
            while (m < M) {
                const int mn = m + NGW;
                if (mn < M) { const GAS f32x4* xr = (const GAS f32x4*)(x + (size_t)mn * DM) + lane;
#pragma unroll
                    for (int j = 0; j < 8; ++j) vn[j] = xr[64 * j]; }
                float s = 0.f;
#pragma unroll
                for (int j = 0; j < 8; ++j) s += (v[j].x * v[j].x + v[j].y * v[j].y) + (v[j].z * v[j].z + v[j].w * v[j].w);
                const float rstd = 1.0f / sqrtf(wave_sum(s) * (1.0f / DM) + 1e-6f);
                GAS unsigned long long* o8 = (GAS unsigned long long*)(Hb + (size_t)m * DM) + lane;
#pragma unroll
                for (int j = 0; j < 8; ++j) { const f32x4 g = gg[j];
                    o8[64 * j] = (unsigned long long)pk2(v[j].x * rstd * g.x, v[j].y * rstd * g.y) | ((unsigned long long)pk2(v[j].z * rstd * g.z, v[j].w * rstd * g.w) << 32); }
#pragma unroll
                for (int j = 0; j < 8; ++j) v[j] = vn[j];
                m = mn; }
        }
        if (gw < 16) { const int i = gw * 64 + lane; const float x = -args.in[12][i]; C8[i] = 8.0f * (fmaxf(x, 0.f) + log1pf(expf(-fabsf(x)))); }
        const float* p = args.in[1];
        for (int m0 = gw; m0 < M; m0 += 4 * NGW) {
            f32x4 pv[4];
#pragma unroll
            for (int i = 0; i < 4; ++i) { const int m = m0 + i * NGW; pv[i] = (f32x4){0.f, 0.f, 0.f, 0.f}; if (m < M) pv[i] = ((const GAS f32x4*)(p + (size_t)m * PLE))[lane]; }
#pragma unroll
            for (int i = 0; i < 4; ++i) { const int m = m0 + i * NGW;
                if (m < M) ((GAS unsigned long long*)(PB + (size_t)m * PLE))[lane] = (unsigned long long)pk2(pv[i].x, pv[i].y) | ((unsigned long long)pk2(pv[i].z, pv[i].w) << 32); }
        }
    }
}

#ifdef PROBE_TS
#ifndef PROBE_SCALE
#define PROBE_SCALE 0.002f
#endif
#ifndef PROBE_BLK
#define PROBE_BLK 0
#endif
#define STAMP(i) do { if (blockIdx.x == PROBE_BLK && threadIdx.x == 0) ((volatile unsigned long long*)(args.ws + (600u << 10)))[i] = __builtin_amdgcn_s_memrealtime(); } while (0)
#else
#define STAMP(i) do { } while (0)
#endif

template <bool DO_LRU, bool DO_ATT, bool WPRE = false> __device__ __forceinline__ void p2_phase(const Args& args, unsigned char* lds, LAS unsigned char* ldsl, int vcu, int G, bf16* Qb, bf16* Kb, bf16* Vb, bf16* GA, bf16* XR, bf16* GL, bf16* Yb, bf16* Wr_t, bf16* Wi_t, float* KMP, bf16* Q1b, float* PUB, unsigned* FLG, const float* C8) {
    const lru::Tensors T{XR, GL, Yb, Q1b, Wr_t, Wi_t, args.in[6], args.in[7], args.in[9], args.in[11], C8, PUB, FLG};
#ifndef SKIP_LRU
    if constexpr (DO_LRU)
    for (int L = vcu; L < 256; L += G) { const int g = L >> 3, q = L & 7;
        int tcs[4]; int nu = 0;
#pragma unroll
        for (int r = 0; r < 4; ++r) { const int tc = lru::unit_tc(q, r); tcs[r] = tc; if (tc >= 0) nu = r + 1; }
        if (nu > 0) {
        lru::Raw R; lru::load_raw(T, g, tcs[0], R);
        if (!(WPRE && L == vcu)) lru::load_weights(ldsl, T, g & 7);
#pragma unroll
        for (int k = 0; k < 4; ++k) if (k < nu) {
            LSTAMP(T, 20);
            lru::conv_stage(ldsl, T, g, R);
            LSTAMP(T, 21);
            if (k > 0) lru::publish(ldsl, T, g, tcs[k - 1]);
            if (k + 1 < nu) lru::load_raw(T, g, tcs[k + 1], R);
            LSTAMP(T, 23);
            lru::gate_stage(ldsl, T, g, tcs[k]); LSTAMP(T, 22); }
        lru::publish(ldsl, T, g, nu == 4 ? tcs[3] : (nu == 3 ? tcs[2] : (nu == 2 ? tcs[1] : tcs[0])));
        }
    }
#endif
    STAMP(10);
#ifndef SKIP_ATTN
    if constexpr (DO_ATT)
    attn::phase((char*)lds, (const attn::bf16*)Qb, (const attn::bf16*)Kb, (const attn::bf16*)Vb, (attn::bf16*)Yb, (const attn::bf16*)GA, KMP, vcu, G);
#endif
    STAMP(11);
#ifndef SKIP_LRU
    if constexpr (DO_LRU)
    for (int L = vcu; L < 256; L += G) { const int g = L >> 3, q = L & 7;
#pragma unroll 1
        for (int r = 0; r < 4; ++r) { const int tc = lru::unit_tc(q, r); if (tc > 0) lru::fix(ldsl, T, g, tc); }
    }
#endif
    STAMP(12);
}

__global__ void __launch_bounds__(NWAVES * 64, 2) moba_rglru_fwd(Args args) {
    extern __shared__ __attribute__((aligned(16))) unsigned char lds[];
    cg::grid_group grid = cg::this_grid();
    LAS unsigned char* ldsl = (LAS unsigned char*)lds;
    const int tid = threadIdx.x, lane = tid & 63, wave = __builtin_amdgcn_readfirstlane(tid >> 6);
    const int G = gridDim.x; const int bx = blockIdx.x; const int vcu = (G % 8 == 0) ? (bx % 8) * (G / 8) + bx / 8 : bx;
    unsigned char* ws = args.ws;
    volatile LAS unsigned* MISC = (volatile LAS unsigned*)(ldsl + MISC_OFF);
    if (tid < 16) MISC[tid] = 0u;
    __syncthreads();
    XcdBarrier bar = xcd_barrier_post((unsigned*)(ws + WS_BAR), MISC);
#ifdef KEEP_CG_DESCRIPTOR
    if (G > (1 << 20)) grid.sync();
#endif
#define GRID_BAR(i) do { xcd_barrier(bar); STAMP(i); } while (0)
    STAMP(0);
    bf16* Win_t = (bf16*)(ws + WS_WIN); bf16* W2_t = (bf16*)(ws + WS_W2); bf16* Wout_t = (bf16*)(ws + WS_WOUT); bf16* Wg_t = (bf16*)(ws + WS_WG); bf16* Wple_t = (bf16*)(ws + WS_WPLE);
    bf16* Wr_t = (bf16*)(ws + WS_WRT); bf16* Wi_t = (bf16*)(ws + WS_WIT);
    bf16* Hb = (bf16*)(ws + WS_H); bf16* MG = (bf16*)(ws + WS_MG); bf16* PB = (bf16*)(ws + WS_PB);
    bf16* Qb = (bf16*)(ws + WS_Q); bf16* Kb = (bf16*)(ws + WS_K); bf16* Vb = (bf16*)(ws + WS_V); bf16* GA = (bf16*)(ws + WS_GA); bf16* XR = (bf16*)(ws + WS_XR); bf16* GL = (bf16*)(ws + WS_GL);
    bf16* SAb = (bf16*)(ws + WS_SA); bf16* SLb = (bf16*)(ws + WS_SL); bf16* Yb = (bf16*)(ws + WS_Y); bf16* X1G = (bf16*)(ws + WS_X1G); bf16* PL = (bf16*)(ws + WS_PL);
    float* KMP = (float*)(ws + WS_KMP); float* SSQ = (float*)(ws + WS_SSQ);
    bf16* Q1b = (bf16*)(ws + WS_Q1); float* PUB = (float*)(ws + WS_PUB); unsigned* FLG = (unsigned*)(ws + WS_FLG); float* C8 = (float*)(ws + WS_C8);

#ifndef SKIP_P0
    p0_prologue(args, ldsl, vcu, G, wave, lane, Win_t, W2_t, Wout_t, Wg_t, Wple_t, Wr_t, Wi_t, Hb, PB, C8);
#if REP_P0 >= 2
    p0_prologue(args, ldsl, vcu, G, wave, lane, Win_t, W2_t, Wout_t, Wg_t, Wple_t, Wr_t, Wi_t, Hb, PB, C8);
#endif
#if REP_P0 >= 3
    p0_prologue(args, ldsl, vcu, G, wave, lane, Win_t, W2_t, Wout_t, Wg_t, Wple_t, Wr_t, Wi_t, Hb, PB, C8);
#endif
#endif
    GRID_BAR(1);

    for (int es_ = 0; es_ < EXTRA_SYNC; ++es_) GRID_BAR(99);
#ifndef SKIP_P1
    for (int rep_ = 0; rep_ < REP_P1; ++rep_) {
    {
        pg8::Gemm g{Hb, Win_t, M, DIN, DM}; pg8::StaticOrder S; S.init(M, DIN, G, bx);
        pg8::EpiG1 E{ws + WS_Q, KMP, args.in[4], args.in[5], (LAS float*)(ldsl + SCR_OFF), 0};
        pg8::gemm_phase<pg8::EpiG1, pg8::StaticOrder, true, true>(ldsl, g, S, E);
    }
    }
#endif
#if !defined(SKIP_P2) && !defined(SKIP_LRU)
    if (vcu < 256 && lru::unit_tc(vcu & 7, 0) >= 0) {
        const lru::Tensors T{XR, GL, Yb, Q1b, Wr_t, Wi_t, args.in[6], args.in[7], args.in[9], args.in[11], C8, PUB, FLG};
        lru::load_weights(ldsl, T, (vcu >> 3) & 7); }
#endif
    GRID_BAR(2);

#ifndef SKIP_P2
    p2_phase<true, true, true>(args, lds, ldsl, vcu, G, Qb, Kb, Vb, GA, XR, GL, Yb, Wr_t, Wi_t, KMP, Q1b, PUB, FLG, C8);
#if REP_LRU >= 2
    p2_phase<true, false>(args, lds, ldsl, vcu, G, Qb, Kb, Vb, GA, XR, GL, Yb, Wr_t, Wi_t, KMP, Q1b, PUB, FLG, C8);
#endif
#if REP_ATT >= 2
    p2_phase<false, true>(args, lds, ldsl, vcu, G, Qb, Kb, Vb, GA, XR, GL, Yb, Wr_t, Wi_t, KMP, Q1b, PUB, FLG, C8);
#endif
#if REP_LRU >= 3
    p2_phase<true, false>(args, lds, ldsl, vcu, G, Qb, Kb, Vb, GA, XR, GL, Yb, Wr_t, Wi_t, KMP, Q1b, PUB, FLG, C8);
#endif
#if REP_ATT >= 3
    p2_phase<false, true>(args, lds, ldsl, vcu, G, Qb, Kb, Vb, GA, XR, GL, Yb, Wr_t, Wi_t, KMP, Q1b, PUB, FLG, C8);
#endif
#endif
    GRID_BAR(3);

#ifndef SKIP_P3
    for (int rep_ = 0; rep_ < REP_P3; ++rep_) {
    {
        size_t zw3 = 0; asm volatile("" : "+s"(zw3)); unsigned char* w3 = args.ws + zw3;
        pg8::Gemm g{(bf16*)(w3 + WS_Y), (bf16*)(w3 + WS_W2), M, DM, DM}; pg8::StaticOrder S; S.init(M, DM, G, bx);
        pg8::EpiG2 E{(bf16*)(w3 + WS_SA), (bf16*)(w3 + WS_SL), (bf16*)(w3 + WS_MG), 16};
        pg8::gemm_phase<pg8::EpiG2, pg8::StaticOrder, ALIGN_SINGLE, true>(ldsl, g, S, E);
    }
    }
#endif
    GRID_BAR(4);

#ifndef SKIP_P4
    for (int rep_ = 0; rep_ < REP_P4; ++rep_) {
    {
        size_t zw4 = 0; asm volatile("" : "+s"(zw4)); unsigned char* w4 = args.ws + zw4;
        pg8::Gemm g{(bf16*)(w4 + WS_MG), (bf16*)(w4 + WS_WOUT), M, DM, DM}; pg8::StaticOrder S; S.init(M, DM, G, bx);
        pg8::EpiG3 E{args.in[0], args.out, (bf16*)(w4 + WS_X1G), (float*)(w4 + WS_SSQ), args.in[16], 0};
        pg8::gemm_phase<pg8::EpiG3, pg8::StaticOrder, ALIGN_SINGLE, true>(ldsl, g, S, E);
    }
    }
#endif
#ifndef SKIP_P5
    {
        size_t zw5a = 0; asm volatile("" : "+s"(zw5a)); unsigned char* w5 = args.ws + zw5a;
        { pg8::Gemm g{(bf16*)(w5 + WS_PB), (bf16*)(w5 + WS_WPLE), M, DM, PLE}; pg8::StaticOrder S; S.init(M, DM, G, bx);
          pg8::EpiG4a E{(bf16*)(w5 + WS_PL), 0};
          pg8::gemm_phase<pg8::EpiG4a, pg8::StaticOrder, ALIGN_SINGLE, true>(ldsl, g, S, E); }
        asm volatile("s_waitcnt vmcnt(0)" ::: "memory"); __syncthreads();
    }
#endif
    GRID_BAR(5);

#ifndef SKIP_P5
    {
        size_t zw5 = 0; asm volatile("" : "+s"(zw5)); unsigned char* w5 = args.ws + zw5;
        { pg8::Gemm g{(bf16*)(w5 + WS_X1G), (bf16*)(w5 + WS_WG), M, DM, DM}; pg8::StaticOrder S; S.init(M, DM, G, bx);
          pg8::EpiG4b E{args.out, (bf16*)(w5 + WS_PL), (float*)(w5 + WS_SSQ), args.in[18], (LAS float*)(ldsl + SCR_OFF), 0};
          pg8::gemm_phase<pg8::EpiG4b, pg8::StaticOrder, ALIGN_SINGLE, true>(ldsl, g, S, E); }
    }
#endif
#ifdef PROBE_TS
    asm volatile("s_waitcnt vmcnt(0)" ::: "memory"); __syncthreads();
    STAMP(6);
    if (blockIdx.x == PROBE_BLK && threadIdx.x == 0) { volatile unsigned long long* ts_ = (volatile unsigned long long*)(args.ws + (600u << 10)); const float us = (float)(ts_[PROBE_TE] - ts_[PROBE_TS]) * 0.01f; args.out[0] += us * PROBE_SCALE; }
#endif
}

extern "C" void kernel_launch(void* const* d_in, const int* in_sizes, int n_in, void* d_out, int out_size, void* d_ws, size_t ws_size, hipStream_t stream) {
    static int grid_blocks = 0;
    if (grid_blocks == 0) {
        if (n_in != 20 || in_sizes[0] != M * DM || out_size != M * DM || ws_size < WS_END) { fprintf(stderr, "kernel_launch: unexpected shapes (n_in %d, in0 %d, out %d, ws %zu)\n", n_in, n_in > 0 ? in_sizes[0] : -1, out_size, ws_size); grid_blocks = -1; return; }
        int dev = 0, cus = 0, per_cu = 0;
        (void)hipGetDevice(&dev);
        (void)hipDeviceGetAttribute(&cus, hipDeviceAttributeMultiprocessorCount, dev);
        if (hipFuncSetAttribute((const void*)moba_rglru_fwd, hipFuncAttributeMaxDynamicSharedMemorySize, LDS_BYTES) != hipSuccess) { fprintf(stderr, "kernel_launch: hipFuncSetAttribute failed\n"); }
        if (hipOccupancyMaxActiveBlocksPerMultiprocessor(&per_cu, (const void*)moba_rglru_fwd, NWAVES * 64, LDS_BYTES) != hipSuccess || per_cu < 1) { fprintf(stderr, "kernel_launch: occupancy query failed (%d)\n", per_cu); per_cu = 1; }
        (void)hipGetLastError();
        if (per_cu > 1) per_cu = 1;
        grid_blocks = cus * per_cu;
        if (grid_blocks > 256) grid_blocks = 256;
    }
    if (grid_blocks < 0) return;
    if (hipMemsetAsync((char*)d_ws + WS_BAR, 0, BAR_BYTES + FLG_BYTES, stream) != hipSuccess) { fprintf(stderr, "kernel_launch: hipMemsetAsync failed\n"); return; }
    Args a{};
    for (int i = 0; i < 20; ++i) a.in[i] = (const float*)d_in[i];
    a.out = (float*)d_out; a.ws = (unsigned char*)d_ws;
    void* kargs[] = {&a};
    hipError_t e = hipLaunchCooperativeKernel((const void*)moba_rglru_fwd, dim3(grid_blocks), dim3(NWAVES * 64), kargs, LDS_BYTES, stream);
    if (e != hipSuccess) fprintf(stderr, "cooperative launch failed: %s (grid %d)\n", hipGetErrorString(e), grid_blocks);
}
```
